# Optimizing an MI355X kernel written in HIP

```python
import jax
import jax.numpy as jnp
from jax import lax
import numpy as np

D_MODEL = 1024
BATCH = 32
SEQ = 2048
DEPTH = 1

D_MIX = D_MODEL
ATTN_HEADS = 8
ATTN_HEAD_DIM = 64
ATTN_WIDTH = ATTN_HEADS * ATTN_HEAD_DIM
DILATED_PATTERNS = ((128, 1), (512, 4), (2048, 16))
RWKV_HEADS = 8
RWKV_HEAD_DIM = 64
RWKV_WIDTH = RWKV_HEADS * RWKV_HEAD_DIM
DECAY_LORA = 64
ICLR_LORA = 64
GATE_LORA = 128
RWKV_IN_WIDTH = 3 * RWKV_WIDTH + DECAY_LORA + ICLR_LORA + GATE_LORA
IN_WIDTH = 3 * ATTN_WIDTH + RWKV_IN_WIDTH
N_EXPERTS = 32
TOP_K = 4
D_FF_EXPERT = D_MODEL
SWIGLU_ALPHA = 1.702
SWIGLU_LIMIT = 7.0
MOE_BLOCK = 512
NORM_EPS = 1e-5
GROUPNORM_EPS = 64e-5
L2_EPS = 1e-12

kernel_name = 'hybrid_dilated_attn_rwkv7_moe_block'


def rms_norm(x, gain):
    xf = x.astype(jnp.float32)
    y = xf * lax.rsqrt(jnp.mean(xf * xf, axis=-1, keepdims=True) + NORM_EPS)
    return (y * gain.astype(jnp.float32)).astype(x.dtype)


def token_shift(z):
    return jnp.pad(z[:, :-1], ((0, 0), (1, 0), (0, 0)))


def dilated_window_attention(q, k, v, window, dilation):
    b, s, h, e = q.shape
    blk = window // dilation
    m = s // dilation
    nb = -(-m // blk)
    mp = nb * blk

    def to_blocks(t):
        t = t.reshape(b, m, dilation, h, e)
        t = jnp.pad(t, ((0, 0), (0, mp - m), (0, 0), (0, 0), (0, 0)))
        return t.reshape(b, nb, blk, dilation, h, e)

    def with_prev(t):
        prev = jnp.pad(t[:, :-1], ((0, 0), (1, 0), (0, 0), (0, 0), (0, 0), (0, 0)))
        return jnp.concatenate([prev, t], axis=2)

    qb = to_blocks(q)
    kc = with_prev(to_blocks(k))
    vc = with_prev(to_blocks(v))
    scores = jnp.einsum('bnidhe,bnjdhe->bndhij', qb, kc).astype(jnp.float32) * (e ** -0.5)
    i = jnp.arange(blk)[:, None]
    j = jnp.arange(2 * blk)[None, :]
    dist = blk + i - j
    band = (dist >= 0) & (dist <= blk)
    has_prev = (jnp.arange(nb) > 0)[:, None, None] | (j >= blk)[None]
    mask = band[None] & has_prev
    scores = jnp.where(mask[:, None, None], scores, -jnp.inf)
    lse = jax.nn.logsumexp(scores, axis=-1)
    probs = jnp.exp(scores - lse[..., None]).astype(v.dtype)
    out = jnp.einsum('bndhij,bnjdhe->bnidhe', probs, vc)
    out = out.reshape(b, mp, dilation, h, e)[:, :m].reshape(b, s, h, e)
    lse = lse.transpose(0, 1, 4, 2, 3).reshape(b, mp, dilation, h)[:, :m].reshape(b, s, h)
    return out, lse


def dilated_attention_group(z_attn, out_gain):
    b, s, _ = z_attn.shape
    q, k, v = jnp.split(z_attn, 3, axis=-1)
    q = q.reshape(b, s, ATTN_HEADS, ATTN_HEAD_DIM)
    k = k.reshape(b, s, ATTN_HEADS, ATTN_HEAD_DIM)
    v = v.reshape(b, s, ATTN_HEADS, ATTN_HEAD_DIM)
    outs, lses = [], []
    for window, dilation in DILATED_PATTERNS:
        o, l = dilated_window_attention(q, k, v, window, dilation)
        outs.append(o.astype(jnp.float32))
        lses.append(l)
    wts = jax.nn.softmax(jnp.stack(lses, 0), axis=0)
    o = jnp.sum(wts[..., None] * jnp.stack(outs, 0), axis=0)
    o = o * lax.rsqrt(jnp.mean(o * o, axis=-1, keepdims=True) + NORM_EPS)
    return (o.reshape(b, s, ATTN_WIDTH) * out_gain.astype(jnp.float32)).astype(z_attn.dtype)


def wkv7_scan(r, decay, k, v, a, bb):
    bsz, _, h, n = r.shape

    def step(state, inp):
        r_t, w_t, k_t, v_t, a_t, b_t = inp
        sa = jnp.einsum('bhij,bhj->bhi', state, a_t)
        state = (state * w_t[:, :, None, :] + sa[..., None] * b_t[:, :, None, :]
                 + v_t[..., None] * k_t[:, :, None, :])
        return state, jnp.einsum('bhij,bhj->bhi', state, r_t)

    xs = tuple(jnp.swapaxes(t, 0, 1) for t in (r, decay, k, v, a, bb))
    state0 = jnp.zeros((bsz, h, n, n), jnp.float32)
    _, ys = lax.scan(step, state0, xs)
    return jnp.swapaxes(ys, 0, 1)


def rwkv7_group(z_rwkv, shift_mu, decay_up, decay_bias, iclr_up, iclr_bias, gate_up,
                k_k, k_a, r_k, lnx_w, lnx_b):
    f32 = jnp.float32
    b, s, _ = z_rwkv.shape
    hn = (RWKV_HEADS, RWKV_HEAD_DIM)
    zs = z_rwkv + (token_shift(z_rwkv) - z_rwkv) * shift_mu
    c0 = RWKV_WIDTH
    c1 = 2 * RWKV_WIDTH
    c2 = 3 * RWKV_WIDTH
    c3 = c2 + DECAY_LORA
    c4 = c3 + ICLR_LORA
    r, k, v, wd, ad, gd = jnp.split(zs, [c0, c1, c2, c3, c4], axis=-1)
    w = -jax.nn.softplus(-(decay_bias + jnp.tanh(wd) @ decay_up).astype(f32)) - 0.5
    decay = jnp.exp(-jnp.exp(w))
    a = jax.nn.sigmoid((iclr_bias + ad @ iclr_up).astype(f32))
    g = (jax.nn.sigmoid(gd) @ gate_up).astype(f32)

    def heads(t):
        return t.astype(f32).reshape(b, s, RWKV_HEADS, RWKV_HEAD_DIM)

    r, k, v, a, decay = heads(r), heads(k), heads(v), heads(a), heads(decay)
    kk = k * k_k.astype(f32).reshape(hn)
    kk = kk / jnp.maximum(jnp.linalg.norm(kk, axis=-1, keepdims=True), L2_EPS)
    k = k * (1.0 + (a - 1.0) * k_a.astype(f32).reshape(hn))
    y = wkv7_scan(r, decay, k, v, -kk, kk * a)
    mean = jnp.mean(y, axis=-1, keepdims=True)
    var = jnp.mean(jnp.square(y - mean), axis=-1, keepdims=True)
    y = ((y - mean) * lax.rsqrt(var + GROUPNORM_EPS) * lnx_w.astype(f32).reshape(hn)
         + lnx_b.astype(f32).reshape(hn))
    y = y + jnp.sum(r * k * r_k.astype(f32), axis=-1, keepdims=True) * v
    return (y.reshape(b, s, RWKV_WIDTH) * g).astype(z_rwkv.dtype)


def clamped_swiglu(u):
    glu, lin = jnp.split(u, 2, axis=-1)
    glu = jnp.minimum(glu, SWIGLU_LIMIT)
    lin = jnp.clip(lin, -SWIGLU_LIMIT, SWIGLU_LIMIT)
    return glu * jax.nn.sigmoid(SWIGLU_ALPHA * glu) * (lin + 1.0)


def moe_ffn(h, router_w, router_b, w1, b1, w2, b2):
    n, d = h.shape
    nk = n * TOP_K
    logits = (h @ router_w + router_b).astype(jnp.float32)
    top_vals, top_idx = lax.top_k(logits, TOP_K)
    gates = jax.nn.softmax(top_vals, axis=-1).reshape(nk)
    expert_of = top_idx.reshape(nk)
    token_of = jnp.arange(nk, dtype=jnp.int32) // TOP_K
    order = jnp.argsort(expert_of)
    e_sorted = expert_of[order]
    sizes = jnp.bincount(expert_of, length=N_EXPERTS)
    starts = jnp.cumsum(sizes) - sizes
    padded = (sizes + MOE_BLOCK - 1) // MOE_BLOCK * MOE_BLOCK
    pad_ends = jnp.cumsum(padded)
    dest = pad_ends[e_sorted] - padded[e_sorted] + jnp.arange(nk) - starts[e_sorted]
    n_blocks = -(-nk // MOE_BLOCK) + N_EXPERTS
    rows = n_blocks * MOE_BLOCK
    slot_token = jnp.zeros((rows,), jnp.int32).at[dest].set(token_of[order])
    slot_gate = jnp.zeros((rows,), jnp.float32).at[dest].set(gates[order])
    block_expert = jnp.minimum(
        jnp.searchsorted(pad_ends, jnp.arange(n_blocks) * MOE_BLOCK, side='right'), N_EXPERTS - 1)

    def expert_block(args):
        tok, gate, e = args
        xb = h[tok]
        u = xb @ w1[e] + b1[e]
        yb = clamped_swiglu(u) @ w2[e] + b2[e]
        return yb * gate[:, None].astype(yb.dtype)

    y = lax.map(expert_block, (slot_token.reshape(n_blocks, MOE_BLOCK),
                               slot_gate.reshape(n_blocks, MOE_BLOCK), block_expert))
    return jax.ops.segment_sum(y.reshape(rows, d), slot_token, num_segments=n)


def setup_inputs(seed: int = 0) -> dict:
    key = jax.random.key(seed)
    ks = jax.random.split(key, 24)
    f32 = jnp.float32

    def normal(k, shape, scale):
        return jax.random.normal(k, shape, f32) * scale

    def gain(k, shape):
        return 1.0 + 0.02 * jax.random.normal(k, shape, f32)

    L, D, E, F = DEPTH, D_MODEL, N_EXPERTS, D_FF_EXPERT
    return {
        'x': normal(ks[0], (BATCH, SEQ, D), 1.0),
        'norm1_gain': gain(ks[1], (L, D)),
        'w_in': normal(ks[2], (L, D, IN_WIDTH), D ** -0.5),
        'shift_mu': jax.random.uniform(ks[3], (L, RWKV_IN_WIDTH), f32),
        'decay_up': normal(ks[4], (L, DECAY_LORA, RWKV_WIDTH), 0.1),
        'decay_bias': jax.random.uniform(ks[5], (L, RWKV_WIDTH), f32, -4.0, 1.0),
        'iclr_up': normal(ks[6], (L, ICLR_LORA, RWKV_WIDTH), 0.1),
        'iclr_bias': normal(ks[7], (L, RWKV_WIDTH), 0.1),
        'gate_up': normal(ks[8], (L, GATE_LORA, RWKV_WIDTH), GATE_LORA ** -0.5),
        'k_k': 0.85 + normal(ks[9], (L, RWKV_WIDTH), 0.05),
        'k_a': 1.0 + normal(ks[10], (L, RWKV_WIDTH), 0.05),
        'r_k': normal(ks[11], (L, RWKV_HEADS, RWKV_HEAD_DIM), 0.1),
        'lnx_w': gain(ks[12], (L, RWKV_WIDTH)),
        'lnx_b': normal(ks[13], (L, RWKV_WIDTH), 0.02),
        'attn_out_gain': gain(ks[14], (L, ATTN_WIDTH)),
        'w_out': normal(ks[15], (L, D_MIX, D), D_MIX ** -0.5),
        'norm2_gain': gain(ks[16], (L, D)),
        'router_w': normal(ks[17], (L, D, E), D ** -0.5),
        'router_b': normal(ks[18], (L, E), 0.01),
        'expert_w1': normal(ks[19], (L, E, D, 2 * F), D ** -0.5),
        'expert_b1': normal(ks[20], (L, E, 2 * F), 0.01),
        'expert_w2': normal(ks[21], (L, E, F, D), F ** -0.5),
        'expert_b2': normal(ks[22], (L, E, D), 0.01),
        'final_norm_gain': gain(ks[23], (D,)),
    }


def reference(x, norm1_gain, w_in, shift_mu, decay_up, decay_bias, iclr_up, iclr_bias, gate_up,
              k_k, k_a, r_k, lnx_w, lnx_b, attn_out_gain, w_out, norm2_gain, router_w, router_b,
              expert_w1, expert_b1, expert_w2, expert_b2, final_norm_gain):
    b, s, d = x.shape
    for l in range(DEPTH):
        h = rms_norm(x, norm1_gain[l])
        z = h @ w_in[l]
        z_attn = z[..., :3 * ATTN_WIDTH]
        z_rwkv = z[..., 3 * ATTN_WIDTH:]
        y_attn = dilated_attention_group(z_attn, attn_out_gain[l])
        y_rwkv = rwkv7_group(z_rwkv, shift_mu[l], decay_up[l], decay_bias[l], iclr_up[l],
                             iclr_bias[l], gate_up[l], k_k[l], k_a[l], r_k[l], lnx_w[l], lnx_b[l])
        x = x + jnp.concatenate([y_attn, y_rwkv], axis=-1) @ w_out[l]
        h = rms_norm(x, norm2_gain[l]).reshape(b * s, d)
        x = x + moe_ffn(h, router_w[l], router_b[l], expert_w1[l], expert_b1[l],
                        expert_w2[l], expert_b2[l]).reshape(b, s, d).astype(x.dtype)
    return rms_norm(x, final_norm_gain)
```

```cpp
#include <hip/hip_runtime.h>
#include <stdint.h>
#include <stdio.h>

#define LAS __attribute__((address_space(3)))
typedef unsigned short bf16_t;
typedef short bf16x8 __attribute__((ext_vector_type(8)));
typedef short s16x4 __attribute__((ext_vector_type(4)));
typedef float f32x4 __attribute__((ext_vector_type(4)));
typedef float f32x2 __attribute__((ext_vector_type(2)));
typedef unsigned u32x4 __attribute__((ext_vector_type(4)));
typedef unsigned u32x2 __attribute__((ext_vector_type(2)));

constexpr int NTOK = 65536, SEQ = 2048, DM = 1024, INW = 3328, NE = 32, FF = 1024, NH = 8;
constexpr int RW_OFF = 1536;
constexpr float NORM_EPS = 1e-5f, GN_EPS = 64e-5f;

constexpr size_t MiB = 1048576;
constexpr size_t WS_CTL   = 0;
constexpr size_t CTL_ZERO_BYTES = 65536;
constexpr size_t WS_WIN   = 2 * MiB;
constexpr size_t WS_WOUT  = WS_WIN + (size_t)INW * DM * 2;
constexpr size_t WS_DECUP = WS_WOUT + (size_t)DM * DM * 2;
constexpr size_t WS_ICLUP = WS_DECUP + 512 * 64 * 2;
constexpr size_t WS_GATUP = WS_ICLUP + 512 * 64 * 2;
constexpr size_t WS_W2T   = 12 * MiB;
constexpr size_t WS_W1T   = 76 * MiB;
constexpr size_t WS_LACT  = 140 * MiB;
constexpr size_t WS_H     = 204 * MiB;
constexpr size_t WS_TAIL  = 332 * MiB;
constexpr size_t WS_Z     = 472 * MiB;
constexpr size_t WS_YMIX  = 888 * MiB;
constexpr size_t WS_END   = 1016 * MiB;
static_assert(WS_GATUP + 512 * 128 * 2 <= WS_W2T, "small weights");
constexpr size_t WS_STA   = WS_H;
constexpr size_t ST_BYTES_PER_BH = (size_t)SEQ * 64 * 4 + (size_t)SEQ * 2 * 4;
constexpr size_t WS_STB   = WS_STA + 256 * ST_BYTES_PER_BH;
static_assert(WS_STB + 256 * ST_BYTES_PER_BH <= WS_Z, "state buffers");
constexpr size_t WS_LIST  = WS_TAIL;
constexpr size_t WS_GATE  = WS_TAIL + 8 * MiB;
constexpr size_t WS_GLIST = WS_TAIL + 16 * MiB;
constexpr size_t WS_HID   = WS_Z;
constexpr size_t WS_X1    = 736 * MiB;
constexpr size_t WS_Y2    = WS_W1T;
constexpr int CW_BAR = 0;
constexpr int CW_CNT = 4096;

#define XB_TMO      128
#define XB_XCNT(j)  (256  + 64 * (j))
#define XB_XSUB(j)  (1280 + 64 * (j))
#define XB_XGEN(j)  (2304 + 64 * (j))
#define XB_TOP      3328
#define XB_TOPGEN   3392
#define XCD_BAR_WORDS 3456
#define XB_SPIN_CAP (1u << 18)

__device__ __forceinline__ unsigned xb_ld(unsigned* p)              { return __hip_atomic_load(p, __ATOMIC_RELAXED, __HIP_MEMORY_SCOPE_AGENT); }
__device__ __forceinline__ unsigned xb_add(unsigned* p, unsigned v) { return __hip_atomic_fetch_add(p, v, __ATOMIC_RELAXED, __HIP_MEMORY_SCOPE_AGENT); }
__device__ __forceinline__ unsigned xb_xcc_id() { return (unsigned)__builtin_amdgcn_s_getreg((3 << 11) | 20) & 0xFu; }
#define XB_SPIN(cond, bar) do { unsigned _sp = 0; while (cond) { __builtin_amdgcn_s_sleep(1); \
    if ((++_sp & 255u) == 0u) { if (xb_ld(&(bar)[XB_TMO])) break; if (_sp > XB_SPIN_CAP) { atomicAdd(&(bar)[XB_TMO], 1u); break; } } } } while (0)

struct XcdBarrier { unsigned* bar; unsigned x; volatile LAS unsigned* st; };

__device__ __forceinline__ XcdBarrier xcd_barrier_post(unsigned* bar, volatile LAS unsigned* st) {
    XcdBarrier b; b.bar = bar; b.x = xb_xcc_id(); b.st = st;
    if (threadIdx.x == 0) (void)xb_add(&bar[XB_XCNT(b.x)], 1u);
    return b;
}
__device__ __forceinline__ void xcd_barrier_complete(unsigned* bar, unsigned x, unsigned& nloc, unsigned& nx) {
    const unsigned G = gridDim.x * gridDim.y * gridDim.z;
    unsigned sum, cnt, mine, sp = 0u;
    for (;;) {
        sum = 0u; cnt = 0u; mine = 0u;
#pragma unroll
        for (unsigned j = 0; j < 16; ++j) { const unsigned c = xb_ld(&bar[XB_XCNT(j)]); sum += c; cnt += (c > 0u) ? 1u : 0u; mine = (j == x) ? c : mine; }
        if (sum == G) break;
        __builtin_amdgcn_s_sleep(1);
        if ((++sp & 255u) == 0u) { if (xb_ld(&bar[XB_TMO])) break; if (sp > XB_SPIN_CAP) { atomicAdd(&bar[XB_TMO], 1u); break; } }
    }
    nloc = mine > 0u ? mine : 1u; nx = cnt > 0u ? cnt : 1u;
}
__device__ __forceinline__ void xcd_barrier(const XcdBarrier& b) {
    asm volatile("s_waitcnt vmcnt(0)" ::: "memory");
    __syncthreads();
    if (threadIdx.x == 0) {
        unsigned* bar = b.bar;
        __builtin_amdgcn_s_waitcnt(0);
        unsigned nloc = b.st[0], nx = b.st[1];
        if (nloc == 0u) { xcd_barrier_complete(bar, b.x, nloc, nx); b.st[0] = nloc; b.st[1] = nx; }
        const unsigned old = xb_add(&bar[XB_XSUB(b.x)], 1u);
        const unsigned gen = old / nloc;
        if (old + 1u == (gen + 1u) * nloc) {
            __builtin_amdgcn_fence(__ATOMIC_RELEASE, "agent");
            asm volatile("s_waitcnt vmcnt(0)" ::: "memory");
            const unsigned og = xb_add(&bar[XB_TOP], 1u);
            const unsigned tg = og / nx;
            if (og + 1u == (tg + 1u) * nx) xb_add(&bar[XB_TOPGEN], 1u);
            else XB_SPIN(xb_ld(&bar[XB_TOPGEN]) == tg, bar);
            __builtin_amdgcn_fence(__ATOMIC_ACQUIRE, "agent");
            xb_add(&bar[XB_XGEN(b.x)], 1u);
            asm volatile("s_waitcnt vmcnt(0)" ::: "memory");
        } else {
            XB_SPIN(xb_ld(&bar[XB_XGEN(b.x)]) == gen, bar);
            __builtin_amdgcn_fence(__ATOMIC_ACQUIRE, "agent");
            asm volatile("s_waitcnt vmcnt(0)" ::: "memory");
        }
    }
    __syncthreads();
}

__device__ __forceinline__ unsigned cvt_pk_bf16(float lo, float hi) { unsigned r; asm volatile("v_cvt_pk_bf16_f32 %0, %1, %2" : "=v"(r) : "v"(lo), "v"(hi)); return r; }
__device__ __forceinline__ float bf_lo(unsigned w) { return __uint_as_float(w << 16); }
__device__ __forceinline__ float bf_hi(unsigned w) { return __uint_as_float(w & 0xffff0000u); }
__device__ __forceinline__ float bf1(bf16_t v) { return __uint_as_float(((unsigned)v) << 16); }
template <int CTRL> __device__ __forceinline__ float dpp_f(float v) { return __int_as_float(__builtin_amdgcn_update_dpp(0, __float_as_int(v), CTRL, 0xf, 0xf, true)); }
__device__ __forceinline__ u32x4 xchg1(u32x4 v) { u32x4 r;
#pragma unroll
    for (int i = 0; i < 4; ++i) r[i] = (unsigned)__builtin_amdgcn_update_dpp(0, (int)v[i], 0xB1, 0xf, 0xf, true);
    return r; }
__device__ __forceinline__ float red8(float v)  { v += dpp_f<0xB1>(v); v += dpp_f<0x4E>(v); v += dpp_f<0x141>(v); return v; }
__device__ __forceinline__ float red16(float v) { v = red8(v); v += dpp_f<0x140>(v); return v; }
__device__ __forceinline__ float wave_sum(float v) { v = red16(v); v += __shfl_xor(v, 16); v += __shfl_xor(v, 32); return v; }
__device__ __forceinline__ float fexp(float x) { return __builtin_amdgcn_exp2f(x * 1.4426950408889634f); }
__device__ __forceinline__ float frcp(float x) { return __builtin_amdgcn_rcpf(x); }
__device__ __forceinline__ float sigmoidf_(float x) { return frcp(1.0f + fexp(-x)); }
__device__ __forceinline__ float ftanh(float x) { return 1.0f - 2.0f * frcp(1.0f + fexp(2.0f * x)); }

struct Params {
    const float *x, *norm1_gain, *w_in, *shift_mu, *decay_up, *decay_bias, *iclr_up, *iclr_bias, *gate_up,
                *k_k, *k_a, *r_k, *lnx_w, *lnx_b, *attn_out_gain, *w_out, *norm2_gain, *router_w, *router_b,
                *expert_w1, *expert_b1, *expert_w2, *expert_b2, *final_norm_gain;
    float* out;
    unsigned char* ws;
    int ph_lo, ph_hi;
};

__device__ __forceinline__ unsigned pk4_fp8(float a, float b, float c, float d) { int w = 0; w = __builtin_amdgcn_cvt_pk_fp8_f32(a, b, w, false); w = __builtin_amdgcn_cvt_pk_fp8_f32(c, d, w, true); return (unsigned)w; }
constexpr float W8_SCALE = 64.0f;
constexpr int SC_ONE = 0x7f7f7f7f, SC_W = 0x79797979;
struct TJob { const float* src; unsigned char* dst; int N, K, k0, n0, fp8; };
__device__ __forceinline__ TJob tjob(const Params& p, int j) {
    unsigned char* ws = p.ws; TJob t;
    constexpr int J_W1 = 32 * 16 * 8, J_W2 = 32 * 16 * 4, J_WIN = 16 * 13, J_WOUT = 16 * 4, J_DEC = 2, J_ICL = 2;
    if (j < J_W1) { const int e = j / 128, r = j % 128; t = TJob{p.expert_w1 + (size_t)e * DM * 2048, ws + WS_W1T + (size_t)e * 2048 * DM, 2048, DM, (r / 8) * 64, (r % 8) * 256, 1}; return t; }
    j -= J_W1;
    if (j < J_W2) { const int e = j / 64, r = j % 64; t = TJob{p.expert_w2 + (size_t)e * FF * DM, ws + WS_W2T + (size_t)e * DM * FF, DM, FF, (r / 4) * 64, (r % 4) * 256, 1}; return t; }
    j -= J_W2;
    if (j < J_WIN) { t = TJob{p.w_in, ws + WS_WIN, INW, DM, (j / 13) * 64, (j % 13) * 256, 0}; return t; }
    j -= J_WIN;
    if (j < J_WOUT) { t = TJob{p.w_out, ws + WS_WOUT, DM, DM, (j / 4) * 64, (j % 4) * 256, 0}; return t; }
    j -= J_WOUT;
    if (j < J_DEC) { t = TJob{p.decay_up, ws + WS_DECUP, 512, 64, 0, j * 256, 2}; return t; }
    j -= J_DEC;
    if (j < J_ICL) { t = TJob{p.iclr_up, ws + WS_ICLUP, 512, 64, 0, j * 256, 2}; return t; }
    j -= J_ICL;
    t = TJob{p.gate_up, ws + WS_GATUP, 512, 128, (j / 2) * 64, (j % 2) * 256, 2}; return t;
}
constexpr int T_NJOBS = 32 * 16 * 8 + 32 * 16 * 4 + 16 * 13 + 16 * 4 + 2 + 2 + 4;
constexpr int T_STR = 260;
__device__ __forceinline__ void phase0(const Params& p, LAS unsigned char* lds) {
    unsigned char* ws = p.ws;
    const int tid = threadIdx.x, lane = tid & 63, wid = tid >> 6;
    {
        f32x4 g[4];
        g[0] = *(const f32x4*)(p.norm1_gain + lane * 8); g[1] = *(const f32x4*)(p.norm1_gain + lane * 8 + 4);
        g[2] = *(const f32x4*)(p.norm1_gain + 512 + lane * 8); g[3] = *(const f32x4*)(p.norm1_gain + 512 + lane * 8 + 4);
        bf16_t* o = (bf16_t*)(ws + WS_H);
        for (int row0 = (blockIdx.x * 8 + wid) * 4; row0 < NTOK; row0 += gridDim.x * 32) {
            f32x4 v[4][4];
#pragma unroll
            for (int r = 0; r < 4; ++r) { const float* xr = p.x + (size_t)(row0 + r) * DM;
                v[r][0] = __builtin_nontemporal_load((const f32x4*)(xr + lane * 8)); v[r][1] = __builtin_nontemporal_load((const f32x4*)(xr + lane * 8 + 4)); v[r][2] = __builtin_nontemporal_load((const f32x4*)(xr + 512 + lane * 8)); v[r][3] = __builtin_nontemporal_load((const f32x4*)(xr + 512 + lane * 8 + 4)); }
#pragma unroll
            for (int r = 0; r < 4; ++r) {
                float ss = 0.f;
#pragma unroll
                for (int i = 0; i < 4; ++i) ss += v[r][i][0] * v[r][i][0] + v[r][i][1] * v[r][i][1] + v[r][i][2] * v[r][i][2] + v[r][i][3] * v[r][i][3];
                ss = wave_sum(ss);
                const float rs = rsqrtf(ss * (1.0f / DM) + NORM_EPS);
                f32x4 q[4];
#pragma unroll
                for (int i = 0; i < 4; ++i) q[i] = v[r][i] * rs * g[i];
                u32x4 w0, w1;
                w0.x = cvt_pk_bf16(q[0][0], q[0][1]); w0.y = cvt_pk_bf16(q[0][2], q[0][3]); w0.z = cvt_pk_bf16(q[1][0], q[1][1]); w0.w = cvt_pk_bf16(q[1][2], q[1][3]);
                w1.x = cvt_pk_bf16(q[2][0], q[2][1]); w1.y = cvt_pk_bf16(q[2][2], q[2][3]); w1.z = cvt_pk_bf16(q[3][0], q[3][1]); w1.w = cvt_pk_bf16(q[3][2], q[3][3]);
                *(u32x4*)(o + (size_t)(row0 + r) * DM + lane * 8) = w0;
                *(u32x4*)(o + (size_t)(row0 + r) * DM + 512 + lane * 8) = w1;
            }
        }
    }
    LAS float* T0 = (LAS float*)lds; LAS float* T1 = T0 + 64 * T_STR;
    f32x4 rg[8];
    const int lr = tid >> 6, lc = (tid & 63) * 4;
#define T_LOAD(J) do { const TJob t_ = tjob(p, (J)); _Pragma("unroll") for (int i = 0; i < 8; ++i) rg[i] = __builtin_nontemporal_load((const f32x4*)(t_.src + (size_t)(t_.k0 + lr + 8 * i) * t_.N + t_.n0 + lc)); } while (0)
#define T_PARK(T) do { _Pragma("unroll") for (int i = 0; i < 8; ++i) *(LAS f32x4*)((T) + (lr + 8 * i) * T_STR + lc) = rg[i]; } while (0)
    int j = blockIdx.x;
    if (j < T_NJOBS) { T_LOAD(j); T_PARK(T0); }
    __syncthreads();
    for (int it = 0; j < T_NJOBS; j += gridDim.x, ++it) {
        const int jn = j + gridDim.x;
        if (jn < T_NJOBS) T_LOAD(jn);
        const TJob t = tjob(p, j);
        const LAS float* T = (it & 1) ? T1 : T0;
        {   const int n = tid >> 1, kh = tid & 1;
            float v[32];
#pragma unroll
            for (int i = 0; i < 32; ++i) v[i] = T[(32 * kh + i) * T_STR + n];
            if (t.fp8 == 1) {
                u32x4 w0, w1;
                w0.x = pk4_fp8(v[0] * W8_SCALE, v[1] * W8_SCALE, v[2] * W8_SCALE, v[3] * W8_SCALE); w0.y = pk4_fp8(v[4] * W8_SCALE, v[5] * W8_SCALE, v[6] * W8_SCALE, v[7] * W8_SCALE);
                w0.z = pk4_fp8(v[8] * W8_SCALE, v[9] * W8_SCALE, v[10] * W8_SCALE, v[11] * W8_SCALE); w0.w = pk4_fp8(v[12] * W8_SCALE, v[13] * W8_SCALE, v[14] * W8_SCALE, v[15] * W8_SCALE);
                w1.x = pk4_fp8(v[16] * W8_SCALE, v[17] * W8_SCALE, v[18] * W8_SCALE, v[19] * W8_SCALE); w1.y = pk4_fp8(v[20] * W8_SCALE, v[21] * W8_SCALE, v[22] * W8_SCALE, v[23] * W8_SCALE);
                w1.z = pk4_fp8(v[24] * W8_SCALE, v[25] * W8_SCALE, v[26] * W8_SCALE, v[27] * W8_SCALE); w1.w = pk4_fp8(v[28] * W8_SCALE, v[29] * W8_SCALE, v[30] * W8_SCALE, v[31] * W8_SCALE);
                unsigned char* d = t.dst + (size_t)(t.n0 + n) * t.K + t.k0 + 32 * kh;
                *(u32x4*)d = w0; *(u32x4*)(d + 16) = w1;
            } else {
                const int r = t.n0 + n;
                bf16_t* d = t.fp8 == 2 ? (bf16_t*)t.dst + ((size_t)(((r >> 4) * (t.K >> 5) + (t.k0 >> 5) + kh) * 64 + (r & 15))) * 8 : (bf16_t*)t.dst + (size_t)r * t.K + t.k0 + 32 * kh;
                const int qs = t.fp8 == 2 ? 128 : 8;
#pragma unroll
                for (int q = 0; q < 4; ++q) { u32x4 w; w.x = cvt_pk_bf16(v[8 * q], v[8 * q + 1]); w.y = cvt_pk_bf16(v[8 * q + 2], v[8 * q + 3]); w.z = cvt_pk_bf16(v[8 * q + 4], v[8 * q + 5]); w.w = cvt_pk_bf16(v[8 * q + 6], v[8 * q + 7]);
                    *(u32x4*)(d + qs * q) = w; }
            }
        }
        if (jn < T_NJOBS) { if (it & 1) T_PARK(T0); else T_PARK(T1); }
        __syncthreads();
    }
#undef T_LOAD
#undef T_PARK
}

namespace g8 {
constexpr int BM = 256, BK = 64, HALF = 128, HTB = HALF * BK * 2, STAGE_BYTES = 8 * HTB;
typedef int i32x8 __attribute__((ext_vector_type(8)));
typedef int i32x4v __attribute__((ext_vector_type(4)));
__device__ __forceinline__ int lds_byte(int r, int c) { const int st = (r >> 4) * 2 + (c >> 5), rr = r & 15, cc = c & 31, ob = rr * 64 + cc * 2; return st * 1024 + (ob ^ (((ob >> 9) & 1) << 5)); }
__device__ __forceinline__ void stage_rc(int b, int& R, int& C) { const int st = b / 1024, sb = b % 1024, swz = sb ^ (((sb >> 9) & 1) << 5); R = (st >> 1) * 16 + swz / 64; C = (st & 1) * 32 + (swz % 64) / 2; }
__device__ __forceinline__ int perm32(int rho) { const int n = rho >> 4, i = rho & 15; return 8 * (i >> 2) + 4 * n + (i & 3); }

struct Unit { int pm, pn, e, cnt; };

template <bool FP8, class Prob, class Epi>
__device__ __forceinline__ void gemm_phase(LAS unsigned char* lds, const Prob& S, const Epi& E) {
    constexpr int KB = FP8 ? 1024 : 2048, NT = KB / 128;
    const int tid = threadIdx.x, wid = __builtin_amdgcn_readfirstlane(tid >> 6), lane = tid & 63, wr = wid >> 2, wc = wid & 3, fr = lane & 15, fq = lane >> 4;
    unsigned voffB[2];
#pragma unroll
    for (int i = 0; i < 2; ++i) { int R, C; stage_rc(tid * 16 + i * 8192, R, C); const int Rb = Epi::COLMAP ? (64 * (R >> 5) + perm32(R & 31)) : (Epi::PERM ? ((R & ~31) + perm32(R & 31)) : R); voffB[i] = (unsigned)(Rb * KB + C * 2); }
#define G8_AOFF(dst, U) do { _Pragma("unroll") for (int i_ = 0; i_ < 2; ++i_) { int R_, C_; stage_rc(tid * 16 + i_ * 8192, R_, C_); \
        _Pragma("unroll") for (int h_ = 0; h_ < 2; ++h_) dst[h_][i_] = S.a_off(U, h_ * HALF + R_) + (unsigned)(C_ * 2); } } while (0)
    const unsigned ldsw = (unsigned)wid * 1024u;
    const int aoff = lds_byte(wr * 64 + fr, fq * 8), boff = lds_byte(wc * 32 + fr, fq * 8);
    const char* const Abase = S.Abase;
#define G8_SA(b, h) (((b) * 2 + (h)) * HTB)
#define G8_SB(b, h) ((4 + (b) * 2 + (h)) * HTB)
#define G8_GLDS(gp, bufoff, i) __builtin_amdgcn_global_load_lds((const unsigned*)(gp), (LAS unsigned*)(lds + (bufoff) + ldsw + (i) * 8192), 16, 0, 0)
#define G8_STA(bufoff, AO, h, kb) do { const char* ak_ = Abase + (kb); G8_GLDS(ak_ + (AO)[h][0], bufoff, 0); G8_GLDS(ak_ + (AO)[h][1], bufoff, 1); } while (0)
#define G8_STB(bufoff, bp) do { G8_GLDS((bp) + voffB[0], bufoff, 0); G8_GLDS((bp) + voffB[1], bufoff, 1); } while (0)
#define G8_LDA(dst, b, h) do { _Pragma("unroll") for (int m = 0; m < 4; ++m) _Pragma("unroll") for (int k = 0; k < 2; ++k) dst[m][k] = *(const LAS bf16x8*)(lds + G8_SA(b, h) + aoff + m * 2048 + k * 1024); } while (0)
#define G8_LDB(dst, b, h) do { _Pragma("unroll") for (int n = 0; n < 2; ++n) _Pragma("unroll") for (int k = 0; k < 2; ++k) dst[n][k] = *(const LAS bf16x8*)(lds + G8_SB(b, h) + boff + n * 2048 + k * 1024); } while (0)
#define G8_MMA(ai, bj, At, Bt) do { __builtin_amdgcn_s_setprio(1); \
        if (FP8) { i32x8 wf_[2], xf_[4]; \
            _Pragma("unroll") for (int n = 0; n < 2; ++n) wf_[n] = __builtin_shufflevector(__builtin_bit_cast(i32x4v, Bt[n][0]), __builtin_bit_cast(i32x4v, Bt[n][1]), 0, 1, 2, 3, 4, 5, 6, 7); \
            _Pragma("unroll") for (int m = 0; m < 4; ++m) xf_[m] = __builtin_shufflevector(__builtin_bit_cast(i32x4v, At[m][0]), __builtin_bit_cast(i32x4v, At[m][1]), 0, 1, 2, 3, 4, 5, 6, 7); \
            asm volatile("s_nop 1" ::: "memory"); \
            _Pragma("unroll") for (int m = 0; m < 4; ++m) _Pragma("unroll") for (int n = 0; n < 2; ++n) \
                asm volatile("v_mfma_f32_16x16x128_f8f6f4 %0, %1, %2, %0" : "+v"(acc[ai][bj][m][n]) : "v"(wf_[n]), "v"(xf_[m])); } \
        else { _Pragma("unroll") for (int m = 0; m < 4; ++m) _Pragma("unroll") for (int n = 0; n < 2; ++n) _Pragma("unroll") for (int k = 0; k < 2; ++k) \
            acc[ai][bj][m][n] = __builtin_amdgcn_mfma_f32_16x16x32_bf16(Bt[n][k], At[m][k], acc[ai][bj][m][n], 0, 0, 0); } \
        __builtin_amdgcn_s_setprio(0); } while (0)
#define G8_WAIT_V(n) asm volatile("s_waitcnt vmcnt(" #n ")" ::: "memory")
#define G8_WAIT_L(n) asm volatile("s_waitcnt lgkmcnt(" #n ")" ::: "memory")
#define G8_BAR __builtin_amdgcn_s_barrier()
#define G8_SCHED __builtin_amdgcn_sched_barrier(0)
    Unit cur, nxt; int ui = 0;
    if (!S.next(0, cur)) return;
    f32x4 acc[2][2][4][2];
#pragma unroll
    for (int a = 0; a < 2; ++a)
#pragma unroll
        for (int b = 0; b < 2; ++b)
#pragma unroll
            for (int m = 0; m < 4; ++m)
#pragma unroll
                for (int n = 0; n < 2; ++n) acc[a][b][m][n] = (f32x4){0.f, 0.f, 0.f, 0.f};
    bf16x8 At[4][2], B0[2][2], B1[2][2];
    unsigned ao[2][2], nao[2][2];
    G8_AOFF(ao, cur);
    const char* cB[2] = {S.template b_ptr<Epi::COLMAP>(cur, 0), S.template b_ptr<Epi::COLMAP>(cur, 1)};
    G8_STB(G8_SB(0, 0), cB[0]); G8_STA(G8_SA(0, 0), ao, 0, 0); G8_STB(G8_SB(0, 1), cB[1]); G8_STA(G8_SA(0, 1), ao, 1, 0);
    if (wr == 1) G8_BAR;
    G8_WAIT_V(4); G8_BAR;
    G8_STB(G8_SB(1, 0), cB[0] + 128); G8_STA(G8_SA(1, 0), ao, 0, 128); G8_STB(G8_SB(1, 1), cB[1] + 128);
    G8_WAIT_V(6); G8_BAR;
    for (;;) {
        E.prefetch(cur, lds + STAGE_BYTES + wid * 2048, wid, lane);
        const bool has_next = S.next(ui + 1, nxt);
        const char* nB[2];
        if (has_next) {
            G8_AOFF(nao, nxt);
            nB[0] = S.template b_ptr<Epi::COLMAP>(nxt, 0); nB[1] = S.template b_ptr<Epi::COLMAP>(nxt, 1);
        } else {
#pragma unroll
            for (int h = 0; h < 2; ++h)
#pragma unroll
                for (int i = 0; i < 2; ++i) nao[h][i] = ao[h][i];
            nB[0] = cB[0]; nB[1] = cB[1];
        }
#pragma nounroll
        for (int t = 0; t < NT; t += 2) {
            const bool last = (t == NT - 2);
            const int kb1 = (t + 1) * 128, kb2 = last ? 0 : (t + 2) * 128;
            unsigned a2[2][2];
#pragma unroll
            for (int h = 0; h < 2; ++h)
#pragma unroll
                for (int i = 0; i < 2; ++i) a2[h][i] = last ? nao[h][i] : ao[h][i];
            const char* b20 = last ? nB[0] : cB[0] + (t + 2) * 128; const char* b21 = last ? nB[1] : cB[1] + (t + 2) * 128;
            G8_LDB(B0, 0, 0); G8_SCHED; G8_LDA(At, 0, 0); G8_STA(G8_SA(1, 1), ao, 1, kb1);
            G8_WAIT_L(8); G8_BAR; G8_WAIT_L(0); G8_MMA(0, 0, At, B0); G8_BAR; G8_SCHED;
            G8_LDB(B1, 0, 1); G8_STB(G8_SB(0, 0), b20);
            G8_BAR; G8_WAIT_L(0); G8_MMA(0, 1, At, B1); G8_BAR;
            G8_LDA(At, 0, 1); G8_STA(G8_SA(0, 0), a2, 0, kb2);
            G8_BAR; G8_WAIT_L(0); G8_MMA(1, 0, At, B0); G8_BAR; G8_SCHED;
            G8_STB(G8_SB(0, 1), b21);
            G8_WAIT_V(6); G8_BAR; G8_MMA(1, 1, At, B1); G8_BAR;
            G8_LDB(B0, 1, 0); G8_SCHED; G8_LDA(At, 1, 0); G8_STA(G8_SA(0, 1), a2, 1, kb2);
            G8_WAIT_L(8); G8_BAR; G8_WAIT_L(0); G8_MMA(0, 0, At, B0); G8_BAR; G8_SCHED;
            G8_LDB(B1, 1, 1); G8_STB(G8_SB(1, 0), b20 + 128);
            G8_BAR; G8_WAIT_L(0); G8_MMA(0, 1, At, B1); G8_BAR;
            G8_LDA(At, 1, 1); G8_STA(G8_SA(1, 0), a2, 0, kb2 + 128);
            G8_BAR; G8_WAIT_L(0); G8_MMA(1, 0, At, B0); G8_BAR; G8_SCHED;
            G8_STB(G8_SB(1, 1), b21 + 128);
            G8_WAIT_V(6); G8_BAR; G8_MMA(1, 1, At, B1); G8_BAR;
        }
        if (FP8) asm volatile("s_nop 15\n\ts_nop 15" ::: "memory");
        E(acc, cur, wr, wc, fr, fq, lds + STAGE_BYTES + wid * 2048);
        if (!has_next) break;
#pragma unroll
        for (int a = 0; a < 2; ++a)
#pragma unroll
            for (int b = 0; b < 2; ++b)
#pragma unroll
                for (int m = 0; m < 4; ++m)
#pragma unroll
                    for (int n = 0; n < 2; ++n) acc[a][b][m][n] = (f32x4){0.f, 0.f, 0.f, 0.f};
        cur = nxt; cB[0] = nB[0]; cB[1] = nB[1]; ++ui;
#pragma unroll
        for (int h = 0; h < 2; ++h)
#pragma unroll
            for (int i = 0; i < 2; ++i) ao[h][i] = nao[h][i];
    }
    G8_WAIT_V(0);
    if (wr == 0) G8_BAR;
    G8_BAR;
#undef G8_SA
#undef G8_AOFF
#undef G8_SB
#undef G8_GLDS
#undef G8_STA
#undef G8_STB
#undef G8_LDA
#undef G8_LDB
#undef G8_MMA
#undef G8_WAIT_V
#undef G8_WAIT_L
#undef G8_BAR
#undef G8_SCHED
}

struct DenseProb {
    const char* Abase; const char* Bt; int nM, nN, nwg, G, c;
    __device__ __forceinline__ void init(const void* A, const void* B, int M, int N, int G_, int c_) { Abase = (const char*)A; Bt = (const char*)B; nM = M / BM; nN = N / BM; nwg = nM * nN; G = G_; c = c_; }
    __device__ __forceinline__ bool next(int i, Unit& u) const {
        const long L = (long)i * G + c; if (L >= nwg) return false;
        int wgid = (int)L; { const int q = nwg / 8, r = nwg % 8, xcd = wgid % 8, off = wgid / 8; wgid = (xcd < r ? xcd * (q + 1) : r * (q + 1) + (xcd - r) * q) + off; }
        const int nig = 8 * nN, gid = wgid / nig, fm = gid * 8, gsz = (nM - fm) < 8 ? (nM - fm) : 8;
        u.pm = fm + ((wgid % nig) % gsz); u.pn = (wgid % nig) / gsz; u.e = 0; u.cnt = 256; return true;
    }
    __device__ __forceinline__ unsigned a_off(const Unit& u, int row) const { return (unsigned)(u.pm * BM + row) * 2048u; }
    template <bool CM> __device__ __forceinline__ const char* b_ptr(const Unit& u, int half) const { return Bt + (size_t)(u.pn * BM + half * (CM ? 32 : HALF)) * 2048; }
};
}

struct EpiZ {
    static constexpr bool PERM = true, COLMAP = true;
    bf16_t* O;
    __device__ __forceinline__ void prefetch(const g8::Unit&, LAS unsigned char*, int, int) const {}
    __device__ __forceinline__ void operator()(const f32x4 (&acc)[2][2][4][2], const g8::Unit& u, int wr, int wc, int fr, int fq, LAS unsigned char*) const {
        const bool odd = (fr & 1) != 0;
        const int rowA = u.pm * 256 + wr * 64 + (fr & ~1), colS = u.pn * 256 + wc * 64 + 8 * fq + (odd ? 32 : 0);
#pragma unroll
        for (int ai = 0; ai < 2; ++ai)
#pragma unroll
            for (int m = 0; m < 4; ++m) { bf16_t* rowp = O + (size_t)(rowA + ai * 128 + m * 16) * INW + colS;
                u32x4 w[2];
#pragma unroll
                for (int bj = 0; bj < 2; ++bj) { const f32x4 v0 = acc[ai][bj][m][0], v1 = acc[ai][bj][m][1];
                    w[bj].x = cvt_pk_bf16(v0[0], v0[1]); w[bj].y = cvt_pk_bf16(v0[2], v0[3]); w[bj].z = cvt_pk_bf16(v1[0], v1[1]); w[bj].w = cvt_pk_bf16(v1[2], v1[3]); }
                const u32x4 snd = odd ? w[0] : w[1]; const u32x4 rcv = xchg1(snd);
                *(u32x4*)rowp = odd ? rcv : w[0]; *(u32x4*)(rowp + INW) = odd ? w[1] : rcv; }
    }
};
struct EpiX1 {
    static constexpr bool PERM = true, COLMAP = true;
    const float* X; bf16_t* O;
    __device__ __forceinline__ void prefetch(const g8::Unit&, LAS unsigned char*, int, int) const {}
    __device__ __forceinline__ void operator()(const f32x4 (&acc)[2][2][4][2], const g8::Unit& u, int wr, int wc, int fr, int fq, LAS unsigned char*) const {
        const bool odd = (fr & 1) != 0;
        const int row0 = u.pm * 256 + wr * 64 + fr, col0 = u.pn * 256 + wc * 64 + 8 * fq;
        const int rowA = u.pm * 256 + wr * 64 + (fr & ~1), colS = col0 + (odd ? 32 : 0);
#pragma unroll
        for (int ai = 0; ai < 2; ++ai) {
            f32x4 xv[4][2][2];
#pragma unroll
            for (int m = 0; m < 4; ++m) { const size_t off = (size_t)(row0 + ai * 128 + m * 16) * DM + col0;
#pragma unroll
                for (int bj = 0; bj < 2; ++bj) { xv[m][bj][0] = *(const f32x4*)(X + off + bj * 32); xv[m][bj][1] = *(const f32x4*)(X + off + bj * 32 + 4); } }
#pragma unroll
            for (int m = 0; m < 4; ++m) { bf16_t* rowp = O + (size_t)(rowA + ai * 128 + m * 16) * DM + colS;
                u32x4 w[2];
#pragma unroll
                for (int bj = 0; bj < 2; ++bj) { const f32x4 v0 = xv[m][bj][0] + acc[ai][bj][m][0], v1 = xv[m][bj][1] + acc[ai][bj][m][1];
                    w[bj].x = cvt_pk_bf16(v0[0], v0[1]); w[bj].y = cvt_pk_bf16(v0[2], v0[3]); w[bj].z = cvt_pk_bf16(v1[0], v1[1]); w[bj].w = cvt_pk_bf16(v1[2], v1[3]); }
                const u32x4 snd = odd ? w[0] : w[1]; const u32x4 rcv = xchg1(snd);
                *(u32x4*)rowp = odd ? rcv : w[0]; *(u32x4*)(rowp + DM) = odd ? w[1] : rcv; }
            asm volatile("" ::: "memory");
        }
    }
};

__device__ __forceinline__ f32x4 ld_bf4(const bf16_t* p) { const u32x2 w = *(const u32x2*)p; return (f32x4){bf_lo(w.x), bf_hi(w.x), bf_lo(w.y), bf_hi(w.y)}; }
__device__ __forceinline__ void ld_bf8(const bf16_t* p, float (&o)[8]) { const u32x4 w = *(const u32x4*)p; o[0] = bf_lo(w.x); o[1] = bf_hi(w.x); o[2] = bf_lo(w.y); o[3] = bf_hi(w.y); o[4] = bf_lo(w.z); o[5] = bf_hi(w.z); o[6] = bf_lo(w.w); o[7] = bf_hi(w.w); }
__device__ __forceinline__ void rwkv_lora_act(const Params& p) {
    const bf16_t* z = (const bf16_t*)(p.ws + WS_Z); bf16_t* act = (bf16_t*)(p.ws + WS_LACT);
    const int sub = threadIdx.x & 31;
    const int col = 8 * sub;
    const f32x4 m0 = *(const f32x4*)(p.shift_mu + 1536 + col), m1 = *(const f32x4*)(p.shift_mu + 1536 + col + 4);
    for (int tok0 = blockIdx.x * 16 + (threadIdx.x >> 5); tok0 < NTOK; tok0 += gridDim.x * 64) {
        u32x4 cw[4], pw[4];
#pragma unroll
        for (int q = 0; q < 4; ++q) { const int tok = tok0 + q * gridDim.x * 16; const bf16_t* zt = z + (size_t)tok * INW + 3072 + col;
            cw[q] = *(const u32x4*)zt; pw[q] = *(const u32x4*)(zt - ((tok & (SEQ - 1)) != 0 ? INW : 0)); }
#pragma unroll
        for (int q = 0; q < 4; ++q) { const int tok = tok0 + q * gridDim.x * 16;
            const float hm = (tok & (SEQ - 1)) != 0 ? 1.0f : 0.0f;
            const float c[8] = {bf_lo(cw[q].x), bf_hi(cw[q].x), bf_lo(cw[q].y), bf_hi(cw[q].y), bf_lo(cw[q].z), bf_hi(cw[q].z), bf_lo(cw[q].w), bf_hi(cw[q].w)};
            const float pv[8] = {bf_lo(pw[q].x), bf_hi(pw[q].x), bf_lo(pw[q].y), bf_hi(pw[q].y), bf_lo(pw[q].z), bf_hi(pw[q].z), bf_lo(pw[q].w), bf_hi(pw[q].w)};
            float v[8];
#pragma unroll
            for (int j = 0; j < 8; ++j) { const float mm = j < 4 ? m0[j] : m1[j - 4]; float x = c[j] + (pv[j] * hm - c[j]) * mm;
                if (col < 64) x = ftanh(x); else if (col >= 128) x = sigmoidf_(x); v[j] = x; }
            u32x4 w; w.x = cvt_pk_bf16(v[0], v[1]); w.y = cvt_pk_bf16(v[2], v[3]); w.z = cvt_pk_bf16(v[4], v[5]); w.w = cvt_pk_bf16(v[6], v[7]);
            *(u32x4*)(act + (size_t)tok * 256 + col) = w; }
    }
}
constexpr int C_MUR = 256, C_MUK = 320, C_MUV = 384, C_DB = 448, C_IB = 512, C_KK = 576, C_KA = 640, C_RK = 704, C_LW = 768, C_LB = 832, C_N = 896;
__device__ __forceinline__ f32x4 up4(u32x2 w) { return (f32x4){bf_lo(w.x), bf_hi(w.x), bf_lo(w.y), bf_hi(w.y)}; }
__device__ __forceinline__ f32x4 lerp4r(u32x2 cur, u32x2 prv, float hm, f32x4 m) { const f32x4 c = up4(cur); return c + (up4(prv) * hm - c) * m; }
constexpr int CK = 16, NIV = SEQ / (CK * 8);
constexpr int CS = 72;
constexpr int SL_VV = 0, SL_RH = 2304, SL_BB = 4608, SL_KB = 6912, SL_AB = 9216  , SL_WT = 12288  , SL_ABR = 14336, SL_AKR = 14848, SL_GC = 15360  ,
              SL_Y = 15616  , SL_SIZE = 17920;
constexpr int RC_CST = 8 * SL_SIZE;
static_assert(RC_CST + C_N * 4 <= 159 * 1024, "chunked rwkv lds");
typedef short s16x4v __attribute__((ext_vector_type(4)));
typedef __bf16 bf16x2t __attribute__((ext_vector_type(2)));
__device__ __forceinline__ unsigned pkv(float lo, float hi) { return __builtin_bit_cast(unsigned, __builtin_convertvector((f32x2){lo, hi}, bf16x2t)); }
__device__ __forceinline__ s16x4v pk4(f32x4 v) { u32x2 w; w.x = pkv(v[0], v[1]); w.y = pkv(v[2], v[3]); return __builtin_bit_cast(s16x4v, w); }
__device__ __forceinline__ f32x4 mm16(s16x4v a, s16x4v b, f32x4 c) { return __builtin_amdgcn_mfma_f32_16x16x16bf16_1k(a, b, c, 0, 0, 0); }
__device__ __forceinline__ s16x4v trread(unsigned addr) { s16x4v r; asm volatile("ds_read_b64_tr_b16 %0, %1\n\ts_waitcnt lgkmcnt(0)" : "=&v"(r) : "v"(addr) : "memory"); return r; }
template <int SH> __device__ __forceinline__ float dpp_shr(float v) { return __int_as_float(__builtin_amdgcn_update_dpp(0, __float_as_int(v), 0x110 + SH, 0xf, 0xf, true)); }

__device__ __forceinline__ void phase_rwkv(const Params& p, LAS unsigned char* lds) {
    const int tid = threadIdx.x, wid = __builtin_amdgcn_readfirstlane(tid >> 6), lane0 = tid & 63;
    const bf16_t* z = (const bf16_t*)(p.ws + WS_Z); const bf16_t* act = (const bf16_t*)(p.ws + WS_LACT);
    const bf16_t* decT = (const bf16_t*)(p.ws + WS_DECUP); const bf16_t* iclT = (const bf16_t*)(p.ws + WS_ICLUP); const bf16_t* gatT = (const bf16_t*)(p.ws + WS_GATUP);
    const f32x4 zero4 = (f32x4){0.f, 0.f, 0.f, 0.f};
    for (int bh = blockIdx.x; bh < 256; bh += gridDim.x) {
        const int b = bh >> 3, h = bh & 7;
        {
            LAS float* C = (LAS float*)(lds + RC_CST);
            for (int i = tid; i < C_N; i += 512) {
                float v;
                if (i < 256) v = 0.f;
                else if (i < 320) v = p.shift_mu[64 * h + (i - 256)];
                else if (i < 384) v = p.shift_mu[512 + 64 * h + (i - 320)];
                else if (i < 448) v = p.shift_mu[1024 + 64 * h + (i - 384)];
                else if (i < 512) v = p.decay_bias[64 * h + (i - 448)];
                else if (i < 576) v = p.iclr_bias[64 * h + (i - 512)];
                else if (i < 640) v = p.k_k[64 * h + (i - 576)];
                else if (i < 704) v = p.k_a[64 * h + (i - 640)];
                else if (i < 768) v = p.r_k[64 * h + (i - 704)];
                else if (i < 832) v = p.lnx_w[64 * h + (i - 768)];
                else v = p.lnx_b[64 * h + (i - 832)];
                C[i] = v;
            }
        }
        __syncthreads();
        const LAS float* CS_ = (const LAS float*)(lds + RC_CST);
        LAS unsigned char* slot = lds + wid * SL_SIZE;
        f32x4 ST[4] = {zero4, zero4, zero4, zero4};
        u32x4 zw[7];
#define RW_LOADZ(iv_, lane_, I0, I1) do { const int t0_ = CK * ((iv_) * 8 + wid); \
            _Pragma("unroll") for (int i = I0; i < I1; ++i) { const int idx_ = 64 * i + (lane_); int pz_ = idx_ >> 3; pz_ = pz_ > 50 ? 50 : pz_; const int a_ = pz_ >= 34 ? 2 : (pz_ >= 17 ? 1 : 0); \
                int tr_ = t0_ - 1 + pz_ - 17 * a_; tr_ = tr_ < 0 ? 0 : tr_; \
                zw[i] = *(const u32x4*)(z + (size_t)(b * SEQ + tr_) * INW + RW_OFF + 64 * h + 512 * a_ + 8 * (idx_ & 7)); } } while (0)
        RW_LOADZ(0, lane0, 0, 5);
#pragma nounroll
        for (int iv = 0; iv < NIV; ++iv) {
            int lane = lane0; asm volatile("" : "+v"(lane));
            const int n = lane & 15, g = lane >> 4;
            const int c = iv * 8 + wid, t = CK * c + n;
            f32x4 gate4[4], v4[4]; float bonus;
            {
                const bf16_t* zt = z + (size_t)(b * SEQ + t) * INW; const bf16_t* zp = zt - (t > 0 ? INW : 0);
                const float hm = t > 0 ? 1.0f : 0.0f;
                const bf16_t* at = act + (size_t)(b * SEQ + t) * 256 + 8 * g;
                const bf16_t* bt = zt + RW_OFF + 64 * h + 4 * g; const bf16_t* bp = zp + RW_OFF + 64 * h + 4 * g;
                f32x4 r4[4], k4[4], lw4[4], an4[4], bn4[4], kn4[4]; float ssq = 0.f;
                bf16x8 xw_[2], xa_[2], xg_[4];
#pragma unroll
                for (int s2 = 0; s2 < 2; ++s2) { xw_[s2] = *(const bf16x8*)(at + 32 * s2); xa_[s2] = *(const bf16x8*)(at + 64 + 32 * s2); }
#pragma unroll
                for (int s2 = 0; s2 < 4; ++s2) xg_[s2] = *(const bf16x8*)(at + 128 + 32 * s2);
                RW_LOADZ(iv, lane, 5, 7);
#define RW_PARK(I0, I1) do { _Pragma("unroll") for (int i = I0; i < I1; ++i) { const int idx = 64 * i + lane; int pz = idx >> 3; pz = pz > 50 ? 50 : pz; *(LAS u32x4*)(slot + pz * 144 + (idx & 7) * 16) = zw[i]; } } while (0)
                RW_PARK(0, 5);
                asm volatile("s_waitcnt lgkmcnt(0)" ::: "memory");
                const LAS unsigned char* zs = slot + n * 144 + 8 * g;
                u32x2 zk[4][2];
#pragma unroll
                for (int ct = 0; ct < 4; ++ct) { zk[ct][1] = *(const LAS u32x2*)(zs + 17 * 144 + 32 * ct); zk[ct][0] = *(const LAS u32x2*)(zs + 18 * 144 + 32 * ct); }
                bf16x8 wD[2][4];
#pragma unroll
                for (int s2 = 0; s2 < 2; ++s2)
#pragma unroll
                    for (int ct = 0; ct < 4; ++ct) wD[s2][ct] = *(const bf16x8*)(decT + (size_t)(((4 * h + ct) * 2 + s2) * 64 + lane) * 8);
                asm volatile("" ::: "memory");
#pragma unroll
                for (int ct = 0; ct < 4; ++ct) { const int cl = 16 * ct + 4 * g;
                    k4[ct] = lerp4r(zk[ct][0], zk[ct][1], hm, *(const LAS f32x4*)(CS_ + C_MUK + cl));
                    const f32x4 kk4 = k4[ct] * *(const LAS f32x4*)(CS_ + C_KK + cl); ssq += (kk4[0] * kk4[0] + kk4[1] * kk4[1]) + (kk4[2] * kk4[2] + kk4[3] * kk4[3]); }
                ssq += __shfl_xor(ssq, 16); ssq += __shfl_xor(ssq, 32);
                const float inv = frcp(fmaxf(sqrtf(ssq), 1e-12f));
                bf16x8 wI[2][4];
                {   f32x4 aw[4] = {zero4, zero4, zero4, zero4};
#pragma unroll
                    for (int s2 = 0; s2 < 2; ++s2) { const bf16x8 xw = xw_[s2];
#pragma unroll
                        for (int ct = 0; ct < 4; ++ct) aw[ct] = __builtin_amdgcn_mfma_f32_16x16x32_bf16(wD[s2][ct], xw, aw[ct], 0, 0, 0); }
#pragma unroll
                    for (int s2 = 0; s2 < 2; ++s2)
#pragma unroll
                        for (int ct = 0; ct < 4; ++ct) wI[s2][ct] = *(const bf16x8*)(iclT + (size_t)(((4 * h + ct) * 2 + s2) * 64 + lane) * 8);
                    asm volatile("" ::: "memory");
#pragma unroll
                    for (int ct = 0; ct < 4; ++ct) { const f32x4 db = *(const LAS f32x4*)(CS_ + C_DB + 16 * ct + 4 * g);
#pragma unroll
                        for (int i = 0; i < 4; ++i) { const float xm = -(db[i] + aw[ct][i]), sp = fmaxf(xm, 0.f) + 0.6931471805599453f * __builtin_amdgcn_logf(1.0f + fexp(-fabsf(xm))); lw4[ct][i] = -fexp(-sp - 0.5f); } } }
                asm volatile("" ::: "memory");
                float bon = 0.f;
                {   f32x4 aa[4] = {zero4, zero4, zero4, zero4};
#pragma unroll
                    for (int s2 = 0; s2 < 2; ++s2) { const bf16x8 xa = xa_[s2];
#pragma unroll
                        for (int ct = 0; ct < 4; ++ct) aa[ct] = __builtin_amdgcn_mfma_f32_16x16x32_bf16(wI[s2][ct], xa, aa[ct], 0, 0, 0); }
#pragma unroll
                    for (int ct = 0; ct < 4; ++ct) { const int cl = 16 * ct + 4 * g;
                        r4[ct] = lerp4r(*(const LAS u32x2*)(zs + 144 + 32 * ct), *(const LAS u32x2*)(zs + 32 * ct), hm, *(const LAS f32x4*)(CS_ + C_MUR + cl));
                        const f32x4 ib = *(const LAS f32x4*)(CS_ + C_IB + cl), kkw = *(const LAS f32x4*)(CS_ + C_KK + cl), kaw = *(const LAS f32x4*)(CS_ + C_KA + cl), rkw = *(const LAS f32x4*)(CS_ + C_RK + cl);
#pragma unroll
                        for (int i = 0; i < 4; ++i) { const float a = sigmoidf_(ib[i] + aa[ct][i]); const float kk = k4[ct][i] * kkw[i] * inv;
                            kn4[ct][i] = k4[ct][i] * (1.0f + (a - 1.0f) * kaw[i]); an4[ct][i] = -kk; bn4[ct][i] = kk * a; bon += r4[ct][i] * kn4[ct][i] * rkw[i]; } } }
                bon += __shfl_xor(bon, 16); bon += __shfl_xor(bon, 32); bonus = bon;
                asm volatile("" ::: "memory");
                RW_PARK(5, 7);
                asm volatile("s_waitcnt lgkmcnt(0)" ::: "memory");
#pragma unroll
                for (int ct = 0; ct < 4; ++ct) v4[ct] = lerp4r(*(const LAS u32x2*)(zs + 35 * 144 + 32 * ct), *(const LAS u32x2*)(zs + 34 * 144 + 32 * ct), hm, *(const LAS f32x4*)(CS_ + C_MUV + 16 * ct + 4 * g));
                asm volatile("s_waitcnt lgkmcnt(0)" ::: "memory");
                f32x4 lg4[4];
#pragma unroll
                for (int ct = 0; ct < 4; ++ct)
#pragma unroll
                    for (int i = 0; i < 4; ++i) { float x = lw4[ct][i]; x += dpp_shr<1>(x); x += dpp_shr<2>(x); x += dpp_shr<4>(x); x += dpp_shr<8>(x); lg4[ct][i] = x; }
                s16x4v fAh[4], fBh[4], fKh[4], fRh[4];
                LAS bf16_t* imVV = (LAS bf16_t*)(slot + SL_VV); LAS bf16_t* imRH = (LAS bf16_t*)(slot + SL_RH); LAS bf16_t* imBB = (LAS bf16_t*)(slot + SL_BB); LAS bf16_t* imKB = (LAS bf16_t*)(slot + SL_KB); LAS bf16_t* imAH = (LAS bf16_t*)(slot + SL_Y);
#pragma unroll
                for (int ct = 0; ct < 4; ++ct) { f32x4 gg, gp, gi, gr, gc;
#pragma unroll
                    for (int i = 0; i < 4; ++i) { gg[i] = fexp(lg4[ct][i]); gi[i] = frcp(gg[i]); const float sh = dpp_shr<1>(gg[i]); gp[i] = n == 0 ? 1.0f : sh;
                        gc[i] = __shfl(gg[i], (lane & 48) | 15); gr[i] = gc[i] * gi[i]; }
                    fAh[ct] = pk4(an4[ct] * gp); fBh[ct] = pk4(bn4[ct] * gi); fKh[ct] = pk4(kn4[ct] * gi); fRh[ct] = pk4(r4[ct] * gg);
                    const int o = n * CS + 16 * ct + 4 * g;
                    *(LAS s16x4v*)(imAH + o) = fAh[ct]; *(LAS s16x4v*)(imRH + o) = fRh[ct]; *(LAS s16x4v*)(imVV + o) = pk4(v4[ct]);
                    *(LAS s16x4v*)(imBB + o) = pk4(bn4[ct] * gr); *(LAS s16x4v*)(imKB + o) = pk4(kn4[ct] * gr);
                    if (n == 15) *(LAS f32x4*)(slot + SL_GC + (16 * ct + 4 * g) * 4) = gc; }
                bf16x8 wG[4][4];
#pragma unroll
                for (int s2 = 0; s2 < 4; ++s2)
#pragma unroll
                    for (int ct = 0; ct < 4; ++ct) wG[s2][ct] = *(const bf16x8*)(gatT + (size_t)(((4 * h + ct) * 4 + s2) * 64 + lane) * 8);
                asm volatile("" ::: "memory");
                f32x4 dA = zero4, dAt = zero4, dKbT = zero4, dBr = zero4, dKr = zero4;
#pragma unroll
                for (int ct = 0; ct < 4; ++ct) { dA = mm16(fBh[ct], fAh[ct], dA); dAt = mm16(fAh[ct], fBh[ct], dAt); dKbT = mm16(fAh[ct], fKh[ct], dKbT); dBr = mm16(fBh[ct], fRh[ct], dBr); dKr = mm16(fKh[ct], fRh[ct], dKr); }
                f32x4 idn;
#pragma unroll
                for (int i = 0; i < 4; ++i) { const int m = 4 * g + i;
                    dA[i] = m < n ? dA[i] : 0.f; dAt[i] = n < m ? dAt[i] : 0.f; dKbT[i] = n < m ? dKbT[i] : 0.f; dBr[i] = m <= n ? dBr[i] : 0.f; dKr[i] = m <= n ? dKr[i] : 0.f; idn[i] = m == n ? 1.0f : 0.f; }
                const s16x4v pA = pk4(dA), pAt = pk4(dAt);
                const f32x4 dA2 = mm16(pAt, pA, zero4), dA2t = mm16(pA, pAt, zero4);
                const s16x4v pA2 = pk4(dA2), pA2t = pk4(dA2t);
                const f32x4 dA4 = mm16(pA2t, pA2, zero4), dA4t = mm16(pA2, pA2t, zero4);
                const s16x4v pA4 = pk4(dA4), pA4t = pk4(dA4t);
                const f32x4 dA8 = mm16(pA4t, pA4, zero4);
                const f32x4 dT1 = mm16(pAt, pA2, idn + dA + dA2), dT1t = mm16(pA2, pAt, idn + dAt + dA2t);
                const s16x4v pT1 = pk4(dT1), pT1t = pk4(dT1t);
                const f32x4 dT2 = mm16(pT1t, pA4, dT1), dT2t = mm16(pA4, pT1t, dT1t);
                const f32x4 dT = mm16(pk4(dT2t), pk4(dA8), dT2);
                const s16x4v pT = pk4(dT);
                const f32x4 dX = mm16(pk4(dKbT), pT, zero4);
                const s16x4v pX = pk4(dX);
                *(LAS s16x4v*)(slot + SL_ABR + lane * 8) = pk4(dBr); *(LAS s16x4v*)(slot + SL_AKR + lane * 8) = pk4(dKr);
                asm volatile("s_waitcnt lgkmcnt(0)" ::: "memory");
                const unsigned aAH = (unsigned)(size_t)(imAH + (4 * g + (n >> 2)) * CS + 4 * (n & 3)), aVV = (unsigned)(size_t)(imVV + (4 * g + (n >> 2)) * CS + 4 * (n & 3));
#pragma unroll
                for (int jt = 0; jt < 4; ++jt) {
                    const f32x4 d = mm16(pT, trread(aAH + 32 * jt), zero4);
                    *(LAS s16x4v*)(slot + SL_AB + ((16 * jt + n) * 24 + 4 * g) * 2) = pk4(d); }
#pragma unroll
                for (int it = 0; it < 4; ++it) {
                    const f32x4 d = mm16(pX, trread(aVV + 32 * it), zero4);
                    *(LAS s16x4v*)(slot + SL_WT + (it * 64 + lane) * 8) = pk4(d); }
                asm volatile("" ::: "memory");
                gate4[0] = zero4; gate4[1] = zero4; gate4[2] = zero4; gate4[3] = zero4;
#pragma unroll
                for (int s2 = 0; s2 < 4; ++s2) { const bf16x8 xg = xg_[s2];
#pragma unroll
                    for (int ct = 0; ct < 4; ++ct) gate4[ct] = __builtin_amdgcn_mfma_f32_16x16x32_bf16(wG[s2][ct], xg, gate4[ct], 0, 0, 0); }
            }
            __syncthreads();
            if (iv + 1 < NIV) RW_LOADZ(iv + 1, lane, 0, 5);
            if (wid < 4) {
                const int it = wid;
                struct Ops { s16x4v ab[4], bb[4], kb[4], vf, rh[4], abr, akr; u32x2 wt; f32x4 gc[4]; };
                const unsigned oAB = (unsigned)(size_t)(lds + SL_AB + ((4 * g + (n >> 2)) * 24 + 4 * (n & 3)) * 2);
                const unsigned oBB = (unsigned)(size_t)((LAS bf16_t*)(lds + SL_BB) + (4 * g + (n >> 2)) * CS + 4 * (n & 3));
                const unsigned oKB = (unsigned)(size_t)((LAS bf16_t*)(lds + SL_KB) + (4 * g + (n >> 2)) * CS + 4 * (n & 3));
                const unsigned oVV = (unsigned)(size_t)((LAS bf16_t*)(lds + SL_VV) + (4 * g + (n >> 2)) * CS + 16 * it + 4 * (n & 3));
#define CH_ISSUE(P, sl_) do { const unsigned so_ = (unsigned)((sl_) * SL_SIZE); LAS unsigned char* S8 = lds + (sl_) * SL_SIZE; \
                    asm volatile("ds_read_b64_tr_b16 %0, %13\n\tds_read_b64_tr_b16 %1, %13 offset:768\n\tds_read_b64_tr_b16 %2, %13 offset:1536\n\tds_read_b64_tr_b16 %3, %13 offset:2304\n\t" \
                                 "ds_read_b64_tr_b16 %4, %14\n\tds_read_b64_tr_b16 %5, %14 offset:32\n\tds_read_b64_tr_b16 %6, %14 offset:64\n\tds_read_b64_tr_b16 %7, %14 offset:96\n\t" \
                                 "ds_read_b64_tr_b16 %8, %15\n\tds_read_b64_tr_b16 %9, %15 offset:32\n\tds_read_b64_tr_b16 %10, %15 offset:64\n\tds_read_b64_tr_b16 %11, %15 offset:96\n\t" \
                                 "ds_read_b64_tr_b16 %12, %16" \
                                 : "=&v"(P.ab[0]), "=&v"(P.ab[1]), "=&v"(P.ab[2]), "=&v"(P.ab[3]), "=&v"(P.bb[0]), "=&v"(P.bb[1]), "=&v"(P.bb[2]), "=&v"(P.bb[3]), \
                                   "=&v"(P.kb[0]), "=&v"(P.kb[1]), "=&v"(P.kb[2]), "=&v"(P.kb[3]), "=&v"(P.vf) \
                                 : "v"(oAB + so_), "v"(oBB + so_), "v"(oKB + so_), "v"(oVV + so_) : "memory"); \
                    const LAS bf16_t* rh_ = (const LAS bf16_t*)(S8 + SL_RH) + n * CS + 4 * g; \
                    P.rh[0] = *(const LAS s16x4v*)(rh_); P.rh[1] = *(const LAS s16x4v*)(rh_ + 16); P.rh[2] = *(const LAS s16x4v*)(rh_ + 32); P.rh[3] = *(const LAS s16x4v*)(rh_ + 48); \
                    P.abr = *(const LAS s16x4v*)(S8 + SL_ABR + lane * 8); P.akr = *(const LAS s16x4v*)(S8 + SL_AKR + lane * 8); P.wt = *(const LAS u32x2*)(S8 + SL_WT + (it * 64 + lane) * 8); \
                    _Pragma("unroll") for (int jt = 0; jt < 4; ++jt) P.gc[jt] = *(const LAS f32x4*)(S8 + SL_GC + (16 * jt + 4 * g) * 4); } while (0)
#define CH_WAIT(P) asm volatile("s_waitcnt lgkmcnt(0)" : "+v"(P.ab[0]), "+v"(P.ab[1]), "+v"(P.ab[2]), "+v"(P.ab[3]), "+v"(P.bb[0]), "+v"(P.bb[1]), "+v"(P.bb[2]), "+v"(P.bb[3]), \
                                   "+v"(P.kb[0]), "+v"(P.kb[1]), "+v"(P.kb[2]), "+v"(P.kb[3]), "+v"(P.vf) :: "memory")
#define CH_COMPUTE(P, sl_) do { \
                    const s16x4v sf0 = pk4(ST[0]), sf1 = pk4(ST[1]), sf2 = pk4(ST[2]), sf3 = pk4(ST[3]); \
                    f32x4 U = (f32x4){bf_lo(P.wt.x), bf_hi(P.wt.x), bf_lo(P.wt.y), bf_hi(P.wt.y)}; \
                    U = mm16(P.ab[0], sf0, U); U = mm16(P.ab[1], sf1, U); U = mm16(P.ab[2], sf2, U); U = mm16(P.ab[3], sf3, U); \
                    const s16x4v uf = pk4(U); \
                    ST[0] = mm16(P.kb[0], P.vf, mm16(P.bb[0], uf, ST[0] * P.gc[0])); ST[1] = mm16(P.kb[1], P.vf, mm16(P.bb[1], uf, ST[1] * P.gc[1])); \
                    ST[2] = mm16(P.kb[2], P.vf, mm16(P.bb[2], uf, ST[2] * P.gc[2])); ST[3] = mm16(P.kb[3], P.vf, mm16(P.bb[3], uf, ST[3] * P.gc[3])); \
                    f32x4 Y = mm16(P.rh[0], sf0, zero4); Y = mm16(P.rh[1], sf1, Y); Y = mm16(P.rh[2], sf2, Y); Y = mm16(P.rh[3], sf3, Y); \
                    Y = mm16(P.abr, uf, Y); Y = mm16(P.akr, P.vf, Y); \
                    LAS bf16_t* yo = (LAS bf16_t*)(lds + (sl_) * SL_SIZE + SL_Y) + 16 * it + n; const unsigned y01 = pkv(Y[0], Y[1]), y23 = pkv(Y[2], Y[3]); \
                    yo[(4 * g + 0) * CS] = (bf16_t)(y01 & 0xffff); yo[(4 * g + 1) * CS] = (bf16_t)(y01 >> 16); yo[(4 * g + 2) * CS] = (bf16_t)(y23 & 0xffff); yo[(4 * g + 3) * CS] = (bf16_t)(y23 >> 16); } while (0)
                Ops A_, B_;
                CH_ISSUE(A_, 0);
#pragma unroll 1
                for (int sl = 0; sl < 8; sl += 2) {
                    CH_WAIT(A_); CH_ISSUE(B_, sl + 1); CH_COMPUTE(A_, sl);
                    CH_WAIT(B_); if (sl + 2 < 8) CH_ISSUE(A_, sl + 2); CH_COMPUTE(B_, sl + 1);
                }
#undef CH_ISSUE
#undef CH_WAIT
#undef CH_COMPUTE
            }
            __syncthreads();
            {
                const LAS bf16_t* yi = (const LAS bf16_t*)(slot + SL_Y) + n * CS + 4 * g;
                f32x4 y[4]; float sm = 0.f;
#pragma unroll
                for (int ct = 0; ct < 4; ++ct) { y[ct] = up4(*(const LAS u32x2*)(yi + 16 * ct)); sm += (y[ct][0] + y[ct][1]) + (y[ct][2] + y[ct][3]); }
                sm += __shfl_xor(sm, 16); sm += __shfl_xor(sm, 32);
                const float mean = sm * (1.0f / 64.0f); float q = 0.f;
#pragma unroll
                for (int ct = 0; ct < 4; ++ct) { const f32x4 d = y[ct] - mean; q += (d[0] * d[0] + d[1] * d[1]) + (d[2] * d[2] + d[3] * d[3]); }
                q += __shfl_xor(q, 16); q += __shfl_xor(q, 32);
                const float rstd = rsqrtf(q * (1.0f / 64.0f) + GN_EPS);
                bf16_t* ym = (bf16_t*)(p.ws + WS_YMIX) + (size_t)(b * SEQ + t) * DM + 512 + 64 * h;
#pragma unroll
                for (int ct = 0; ct < 4; ++ct) { const int cl = 16 * ct + 4 * g;
                    const f32x4 lw = *(const LAS f32x4*)(CS_ + C_LW + cl), lb = *(const LAS f32x4*)(CS_ + C_LB + cl);
                    const f32x4 o = ((y[ct] - mean) * rstd * lw + lb + bonus * v4[ct]) * gate4[ct];
                    u32x2 w; w.x = cvt_pk_bf16(o[0], o[1]); w.y = cvt_pk_bf16(o[2], o[3]);
                    *(u32x2*)(ym + cl) = w; }
            }
            __syncthreads();
        }
    }
}

constexpr int KSTR = 72;
constexpr int VSTR = 80;
constexpr int A_K = 0;
constexpr int A_VT = 3 * 128 * KSTR * 2;
constexpr int A_END = A_VT + 3 * 128 * VSTR * 2;
constexpr int A_STG = A_END;
static_assert(A_STG + 8 * 2560 <= 159 * 1024, "attn lds");

__device__ __forceinline__ void phase_attn(const Params& p, LAS unsigned char* lds) {
    const int tid = threadIdx.x, w = __builtin_amdgcn_readfirstlane(tid >> 6), lane = tid & 63, ql = lane & 15, g = lane >> 4;
    const bf16_t* z = (const bf16_t*)(p.ws + WS_Z);
    LAS bf16_t* Ks = (LAS bf16_t*)(lds + A_K); LAS bf16_t* VT = (LAS bf16_t*)(lds + A_VT);
    constexpr float SC = 0.125f * 1.4426950408889634f;
    for (int i = tid; i < A_END / 16; i += 512) *(LAS u32x4*)(lds + A_K + i * 16) = (u32x4){0u, 0u, 0u, 0u};
    const int srow = tid >> 3, sc8 = tid & 7;
    for (int bh = blockIdx.x; bh < 256; bh += gridDim.x) {
        const int b = bh >> 3, h = bh & 7;
        const bf16_t* zb = z + (size_t)b * SEQ * INW + 64 * h;
        float* stA_O = (float*)(p.ws + WS_STA + (size_t)bh * ST_BYTES_PER_BH); float* stA_ML = stA_O + SEQ * 64;
        float* stB_O = (float*)(p.ws + WS_STB + (size_t)bh * ST_BYTES_PER_BH); float* stB_ML = stB_O + SEQ * 64;
        u32x4 kq[2], vq[2];
#define ATT_DECODE(u_, pat_, d_, r_, n_) const int pat_ = 2 - (u_) / 16, d_ = pat_ == 0 ? 1 : (pat_ == 1 ? 4 : 16), nb_##u_ = 16 / d_, r_ = ((u_) % 16) / nb_##u_, n_ = ((u_) % 16) % nb_##u_
#define ATT_LOAD(d_, r_, n_) do { _Pragma("unroll") for (int it = 0; it < 2; ++it) { const bf16_t* zr = zb + (size_t)((128 * (n_) + srow + 64 * it) * (d_) + (r_)) * INW + sc8 * 8; \
            kq[it] = *(const u32x4*)(zr + 512); vq[it] = *(const u32x4*)(zr + 1024); } } while (0)
#define ATT_STORE(slot_) ATT_STORE_ROW((slot_) * 128)
#define ATT_STORE_ROW(rb_) do { _Pragma("unroll") for (int it = 0; it < 2; ++it) { const int row = (rb_) + srow + 64 * it; \
            *(LAS u32x4*)(Ks + row * KSTR + sc8 * 8) = kq[it]; *(LAS u32x4*)(VT + row * VSTR + sc8 * 8) = vq[it]; } } while (0)
        LAS unsigned char* stg = lds + A_STG + w * 2560;
#define STG_Q(i_) ((LAS u32x4*)(stg + (i_) * 1024 + lane * 16))
#define STG_ML ((LAS f32x2*)(stg + 2048 + lane * 8))
        __syncthreads();
        { ATT_LOAD(16, 0, 0); ATT_STORE(0);
          const bf16_t* zq0 = zb + (size_t)((16 * w + ql) * 16) * INW;
          *STG_Q(0) = *(const u32x4*)(zq0 + 8 * g); *STG_Q(1) = *(const u32x4*)(zq0 + 32 + 8 * g); }
        __syncthreads();
        int cb = 0, pb = 256, nbk = 128;
        for (int u = 0; u < 48; ++u) {
            ATT_DECODE(u, pat, d, r, n);
            const int tq = (128 * n + 16 * w + ql) * d + r;
            float* outO = pat == 2 ? stA_O : stB_O; float* outML = pat == 2 ? stA_ML : stB_ML;
            const bf16x8 qf0 = __builtin_bit_cast(bf16x8, *STG_Q(0)), qf1 = __builtin_bit_cast(bf16x8, *STG_Q(1));
            float m_prev = -INFINITY, l_prev = 0.f;
            f32x4 accO[4];
#pragma unroll
            for (int dt = 0; dt < 4; ++dt) accO[dt] = (f32x4){0.f, 0.f, 0.f, 0.f};
            const bool oddq = (ql & 1) != 0;
            const int tqA = (128 * n + 16 * w + (ql & ~1)) * d + r;
            if (pat != 2) { const f32x2 ml = *STG_ML; m_prev = ml.x; l_prev = ml.y; const unsigned char* inO = (const unsigned char*)(pat == 1 ? stA_O : stB_O) + (oddq ? 64 : 0) + 16 * g;
                const u32x4 la = *(const u32x4*)(inO + (size_t)tqA * 128), lb = *(const u32x4*)(inO + (size_t)(tqA + d) * 128);
                const u32x4 rcv = xchg1(oddq ? la : lb); const u32x4 w0 = oddq ? rcv : la, w1 = oddq ? lb : rcv;
                accO[0] = (f32x4){bf_lo(w0.x), bf_hi(w0.x), bf_lo(w0.y), bf_hi(w0.y)}; accO[1] = (f32x4){bf_lo(w0.z), bf_hi(w0.z), bf_lo(w0.w), bf_hi(w0.w)};
                accO[2] = (f32x4){bf_lo(w1.x), bf_hi(w1.x), bf_lo(w1.y), bf_hi(w1.y)}; accO[3] = (f32x4){bf_lo(w1.z), bf_hi(w1.z), bf_lo(w1.w), bf_hi(w1.w)}; }
            asm volatile("s_waitcnt lgkmcnt(0)" ::: "memory");
            u32x4 nq0 = (u32x4){0u, 0u, 0u, 0u}, nq1 = nq0; f32x2 nml = (f32x2){0.f, 0.f};
            bool nstate = false;
            if (u + 1 < 48) { const int u1 = u + 1; ATT_DECODE(u1, pat1, d1, r1, n1); ATT_LOAD(d1, r1, n1);
                const int tq1 = (128 * n1 + 16 * w + ql) * d1 + r1;
                const bf16_t* zq1 = zb + (size_t)tq1 * INW;
                nq0 = *(const u32x4*)(zq1 + 8 * g); nq1 = *(const u32x4*)(zq1 + 32 + 8 * g);
                if (pat1 != 2) { nstate = true; const float* inML = pat1 == 1 ? stA_ML : stB_ML; nml = *(const f32x2*)(inML + tq1 * 2); } }
            int rbx[9];
#pragma unroll
            for (int x = 0; x < 9; ++x) rbx[x] = (x <= 7 - w) ? pb + 16 * (w + x) : cb + 16 * (x - (8 - w));
            u32x2 vt[9][4];
#define ATT_VISSUE(x0_) do { const unsigned a0_ = (unsigned)(size_t)(VT + (rbx[x0_] + 4 * g + (ql >> 2)) * VSTR + 4 * (ql & 3)), a1_ = (unsigned)(size_t)(VT + (rbx[x0_ + 1] + 4 * g + (ql >> 2)) * VSTR + 4 * (ql & 3)), \
                                                   a2_ = (unsigned)(size_t)(VT + (rbx[x0_ + 2] + 4 * g + (ql >> 2)) * VSTR + 4 * (ql & 3)); \
                asm volatile("ds_read_b64_tr_b16 %0, %12\n\tds_read_b64_tr_b16 %1, %12 offset:32\n\tds_read_b64_tr_b16 %2, %12 offset:64\n\tds_read_b64_tr_b16 %3, %12 offset:96\n\t" \
                             "ds_read_b64_tr_b16 %4, %13\n\tds_read_b64_tr_b16 %5, %13 offset:32\n\tds_read_b64_tr_b16 %6, %13 offset:64\n\tds_read_b64_tr_b16 %7, %13 offset:96\n\t" \
                             "ds_read_b64_tr_b16 %8, %14\n\tds_read_b64_tr_b16 %9, %14 offset:32\n\tds_read_b64_tr_b16 %10, %14 offset:64\n\tds_read_b64_tr_b16 %11, %14 offset:96" \
                             : "=&v"(vt[x0_][0]), "=&v"(vt[x0_][1]), "=&v"(vt[x0_][2]), "=&v"(vt[x0_][3]), "=&v"(vt[x0_ + 1][0]), "=&v"(vt[x0_ + 1][1]), "=&v"(vt[x0_ + 1][2]), "=&v"(vt[x0_ + 1][3]), \
                               "=&v"(vt[x0_ + 2][0]), "=&v"(vt[x0_ + 2][1]), "=&v"(vt[x0_ + 2][2]), "=&v"(vt[x0_ + 2][3]) : "v"(a0_), "v"(a1_), "v"(a2_) : "memory"); } while (0)
            ATT_VISSUE(0); ATT_VISSUE(3); ATT_VISSUE(6);
#undef ATT_VISSUE
            bf16x8 kf0[9], kf1[9];
#pragma unroll
            for (int x = 0; x < 9; ++x) { const LAS bf16_t* kp = Ks + (rbx[x] + ql) * KSTR + 8 * g; kf0[x] = *(const LAS bf16x8*)kp; kf1[x] = *(const LAS bf16x8*)(kp + 32); }
            f32x4 sc[9];
#pragma unroll
            for (int x = 0; x < 9; ++x) {
                const bool prev = (x <= 7 - w);
                f32x4 a = (f32x4){0.f, 0.f, 0.f, 0.f};
                a = __builtin_amdgcn_mfma_f32_16x16x32_bf16(kf0[x], qf0, a, 0, 0, 0);
                a = __builtin_amdgcn_mfma_f32_16x16x32_bf16(kf1[x], qf1, a, 0, 0, 0);
#pragma unroll
                for (int i = 0; i < 4; ++i) { const int kl = 4 * g + i; bool ok = true;
                    if (prev) ok = (n > 0) && (x > 0 || kl >= ql); else ok = (x < 8) || (kl <= ql);
                    a[i] = ok ? a[i] * SC : -INFINITY; }
                sc[x] = a;
            }
            float mx = -INFINITY;
#pragma unroll
            for (int x = 0; x < 9; ++x) mx = fmaxf(mx, fmaxf(fmaxf(sc[x][0], sc[x][1]), fmaxf(sc[x][2], sc[x][3])));
            mx = fmaxf(mx, __shfl_xor(mx, 16)); mx = fmaxf(mx, __shfl_xor(mx, 32));
            const float m_new = fmaxf(m_prev, mx);
            float ls = 0.f;
#pragma unroll
            for (int x = 0; x < 9; ++x)
#pragma unroll
                for (int i = 0; i < 4; ++i) { const float e = __builtin_amdgcn_exp2f(sc[x][i] - m_new); sc[x][i] = e; ls += e; }
            ls += __shfl_xor(ls, 16); ls += __shfl_xor(ls, 32);
            const float alpha = __builtin_amdgcn_exp2f(m_prev - m_new);
            const float l_new = l_prev * alpha + ls;
#pragma unroll
            for (int dt = 0; dt < 4; ++dt) accO[dt] = accO[dt] * alpha;
            asm volatile("s_waitcnt lgkmcnt(0)" : "+v"(vt[0][0]), "+v"(vt[0][1]), "+v"(vt[0][2]), "+v"(vt[0][3]), "+v"(vt[1][0]), "+v"(vt[1][1]), "+v"(vt[1][2]), "+v"(vt[1][3]), "+v"(vt[2][0]), "+v"(vt[2][1]), "+v"(vt[2][2]), "+v"(vt[2][3]),
                                                   "+v"(vt[3][0]), "+v"(vt[3][1]), "+v"(vt[3][2]), "+v"(vt[3][3]), "+v"(vt[4][0]), "+v"(vt[4][1]), "+v"(vt[4][2]), "+v"(vt[4][3]) :: "memory");
            asm volatile("" : "+v"(vt[5][0]), "+v"(vt[5][1]), "+v"(vt[5][2]), "+v"(vt[5][3]), "+v"(vt[6][0]), "+v"(vt[6][1]), "+v"(vt[6][2]), "+v"(vt[6][3]), "+v"(vt[7][0]), "+v"(vt[7][1]), "+v"(vt[7][2]), "+v"(vt[7][3]),
                             "+v"(vt[8][0]), "+v"(vt[8][1]), "+v"(vt[8][2]), "+v"(vt[8][3]) :: "memory");
#pragma unroll
            for (int s2 = 0; s2 < 5; ++s2) {
                const int x0 = 2 * s2, x1 = 2 * s2 + 1;
                u32x4 pw; pw.x = cvt_pk_bf16(sc[x0][0], sc[x0][1]); pw.y = cvt_pk_bf16(sc[x0][2], sc[x0][3]);
                if (x1 < 9) { pw.z = cvt_pk_bf16(sc[x1 < 9 ? x1 : 8][0], sc[x1 < 9 ? x1 : 8][1]); pw.w = cvt_pk_bf16(sc[x1 < 9 ? x1 : 8][2], sc[x1 < 9 ? x1 : 8][3]); } else { pw.z = 0u; pw.w = 0u; }
                const bf16x8 pf = __builtin_bit_cast(bf16x8, pw);
#pragma unroll
                for (int dt = 0; dt < 4; ++dt) {
                    const u32x2 lo = vt[x0][dt], hi = x1 < 9 ? vt[x1 < 9 ? x1 : 8][dt] : (u32x2){0u, 0u};
                    const u32x4 vw = (u32x4){lo.x, lo.y, hi.x, hi.y};
                    accO[dt] = __builtin_amdgcn_mfma_f32_16x16x32_bf16(__builtin_bit_cast(bf16x8, vw), pf, accO[dt], 0, 0, 0);
                }
            }
            if (pat != 0) {
                u32x4 w0, w1;
                w0.x = cvt_pk_bf16(accO[0][0], accO[0][1]); w0.y = cvt_pk_bf16(accO[0][2], accO[0][3]); w0.z = cvt_pk_bf16(accO[1][0], accO[1][1]); w0.w = cvt_pk_bf16(accO[1][2], accO[1][3]);
                w1.x = cvt_pk_bf16(accO[2][0], accO[2][1]); w1.y = cvt_pk_bf16(accO[2][2], accO[2][3]); w1.z = cvt_pk_bf16(accO[3][0], accO[3][1]); w1.w = cvt_pk_bf16(accO[3][2], accO[3][3]);
                const u32x4 rcv = xchg1(oddq ? w0 : w1);
                unsigned char* oO = (unsigned char*)outO + (oddq ? 64 : 0) + 16 * g;
                *(u32x4*)(oO + (size_t)tqA * 128) = oddq ? rcv : w0; *(u32x4*)(oO + (size_t)(tqA + d) * 128) = oddq ? w1 : rcv;
                if (g == 0) { outML[tq * 2] = m_new; outML[tq * 2 + 1] = l_new; }
            } else {
                const float il = frcp(l_new); float ss = 0.f;
#pragma unroll
                for (int dt = 0; dt < 4; ++dt) { accO[dt] = accO[dt] * il; ss += (accO[dt][0] * accO[dt][0] + accO[dt][1] * accO[dt][1]) + (accO[dt][2] * accO[dt][2] + accO[dt][3] * accO[dt][3]); }
                ss += __shfl_xor(ss, 16); ss += __shfl_xor(ss, 32);
                const float rs = rsqrtf(ss * (1.0f / 64.0f) + NORM_EPS);
                bf16_t* ym = (bf16_t*)(p.ws + WS_YMIX) + (size_t)(b * SEQ + tq) * DM + 64 * h;
#pragma unroll
                for (int dt = 0; dt < 4; ++dt) { const f32x4 gn = *(const f32x4*)(p.attn_out_gain + 64 * h + 16 * dt + 4 * g); const f32x4 o = accO[dt] * rs * gn;
                    u32x2 wv; wv.x = cvt_pk_bf16(o[0], o[1]); wv.y = cvt_pk_bf16(o[2], o[3]); *(u32x2*)(ym + 16 * dt + 4 * g) = wv; }
            }
            if (u + 1 < 48) { ATT_STORE_ROW(nbk); *STG_Q(0) = nq0; *STG_Q(1) = nq1;
                if (nstate) *STG_ML = nml; }
            { const int t_ = pb; pb = cb; cb = nbk; nbk = t_; }
            __syncthreads();
        }
#undef ATT_DECODE
#undef ATT_LOAD
#undef ATT_STORE
#undef ATT_STORE_ROW
#undef STG_Q
#undef STG_ML
        asm volatile("s_waitcnt vmcnt(0)" ::: "memory");
    }
}

constexpr int P4_WH = 0;
constexpr int P4_WL = 65536;
constexpr int P4_GN = 131072;
constexpr int P4_LG = P4_GN + 4096;
constexpr int P4_RS = P4_LG + 16384;
constexpr int P4_CNT = P4_RS + 512;
constexpr int P4_ASG = P4_CNT + 256;
constexpr int P4_GT = P4_ASG + 4096;
constexpr int P4_END = P4_GT + 4096;
static_assert(P4_END <= 158 * 1024, "router lds");

__device__ __forceinline__ void phase_router(const Params& p, LAS unsigned char* lds) {
    const int tid = threadIdx.x, wid = __builtin_amdgcn_readfirstlane(tid >> 6), lane = tid & 63, n = lane & 15, g = lane >> 4;
    LAS float* GN = (LAS float*)(lds + P4_GN); LAS float* LG = (LAS float*)(lds + P4_LG) + wid * 512; LAS float* RSD = (LAS float*)(lds + P4_RS) + wid * 16;
    LAS unsigned* cnt = (LAS unsigned*)(lds + P4_CNT); LAS unsigned* bas = cnt + 32; LAS unsigned* asg = (LAS unsigned*)(lds + P4_ASG);
    unsigned* ctl = (unsigned*)(p.ws + WS_CTL);
    int* list = (int*)(p.ws + WS_LIST); float* glist = (float*)(p.ws + WS_GLIST);
    LAS float* gtl = (LAS float*)(lds + P4_GT);
    unsigned char* h2 = p.ws + WS_H;
    const bf16_t* x1 = (const bf16_t*)(p.ws + WS_X1);
    for (int i = tid; i < 1024; i += 512) GN[i] = p.norm2_gain[i];
    for (int i0 = tid; i0 < 32 * 1024; i0 += 8 * 512) {
        float wv[8], gv[8];
#pragma unroll
        for (int j = 0; j < 8; ++j) { const int i = i0 + 512 * j; wv[j] = p.router_w[i]; gv[j] = p.norm2_gain[i >> 5]; }
#pragma unroll
        for (int j = 0; j < 8; ++j) { const int i = i0 + 512 * j, k = i >> 5, e = i & 31; const float w = wv[j] * gv[j];
            const unsigned hb = cvt_pk_bf16(w, 0.f) & 0xffffu; const float hf = __uint_as_float(hb << 16); const unsigned lb = cvt_pk_bf16(w - hf, 0.f) & 0xffffu;
            const int off = e * 2048 + ((((k >> 3) ^ (e & 15)) << 4) | ((k & 7) << 1));
            *(LAS bf16_t*)(lds + P4_WH + off) = (bf16_t)hb; *(LAS bf16_t*)(lds + P4_WL + off) = (bf16_t)lb; } }
    const float rb0 = p.router_b[lane & 31];
    for (int panel = blockIdx.x; panel < NTOK / 256; panel += gridDim.x) {
        if (tid < 32) cnt[tid] = 0u;
        __syncthreads();
        for (int tile = 0; tile < 2; ++tile) {
            const int tl0 = wid * 32 + tile * 16, tok0 = panel * 256 + tl0;
            bf16x8 raw[32];
            const bf16_t* xp = x1 + (size_t)(tok0 + n) * DM + 8 * g;
#pragma unroll
            for (int s2 = 0; s2 < 32; ++s2) raw[s2] = *(const bf16x8*)(xp + 32 * s2);
            f32x4 aq = (f32x4){0.f, 0.f, 0.f, 0.f};
#pragma unroll
            for (int s2 = 0; s2 < 32; ++s2) aq = __builtin_amdgcn_mfma_f32_16x16x32_bf16(raw[s2], raw[s2], aq, 0, 0, 0);
            { const int i = n & 3; const float d = i == 0 ? aq[0] : (i == 1 ? aq[1] : (i == 2 ? aq[2] : aq[3]));
              if (g == (n >> 2)) RSD[n] = rsqrtf(d * (1.0f / DM) + NORM_EPS); }
            asm volatile("s_waitcnt lgkmcnt(0)" ::: "memory");
            const float rs = RSD[n];
            f32x4 al[2] = {{0.f, 0.f, 0.f, 0.f}, {0.f, 0.f, 0.f, 0.f}};
            unsigned char* hp = h2 + (size_t)(tok0 + n) * DM + 8 * g;
#pragma unroll
            for (int s2 = 0; s2 < 32; ++s2) {
#pragma unroll
                for (int et = 0; et < 2; ++et) { const int e = 16 * et + n; const int off = e * 2048 + (((4 * s2 + g) ^ (e & 15)) << 4);
                    const bf16x8 wh = *(const LAS bf16x8*)(lds + P4_WH + off), wl = *(const LAS bf16x8*)(lds + P4_WL + off);
                    al[et] = __builtin_amdgcn_mfma_f32_16x16x32_bf16(raw[s2], wh, al[et], 0, 0, 0);
                    al[et] = __builtin_amdgcn_mfma_f32_16x16x32_bf16(raw[s2], wl, al[et], 0, 0, 0); }
                const f32x4 g0 = *(const LAS f32x4*)(GN + 32 * s2 + 8 * g), g1 = *(const LAS f32x4*)(GN + 32 * s2 + 8 * g + 4);
                const u32x4 rw = __builtin_bit_cast(u32x4, raw[s2]);
                const f32x4 v0 = (f32x4){bf_lo(rw.x), bf_hi(rw.x), bf_lo(rw.y), bf_hi(rw.y)} * g0 * rs, v1 = (f32x4){bf_lo(rw.z), bf_hi(rw.z), bf_lo(rw.w), bf_hi(rw.w)} * g1 * rs;
                *(u32x2*)(hp + 32 * s2) = (u32x2){pk4_fp8(v0[0], v0[1], v0[2], v0[3]), pk4_fp8(v1[0], v1[1], v1[2], v1[3])};
            }
            const float rbv0 = __shfl(rb0, n), rbv1 = __shfl(rb0, 16 + n);
#pragma unroll
            for (int i = 0; i < 4; ++i) { const float rsi = RSD[4 * g + i]; LG[(4 * g + i) * 32 + n] = al[0][i] * rsi + rbv0; LG[(4 * g + i) * 32 + 16 + n] = al[1][i] * rsi + rbv1; }
            asm volatile("s_waitcnt lgkmcnt(0)" ::: "memory");
            if (lane < 16) {
                float lv[32];
#pragma unroll
                for (int q = 0; q < 8; ++q) { const f32x4 t4 = *(const LAS f32x4*)(LG + lane * 32 + 4 * q); lv[4 * q] = t4[0]; lv[4 * q + 1] = t4[1]; lv[4 * q + 2] = t4[2]; lv[4 * q + 3] = t4[3]; }
                float tv[4]; int te[4];
#pragma unroll
                for (int k = 0; k < 4; ++k) { float bv = -INFINITY; int be = 0;
#pragma unroll
                    for (int e = 0; e < 32; ++e) { const bool taken = (k > 0 && te[0] == e) || (k > 1 && te[1] == e) || (k > 2 && te[2] == e); if (!taken && lv[e] > bv) { bv = lv[e]; be = e; } }
                    tv[k] = bv; te[k] = be; }
                const float e1 = fexp(tv[1] - tv[0]), e2 = fexp(tv[2] - tv[0]), e3 = fexp(tv[3] - tv[0]);
                const float isum = 1.0f / (1.0f + e1 + e2 + e3);
                const float gk[4] = {isum, e1 * isum, e2 * isum, e3 * isum};
                const int tl = tl0 + lane, tok = tok0 + lane;
#pragma unroll
                for (int k = 0; k < 4; ++k) { const unsigned pos = __hip_atomic_fetch_add(&cnt[te[k]], 1u, __ATOMIC_RELAXED, __HIP_MEMORY_SCOPE_WORKGROUP);
                    asg[tl * 4 + k] = ((unsigned)te[k] << 16) | pos; gtl[tl * 4 + k] = gk[k]; }
            }
            asm volatile("s_waitcnt lgkmcnt(0)" ::: "memory");
        }
        __syncthreads();
        if (tid < 32) bas[tid] = __hip_atomic_fetch_add(ctl + CW_CNT + 64 * tid, cnt[tid], __ATOMIC_RELAXED, __HIP_MEMORY_SCOPE_AGENT);
        __syncthreads();
        for (int i = tid; i < 1024; i += 512) { const unsigned a = asg[i]; const int e = a >> 16, pos = a & 0xffff; const size_t li = (size_t)e * NTOK + bas[e] + pos;
            list[li] = (panel * 256 + (i >> 2)) * 4 + (i & 3); glist[li] = gtl[i]; }
        __syncthreads();
    }
}

struct TileTab { int tb[33]; int cn[32]; };
__device__ __forceinline__ void build_tiletab(const Params& p, LAS TileTab* T) {
    if (threadIdx.x < 32) {
        const unsigned* ctl = (const unsigned*)(p.ws + WS_CTL);
        const int e = threadIdx.x, c = (int)__hip_atomic_load(ctl + CW_CNT + 64 * e, __ATOMIC_RELAXED, __HIP_MEMORY_SCOPE_AGENT), nt = (c + 255) >> 8;
        int incl = nt;
#pragma unroll
        for (int o = 1; o < 32; o <<= 1) { const int v = __shfl_up(incl, o); if (e >= o) incl += v; }
        T->cn[e] = c; T->tb[e] = incl - nt; if (e == 31) T->tb[32] = incl;
    }
    __syncthreads();
}
template <int NCT>
struct GroupProb {
    const char* Abase; const char* Bt; const int* list; const LAS TileTab* T; int ntiles, xcd, rank; bool gather;
    static constexpr int RPX = 32 / NCT;
    __device__ __forceinline__ void init(const void* A, const void* B, const int* list_, const LAS TileTab* T_, bool gather_) {
        Abase = (const char*)A; Bt = (const char*)B; list = list_; T = T_; gather = gather_; ntiles = T_->tb[32];
        const int c = blockIdx.x; xcd = c & 7; rank = c >> 3; }
    __device__ __forceinline__ bool next(int i, g8::Unit& u) const {
        if (rank >= 32) return false;
        const int rt = (i * 8 + xcd) * RPX + rank / NCT; if (rt >= ntiles) return false;
        int e = 0;
#pragma unroll
        for (int s = 16; s >= 1; s >>= 1) if (T->tb[e + s] <= rt) e += s;
        u.pm = rt; u.pn = rank % NCT; u.e = e; u.cnt = T->cn[e] - (rt - T->tb[e]) * 256; return true;
    }
    __device__ __forceinline__ unsigned a_off(const g8::Unit& u, int row) const {
        if (gather) { const int rc = row < u.cnt ? row : u.cnt - 1; const int tokn = list[(size_t)u.e * NTOK + (u.pm - T->tb[u.e]) * 256 + rc] >> 2; return (unsigned)tokn * 1024u; }
        return (unsigned)(u.pm * 256 + row) * 1024u;
    }
    template <bool CM> __device__ __forceinline__ const char* b_ptr(const g8::Unit& u, int half) const {
        if (NCT == 8) return Bt + ((size_t)u.e * 2048 + (size_t)half * 1024 + u.pn * 128) * 1024;
        return Bt + ((size_t)u.e * 1024 + u.pn * 256 + half * (CM ? 32 : 128)) * 1024;
    }
};
struct EpiHid {
    static constexpr bool PERM = true, COLMAP = false;
    unsigned char* H; const float* b1;
    __device__ __forceinline__ void prefetch(const g8::Unit& u, LAS unsigned char* my, int wid, int lane) const {
        const float* src = b1 + (size_t)u.e * 2048 + (lane >> 5) * 1024 + u.pn * 128 + (wid & 3) * 32 + (lane & 31);
        __builtin_amdgcn_global_load_lds((const unsigned*)src, (LAS unsigned*)my, 4, 0, 0);
    }
    __device__ __forceinline__ void operator()(const f32x4 (&acc)[2][2][4][2], const g8::Unit& u, int wr, int wc, int fr, int fq, LAS unsigned char* my) const {
        const int row0 = u.pm * 256 + wr * 64 + fr, col0 = u.pn * 128 + wc * 32 + 8 * fq;
        const f32x4 bg0 = *(const LAS f32x4*)(my + 32 * fq), bg1 = *(const LAS f32x4*)(my + 32 * fq + 16), bl0 = *(const LAS f32x4*)(my + 128 + 32 * fq), bl1 = *(const LAS f32x4*)(my + 128 + 32 * fq + 16);
        const f32x2 bg[4] = {{bg0[0], bg0[1]}, {bg0[2], bg0[3]}, {bg1[0], bg1[1]}, {bg1[2], bg1[3]}};
        const f32x2 bl[4] = {{bl0[0] + 1.0f, bl0[1] + 1.0f}, {bl0[2] + 1.0f, bl0[3] + 1.0f}, {bl1[0] + 1.0f, bl1[1] + 1.0f}, {bl1[2] + 1.0f, bl1[3] + 1.0f}};
        const f32x2 sc = {1.0f / W8_SCALE, 1.0f / W8_SCALE}, ce = {-1.702f * 1.4426950408889634f, -1.702f * 1.4426950408889634f}, one = {1.0f, 1.0f};
        const bool oddq = (fq & 1) != 0;
        const int colS = u.pn * 128 + wc * 32 + 16 * (fq >> 1);
        u32x2 wv[4];
#pragma unroll
        for (int ai = 0; ai < 2; ++ai)
#pragma unroll
            for (int m = 0; m < 4; ++m) {
                f32x2 o[4];
#pragma unroll
                for (int q = 0; q < 4; ++q) {
                    const f32x4 ga = acc[ai][0][m][q >> 1], la = acc[ai][1][m][q >> 1];
                    const f32x2 gr = (q & 1) ? (f32x2){ga[2], ga[3]} : (f32x2){ga[0], ga[1]}, lr = (q & 1) ? (f32x2){la[2], la[3]} : (f32x2){la[0], la[1]};
                    f32x2 gl = __builtin_elementwise_fma(gr, sc, bg[q]), li = __builtin_elementwise_fma(lr, sc, bl[q]);
                    gl.x = fminf(gl.x, 7.0f); gl.y = fminf(gl.y, 7.0f);
                    li.x = __builtin_amdgcn_fmed3f(li.x, -6.0f, 8.0f); li.y = __builtin_amdgcn_fmed3f(li.y, -6.0f, 8.0f);
                    const f32x2 ex = gl * ce;
                    f32x2 den = {__builtin_amdgcn_exp2f(ex.x), __builtin_amdgcn_exp2f(ex.y)}; den = den + one;
                    const f32x2 rc = {__builtin_amdgcn_rcpf(den.x), __builtin_amdgcn_rcpf(den.y)};
                    o[q] = (gl * rc) * li; }
                wv[m].x = pk4_fp8(o[0].x, o[0].y, o[1].x, o[1].y); wv[m].y = pk4_fp8(o[2].x, o[2].y, o[3].x, o[3].y);
                if (m & 1) {
                    const u32x2 snd = oddq ? wv[m - 1] : wv[m];
                    const u32x2 rcv = {(unsigned)__shfl_xor((int)snd.x, 16), (unsigned)__shfl_xor((int)snd.y, 16)};
                    const u32x4 dat = oddq ? (u32x4){rcv.x, rcv.y, wv[m].x, wv[m].y} : (u32x4){wv[m - 1].x, wv[m - 1].y, rcv.x, rcv.y};
                    *(u32x4*)(H + (size_t)(row0 + ai * 128 + (oddq ? m : m - 1) * 16) * FF + colS) = dat; } }
    }
};
struct EpiY2 {
    static constexpr bool PERM = true, COLMAP = true;
    unsigned char* Y; const float* b2; const int* list; const float* gate; const LAS TileTab* T;
    __device__ __forceinline__ void prefetch(const g8::Unit& u, LAS unsigned char* my, int wid, int lane) const {
        const size_t lb = (size_t)u.e * NTOK + (u.pm - T->tb[u.e]) * 256;
#pragma unroll
        for (int ai = 0; ai < 2; ++ai) { const int r = ai * 128 + (wid >> 2) * 64 + lane, rc = r < u.cnt ? r : u.cnt - 1;
            __builtin_amdgcn_global_load_lds((const unsigned*)(list + lb + rc), (LAS unsigned*)(my + ai * 256), 4, 0, 0);
            __builtin_amdgcn_global_load_lds((const unsigned*)(gate + lb + rc), (LAS unsigned*)(my + 512 + ai * 256), 4, 0, 0); }
        __builtin_amdgcn_global_load_lds((const unsigned*)(b2 + (size_t)u.e * DM + u.pn * 256 + (wid & 3) * 64 + lane), (LAS unsigned*)(my + 1024), 4, 0, 0);
    }
    __device__ __forceinline__ void operator()(const f32x4 (&acc)[2][2][4][2], const g8::Unit& u, int wr, int wc, int fr, int fq, LAS unsigned char* my) const {
        const bool oddq = (fq & 1) != 0;
        const int colS = u.pn * 256 + wc * 64 + (oddq ? 32 + 8 * (fq - 1) : 8 * fq);
        f32x4 bv[2][2];
#pragma unroll
        for (int bj = 0; bj < 2; ++bj) { bv[bj][0] = *(const LAS f32x4*)(my + 1024 + 128 * bj + 32 * fq); bv[bj][1] = *(const LAS f32x4*)(my + 1024 + 128 * bj + 32 * fq + 16); }
        int dsts[2][4]; float gts[2][4];
#pragma unroll
        for (int ai = 0; ai < 2; ++ai)
#pragma unroll
            for (int m = 0; m < 4; ++m) { dsts[ai][m] = *(const LAS int*)(my + ai * 256 + (m * 16 + fr) * 4); gts[ai][m] = *(const LAS float*)(my + 512 + ai * 256 + (m * 16 + fr) * 4); }
#pragma unroll
        for (int ai = 0; ai < 2; ++ai)
#pragma unroll
            for (int m = 0; m < 4; ++m) { const int r = ai * 128 + wr * 64 + m * 16 + fr; const float gt = gts[ai][m];
                u32x2 pc[2];
#pragma unroll
                for (int bj = 0; bj < 2; ++bj) { const f32x4 v0 = (acc[ai][bj][m][0] * (1.0f / W8_SCALE) + bv[bj][0]) * gt, v1 = (acc[ai][bj][m][1] * (1.0f / W8_SCALE) + bv[bj][1]) * gt;
                    pc[bj] = (u32x2){pk4_fp8(v0[0], v0[1], v0[2], v0[3]), pk4_fp8(v1[0], v1[1], v1[2], v1[3])}; }
                const u32x2 snd = oddq ? pc[0] : pc[1];
                const u32x2 rcv = {(unsigned)__shfl_xor((int)snd.x, 16), (unsigned)__shfl_xor((int)snd.y, 16)};
                const u32x4 dat = oddq ? (u32x4){rcv.x, rcv.y, pc[1].x, pc[1].y} : (u32x4){pc[0].x, pc[0].y, rcv.x, rcv.y};
                if (r < u.cnt) *(u32x4*)(Y + (size_t)dsts[ai][m] * DM + colS) = dat; }
    }
};
__device__ __forceinline__ void phase_final(const Params& p) {
    const int lane = threadIdx.x & 63, wid = threadIdx.x >> 6;
    const unsigned char* y2 = p.ws + WS_Y2;
    f32x4 gn[4];
#pragma unroll
    for (int c = 0; c < 4; ++c) gn[c] = *(const f32x4*)(p.final_norm_gain + 256 * c + 4 * lane);
    for (int tok0 = (blockIdx.x * 8 + wid) * 4; tok0 < NTOK; tok0 += gridDim.x * 32) {
        u32x2 xb[4][4]; int yw[4][4][4];
#pragma unroll
        for (int q = 0; q < 4; ++q) { const bf16_t* x1r = (const bf16_t*)(p.ws + WS_X1) + (size_t)(tok0 + q) * DM;
#pragma unroll
            for (int c = 0; c < 4; ++c) xb[q][c] = *(const u32x2*)(x1r + 256 * c + 4 * lane);
#pragma unroll
            for (int k = 0; k < 4; ++k) { const unsigned char* yr = y2 + ((size_t)(tok0 + q) * 4 + k) * DM;
#pragma unroll
                for (int c = 0; c < 4; ++c) yw[q][k][c] = *(const int*)(yr + 256 * c + 4 * lane); } }
#pragma unroll
        for (int q = 0; q < 4; ++q) {
            f32x4 v[4];
#pragma unroll
            for (int c = 0; c < 4; ++c) v[c] = up4(xb[q][c]);
#pragma unroll
            for (int k = 0; k < 4; ++k)
#pragma unroll
                for (int c = 0; c < 4; ++c) { const int w = yw[q][k][c];
                    const f32x2 lo = __builtin_amdgcn_cvt_pk_f32_fp8(w, false), hi = __builtin_amdgcn_cvt_pk_f32_fp8(w, true);
                    v[c][0] += lo.x; v[c][1] += lo.y; v[c][2] += hi.x; v[c][3] += hi.y; }
            float ss = 0.f;
#pragma unroll
            for (int c = 0; c < 4; ++c) ss += (v[c][0] * v[c][0] + v[c][1] * v[c][1]) + (v[c][2] * v[c][2] + v[c][3] * v[c][3]);
            ss = wave_sum(ss);
            const float rs = rsqrtf(ss * (1.0f / DM) + NORM_EPS);
            float* xr = p.out + (size_t)(tok0 + q) * DM;
#pragma unroll
            for (int c = 0; c < 4; ++c) *(f32x4*)(xr + 256 * c + 4 * lane) = v[c] * rs * gn[c];
        }
    }
}

constexpr int LDS_BYTES = 163840;
constexpr int L_MISC = 159 * 1024;
__global__ void __launch_bounds__(512, 2) mega_fwd(Params p) {
    extern __shared__ __attribute__((aligned(16))) unsigned char lds_raw[];
    LAS unsigned char* lds = (LAS unsigned char*)lds_raw;
    volatile LAS unsigned* misc = (volatile LAS unsigned*)(lds + L_MISC);
    LAS TileTab* TT = (LAS TileTab*)(lds + L_MISC + 64);
    if (threadIdx.x < 4) misc[threadIdx.x] = 0u;
    __syncthreads();
    XcdBarrier bar = xcd_barrier_post((unsigned*)(p.ws + WS_CTL) + CW_BAR, misc);
    const int lo = p.ph_lo, hi = p.ph_hi;
#define IN(k) (lo <= (k) && (k) < hi)
    if (IN(0)) { phase0(p, lds); xcd_barrier(bar); }
    if (IN(1)) {
        g8::DenseProb S; S.init(p.ws + WS_H, p.ws + WS_WIN, NTOK, INW, (int)gridDim.x, (int)blockIdx.x);
        EpiZ E{(bf16_t*)(p.ws + WS_Z)};
        g8::gemm_phase<false>(lds, S, E);
        xcd_barrier(bar);
    }
    if (IN(2)) { rwkv_lora_act(p); xcd_barrier(bar); phase_rwkv(p, lds); __syncthreads(); phase_attn(p, lds); xcd_barrier(bar); }
    if (IN(3)) {
        g8::DenseProb S; S.init(p.ws + WS_YMIX, p.ws + WS_WOUT, NTOK, DM, (int)gridDim.x, (int)blockIdx.x);
        EpiX1 E{p.x, (bf16_t*)(p.ws + WS_X1)};
        g8::gemm_phase<false>(lds, S, E);
        xcd_barrier(bar);
    }
    if (IN(4)) { phase_router(p, lds); xcd_barrier(bar); }
    if (IN(5)) {
        build_tiletab(p, TT);
        GroupProb<8> S; S.init(p.ws + WS_H, p.ws + WS_W1T, (const int*)(p.ws + WS_LIST), TT, true);
        EpiHid E{p.ws + WS_HID, p.expert_b1};
        g8::gemm_phase<true>(lds, S, E);
        xcd_barrier(bar);
    }
    if (IN(6)) {
        build_tiletab(p, TT);
        GroupProb<4> S; S.init(p.ws + WS_HID, p.ws + WS_W2T, (const int*)(p.ws + WS_LIST), TT, false);
        EpiY2 E{p.ws + WS_Y2, p.expert_b2, (const int*)(p.ws + WS_LIST), (const float*)(p.ws + WS_GLIST), TT};
        g8::gemm_phase<true>(lds, S, E);
        xcd_barrier(bar);
    }
    if (IN(7)) phase_final(p);
#undef IN
}

extern "C" void kernel_launch(void* const* d_in, const int* in_sizes, int n_in, void* d_out, int out_size, void* d_ws, size_t ws_size, hipStream_t stream) {
    static int grid = 0;
    if (grid == 0) {
        if (n_in != 24 || out_size != NTOK * DM || ws_size < WS_END) { fprintf(stderr, "kernel_launch: unexpected shapes (n_in %d, out %d, ws %zu < %zu); nothing launched\n", n_in, out_size, ws_size, (size_t)WS_END); grid = -1; return; }
        int dev = 0, cus = 0, per_cu = 0;
        if (hipGetDevice(&dev) != hipSuccess || hipDeviceGetAttribute(&cus, hipDeviceAttributeMultiprocessorCount, dev) != hipSuccess) { grid = -1; return; }
        if (hipFuncSetAttribute((const void*)mega_fwd, hipFuncAttributeMaxDynamicSharedMemorySize, LDS_BYTES) != hipSuccess) { fprintf(stderr, "kernel_launch: hipFuncSetAttribute failed\n"); grid = -1; return; }
        if (hipOccupancyMaxActiveBlocksPerMultiprocessor(&per_cu, (const void*)mega_fwd, 512, LDS_BYTES) != hipSuccess || per_cu < 1) { fprintf(stderr, "kernel_launch: occupancy query says %d\n", per_cu); (void)hipGetLastError(); grid = -1; return; }
        grid = cus;
    }
    if (grid < 0) return;
    if (hipMemsetAsync((char*)d_ws + WS_CTL, 0, CTL_ZERO_BYTES, stream) != hipSuccess) return;
    Params p{};
    const float** pp = (const float**)&p;
    for (int i = 0; i < 24; ++i) pp[i] = (const float*)d_in[i];
    p.out = (float*)d_out; p.ws = (unsigned char*)d_ws;
    p.ph_lo = 0; p.ph_hi = 8;
    hipLaunchKernelGGL(mega_fwd, dim3(grid), dim3(512), LDS_BYTES, stream, p);
}
```

```cpp
#include <hip/hip_runtime.h>
#include <stdint.h>
#include <stdio.h>

#define LAS __attribute__((address_space(3)))
typedef unsigned short bf16_t;
typedef short bf16x8 __attribute__((ext_vector_type(8)));
typedef short s16x4 __attribute__((ext_vector_type(4)));
typedef float f32x4 __attribute__((ext_vector_type(4)));
typedef float f32x2 __attribute__((ext_vector_type(2)));
typedef unsigned u32x4 __attribute__((ext_vector_type(4)));
typedef unsigned u32x2 __attribute__((ext_vector_type(2)));

constexpr int NTOK = 65536, SEQ = 2048, DM = 1024, INW = 3328, NE = 32, FF = 1024, NH = 8;
constexpr int RW_OFF = 1536;
constexpr float NORM_EPS = 1e-5f, GN_EPS = 64e-5f;

constexpr size_t MiB = 1048576;
constexpr size_t WS_CTL   = 0;
constexpr size_t CTL_ZERO_BYTES = 65536;
constexpr size_t WS_WIN   = 2 * MiB;
constexpr size_t WS_WOUT  = WS_WIN + (size_t)INW * DM * 2;
constexpr size_t WS_DECUP = WS_WOUT + (size_t)DM * DM * 2;
constexpr size_t WS_ICLUP = WS_DECUP + 512 * 64 * 2;
constexpr size_t WS_GATUP = WS_ICLUP + 512 * 64 * 2;
constexpr size_t WS_W2T   = 12 * MiB;
constexpr size_t WS_W1T   = 76 * MiB;
constexpr size_t WS_LACT  = 140 * MiB;
constexpr size_t WS_H     = 204 * MiB;
constexpr size_t WS_TAIL  = 332 * MiB;
constexpr size_t WS_Z     = 472 * MiB;
constexpr size_t WS_YMIX  = 888 * MiB;
constexpr size_t WS_END   = 1016 * MiB;
static_assert(WS_GATUP + 512 * 128 * 2 <= WS_W2T, "small weights");
constexpr size_t WS_STA   = WS_H;
constexpr size_t ST_BYTES_PER_BH = (size_t)SEQ * 64 * 4 + (size_t)SEQ * 2 * 4;
constexpr size_t WS_STB   = WS_STA + 256 * ST_BYTES_PER_BH;
static_assert(WS_STB + 256 * ST_BYTES_PER_BH <= WS_Z, "state buffers");
constexpr size_t WS_LIST  = WS_TAIL;
constexpr size_t WS_GATE  = WS_TAIL + 8 * MiB;
constexpr size_t WS_GLIST = WS_TAIL + 16 * MiB;
constexpr size_t WS_HID   = WS_Z;
constexpr size_t WS_X1    = 736 * MiB;
constexpr size_t WS_Y2    = WS_W1T;
constexpr int CW_BAR = 0;
constexpr int CW_CNT = 4096;

#define XB_TMO      128
#define XB_XCNT(j)  (256  + 64 * (j))
#define XB_XSUB(j)  (1280 + 64 * (j))
#define XB_XGEN(j)  (2304 + 64 * (j))
#define XB_TOP      3328
#define XB_TOPGEN   3392
#define XCD_BAR_WORDS 3456
#define XB_SPIN_CAP (1u << 18)

__device__ __forceinline__ unsigned xb_ld(unsigned* p)              { return __hip_atomic_load(p, __ATOMIC_RELAXED, __HIP_MEMORY_SCOPE_AGENT); }
__device__ __forceinline__ unsigned xb_add(unsigned* p, unsigned v) { return __hip_atomic_fetch_add(p, v, __ATOMIC_RELAXED, __HIP_MEMORY_SCOPE_AGENT); }
__device__ __forceinline__ unsigned xb_xcc_id() { return (unsigned)__builtin_amdgcn_s_getreg((3 << 11) | 20) & 0xFu; }
#define XB_SPIN(cond, bar) do { unsigned _sp = 0; while (cond) { __builtin_amdgcn_s_sleep(1); \
    if ((++_sp & 255u) == 0u) { if (xb_ld(&(bar)[XB_TMO])) break; if (_sp > XB_SPIN_CAP) { atomicAdd(&(bar)[XB_TMO], 1u); break; } } } } while (0)

struct XcdBarrier { unsigned* bar; unsigned x; volatile LAS unsigned* st; };

__device__ __forceinline__ XcdBarrier xcd_barrier_post(unsigned* bar, volatile LAS unsigned* st) {
    XcdBarrier b; b.bar = bar; b.x = xb_xcc_id(); b.st = st;
    if (threadIdx.x == 0) (void)xb_add(&bar[XB_XCNT(b.x)], 1u);
    return b;
}
__device__ __forceinline__ void xcd_barrier_complete(unsigned* bar, unsigned x, unsigned& nloc, unsigned& nx) {
    const unsigned G = gridDim.x * gridDim.y * gridDim.z;
    unsigned sum, cnt, mine, sp = 0u;
    for (;;) {
        sum = 0u; cnt = 0u; mine = 0u;
#pragma unroll
        for (unsigned j = 0; j < 16; ++j) { const unsigned c = xb_ld(&bar[XB_XCNT(j)]); sum += c; cnt += (c > 0u) ? 1u : 0u; mine = (j == x) ? c : mine; }
        if (sum == G) break;
        __builtin_amdgcn_s_sleep(1);
        if ((++sp & 255u) == 0u) { if (xb_ld(&bar[XB_TMO])) break; if (sp > XB_SPIN_CAP) { atomicAdd(&bar[XB_TMO], 1u); break; } }
    }
    nloc = mine > 0u ? mine : 1u; nx = cnt > 0u ? cnt : 1u;
}
__device__ __forceinline__ void xcd_barrier(const XcdBarrier& b) {
    asm volatile("s_waitcnt vmcnt(0)" ::: "memory");
    __syncthreads();
    if (threadIdx.x == 0) {
        unsigned* bar = b.bar;
        __builtin_amdgcn_s_waitcnt(0);
        unsigned nloc = b.st[0], nx = b.st[1];
        if (nloc == 0u) { xcd_barrier_complete(bar, b.x, nloc, nx); b.st[0] = nloc; b.st[1] = nx; }
        const unsigned old = xb_add(&bar[XB_XSUB(b.x)], 1u);
        const unsigned gen = old / nloc;
        if (old + 1u == (gen + 1u) * nloc) {
            __builtin_amdgcn_fence(__ATOMIC_RELEASE, "agent");
            asm volatile("s_waitcnt vmcnt(0)" ::: "memory");
            const unsigned og = xb_add(&bar[XB_TOP], 1u);
            const unsigned tg = og / nx;
            if (og + 1u == (tg + 1u) * nx) xb_add(&bar[XB_TOPGEN], 1u);
            else XB_SPIN(xb_ld(&bar[XB_TOPGEN]) == tg, bar);
            __builtin_amdgcn_fence(__ATOMIC_ACQUIRE, "agent");
            xb_add(&bar[XB_XGEN(b.x)], 1u);
            asm volatile("s_waitcnt vmcnt(0)" ::: "memory");
        } else {
            XB_SPIN(xb_ld(&bar[XB_XGEN(b.x)]) == gen, bar);
            __builtin_amdgcn_fence(__ATOMIC_ACQUIRE, "agent");
            asm volatile("s_waitcnt vmcnt(0)" ::: "memory");
        }
    }
    __syncthreads();
}

__device__ __forceinline__ unsigned cvt_pk_bf16(float lo, float hi) { unsigned r; asm volatile("v_cvt_pk_bf16_f32 %0, %1, %2" : "=v"(r) : "v"(lo), "v"(hi)); return r; }
__device__ __forceinline__ float bf_lo(unsigned w) { return __uint_as_float(w << 16); }
__device__ __forceinline__ float bf_hi(unsigned w) { return __uint_as_float(w & 0xffff0000u); }
__device__ __forceinline__ float bf1(bf16_t v) { return __uint_as_float(((unsigned)v) << 16); }
template <int CTRL> __device__ __forceinline__ float dpp_f(float v) { return __int_as_float(__builtin_amdgcn_update_dpp(0, __float_as_int(v), CTRL, 0xf, 0xf, true)); }
__device__ __forceinline__ u32x4 xchg1(u32x4 v) { u32x4 r;
#pragma unroll
    for (int i = 0; i < 4; ++i) r[i] = (unsigned)__builtin_amdgcn_update_dpp(0, (int)v[i], 0xB1, 0xf, 0xf, true);
    return r; }
__device__ __forceinline__ float red8(float v)  { v += dpp_f<0xB1>(v); v += dpp_f<0x4E>(v); v += dpp_f<0x141>(v); return v; }
__device__ __forceinline__ float red16(float v) { v = red8(v); v += dpp_f<0x140>(v); return v; }
__device__ __forceinline__ float wave_sum(float v) { v = red16(v); v += __shfl_xor(v, 16); v += __shfl_xor(v, 32); return v; }
__device__ __forceinline__ float fexp(float x) { return __builtin_amdgcn_exp2f(x * 1.4426950408889634f); }
__device__ __forceinline__ float frcp(float x) { return __builtin_amdgcn_rcpf(x); }
__device__ __forceinline__ float sigmoidf_(float x) { return frcp(1.0f + fexp(-x)); }
__device__ __forceinline__ float ftanh(float x) { return 1.0f - 2.0f * frcp(1.0f + fexp(2.0f * x)); }

struct Params {
    const float *x, *norm1_gain, *w_in, *shift_mu, *decay_up, *decay_bias, *iclr_up, *iclr_bias, *gate_up,
                *k_k, *k_a, *r_k, *lnx_w, *lnx_b, *attn_out_gain, *w_out, *norm2_gain, *router_w, *router_b,
                *expert_w1, *expert_b1, *expert_w2, *expert_b2, *final_norm_gain;
    float* out;
    unsigned char* ws;
    int ph_lo, ph_hi;
};

__device__ __forceinline__ unsigned pk4_fp8(float a, float b, float c, float d) { int w = 0; w = __builtin_amdgcn_cvt_pk_fp8_f32(a, b, w, false); w = __builtin_amdgcn_cvt_pk_fp8_f32(c, d, w, true); return (unsigned)w; }
constexpr float W8_SCALE = 64.0f;
constexpr int SC_ONE = 0x7f7f7f7f, SC_W = 0x79797979;
struct TJob { const float* src; unsigned char* dst; int N, K, k0, n0, fp8; };
__device__ __forceinline__ TJob tjob(const Params& p, int j) {
    unsigned char* ws = p.ws; TJob t;
    constexpr int J_W1 = 32 * 16 * 8, J_W2 = 32 * 16 * 4, J_WIN = 16 * 13, J_WOUT = 16 * 4, J_DEC = 2, J_ICL = 2;
    if (j < J_W1) { const int e = j / 128, r = j % 128; t = TJob{p.expert_w1 + (size_t)e * DM * 2048, ws + WS_W1T + (size_t)e * 2048 * DM, 2048, DM, (r / 8) * 64, (r % 8) * 256, 1}; return t; }
    j -= J_W1;
    if (j < J_W2) { const int e = j / 64, r = j % 64; t = TJob{p.expert_w2 + (size_t)e * FF * DM, ws + WS_W2T + (size_t)e * DM * FF, DM, FF, (r / 4) * 64, (r % 4) * 256, 1}; return t; }
    j -= J_W2;
    if (j < J_WIN) { t = TJob{p.w_in, ws + WS_WIN, INW, DM, (j / 13) * 64, (j % 13) * 256, 0}; return t; }
    j -= J_WIN;
    if (j < J_WOUT) { t = TJob{p.w_out, ws + WS_WOUT, DM, DM, (j / 4) * 64, (j % 4) * 256, 0}; return t; }
    j -= J_WOUT;
    if (j < J_DEC) { t = TJob{p.decay_up, ws + WS_DECUP, 512, 64, 0, j * 256, 2}; return t; }
    j -= J_DEC;
    if (j < J_ICL) { t = TJob{p.iclr_up, ws + WS_ICLUP, 512, 64, 0, j * 256, 2}; return t; }
    j -= J_ICL;
    t = TJob{p.gate_up, ws + WS_GATUP, 512, 128, (j / 2) * 64, (j % 2) * 256, 2}; return t;
}
constexpr int T_NJOBS = 32 * 16 * 8 + 32 * 16 * 4 + 16 * 13 + 16 * 4 + 2 + 2 + 4;
constexpr int T_STR = 260;
__device__ __forceinline__ void phase0(const Params& p, LAS unsigned char* lds) {
    unsigned char* ws = p.ws;
    const int tid = threadIdx.x, lane = tid & 63, wid = tid >> 6;
    {
        f32x4 g[4];
        g[0] = *(const f32x4*)(p.norm1_gain + lane * 8); g[1] = *(const f32x4*)(p.norm1_gain + lane * 8 + 4);
        g[2] = *(const f32x4*)(p.norm1_gain + 512 + lane * 8); g[3] = *(const f32x4*)(p.norm1_gain + 512 + lane * 8 + 4);
        bf16_t* o = (bf16_t*)(ws + WS_H);
        for (int row0 = (blockIdx.x * 8 + wid) * 4; row0 < NTOK; row0 += gridDim.x * 32) {
            f32x4 v[4][4];
#pragma unroll
            for (int r = 0; r < 4; ++r) { const float* xr = p.x + (size_t)(row0 + r) * DM;
                v[r][0] = __builtin_nontemporal_load((const f32x4*)(xr + lane * 8)); v[r][1] = __builtin_nontemporal_load((const f32x4*)(xr + lane * 8 + 4)); v[r][2] = __builtin_nontemporal_load((const f32x4*)(xr + 512 + lane * 8)); v[r][3] = __builtin_nontemporal_load((const f32x4*)(xr + 512 + lane * 8 + 4)); }
#pragma unroll
            for (int r = 0; r < 4; ++r) {
                float ss = 0.f;
#pragma unroll
                for (int i = 0; i < 4; ++i) ss += v[r][i][0] * v[r][i][0] + v[r][i][1] * v[r][i][1] + v[r][i][2] * v[r][i][2] + v[r][i][3] * v[r][i][3];
                ss = wave_sum(ss);
                const float rs = rsqrtf(ss * (1.0f / DM) + NORM_EPS);
                f32x4 q[4];
#pragma unroll
                for (int i = 0; i < 4; ++i) q[i] = v[r][i] * rs * g[i];
                u32x4 w0, w1;
                w0.x = cvt_pk_bf16(q[0][0], q[0][1]); w0.y = cvt_pk_bf16(q[0][2], q[0][3]); w0.z = cvt_pk_bf16(q[1][0], q[1][1]); w0.w = cvt_pk_bf16(q[1][2], q[1][3]);
                w1.x = cvt_pk_bf16(q[2][0], q[2][1]); w1.y = cvt_pk_bf16(q[2][2], q[2][3]); w1.z = cvt_pk_bf16(q[3][0], q[3][1]); w1.w = cvt_pk_bf16(q[3][2], q[3][3]);
                *(u32x4*)(o + (size_t)(row0 + r) * DM + lane * 8) = w0;
                *(u32x4*)(o + (size_t)(row0 + r) * DM + 512 + lane * 8) = w1;
            }
        }
    }
    LAS float* T0 = (LAS float*)lds; LAS float* T1 = T0 + 64 * T_STR;
    f32x4 rg[8];
    const int lr = tid >> 6, lc = (tid & 63) * 4;
#define T_LOAD(J) do { const TJob t_ = tjob(p, (J)); _Pragma("unroll") for (int i = 0; i < 8; ++i) rg[i] = __builtin_nontemporal_load((const f32x4*)(t_.src + (size_t)(t_.k0 + lr + 8 * i) * t_.N + t_.n0 + lc)); } while (0)
#define T_PARK(T) do { _Pragma("unroll") for (int i = 0; i < 8; ++i) *(LAS f32x4*)((T) + (lr + 8 * i) * T_STR + lc) = rg[i]; } while (0)
    int j = blockIdx.x;
    if (j < T_NJOBS) { T_LOAD(j); T_PARK(T0); }
    __syncthreads();
    for (int it = 0; j < T_NJOBS; j += gridDim.x, ++it) {
        const int jn = j + gridDim.x;
        if (jn < T_NJOBS) T_LOAD(jn);
        const TJob t = tjob(p, j);
        const LAS float* T = (it & 1) ? T1 : T0;
        {   const int n = tid >> 1, kh = tid & 1;
            float v[32];
#pragma unroll
            for (int i = 0; i < 32; ++i) v[i] = T[(32 * kh + i) * T_STR + n];
            if (t.fp8 == 1) {
                u32x4 w0, w1;
                w0.x = pk4_fp8(v[0] * W8_SCALE, v[1] * W8_SCALE, v[2] * W8_SCALE, v[3] * W8_SCALE); w0.y = pk4_fp8(v[4] * W8_SCALE, v[5] * W8_SCALE, v[6] * W8_SCALE, v[7] * W8_SCALE);
                w0.z = pk4_fp8(v[8] * W8_SCALE, v[9] * W8_SCALE, v[10] * W8_SCALE, v[11] * W8_SCALE); w0.w = pk4_fp8(v[12] * W8_SCALE, v[13] * W8_SCALE, v[14] * W8_SCALE, v[15] * W8_SCALE);
                w1.x = pk4_fp8(v[16] * W8_SCALE, v[17] * W8_SCALE, v[18] * W8_SCALE, v[19] * W8_SCALE); w1.y = pk4_fp8(v[20] * W8_SCALE, v[21] * W8_SCALE, v[22] * W8_SCALE, v[23] * W8_SCALE);
                w1.z = pk4_fp8(v[24] * W8_SCALE, v[25] * W8_SCALE, v[26] * W8_SCALE, v[27] * W8_SCALE); w1.w = pk4_fp8(v[28] * W8_SCALE, v[29] * W8_SCALE, v[30] * W8_SCALE, v[31] * W8_SCALE);
                unsigned char* d = t.dst + (size_t)(t.n0 + n) * t.K + t.k0 + 32 * kh;
                *(u32x4*)d = w0; *(u32x4*)(d + 16) = w1;
            } else {
                const int r = t.n0 + n;
                bf16_t* d = t.fp8 == 2 ? (bf16_t*)t.dst + ((size_t)(((r >> 4) * (t.K >> 5) + (t.k0 >> 5) + kh) * 64 + (r & 15))) * 8 : (bf16_t*)t.dst + (size_t)r * t.K + t.k0 + 32 * kh;
                const int qs = t.fp8 == 2 ? 128 : 8;
#pragma unroll
                for (int q = 0; q < 4; ++q) { u32x4 w; w.x = cvt_pk_bf16(v[8 * q], v[8 * q + 1]); w.y = cvt_pk_bf16(v[8 * q + 2], v[8 * q + 3]); w.z = cvt_pk_bf16(v[8 * q + 4], v[8 * q + 5]); w.w = cvt_pk_bf16(v[8 * q + 6], v[8 * q + 7]);
                    *(u32x4*)(d + qs * q) = w; }
            }
        }
        if (jn < T_NJOBS) { if (it & 1) T_PARK(T0); else T_PARK(T1); }
        __syncthreads();
    }
#undef T_LOAD
#undef T_PARK
}

namespace g8 {
constexpr int BM = 256, BK = 64, HALF = 128, HTB = HALF * BK * 2, STAGE_BYTES = 8 * HTB;
typedef int i32x8 __attribute__((ext_vector_type(8)));
typedef int i32x4v __attribute__((ext_vector_type(4)));
__device__ __forceinline__ int lds_byte(int r, int c) { const int st = (r >> 4) * 2 + (c >> 5), rr = r & 15, cc = c & 31, ob = rr * 64 + cc * 2; return st * 1024 + (ob ^ (((ob >> 9) & 1) << 5)); }
__device__ __forceinline__ void stage_rc(int b, int& R, int& C) { const int st = b / 1024, sb = b % 1024, swz = sb ^ (((sb >> 9) & 1) << 5); R = (st >> 1) * 16 + swz / 64; C = (st & 1) * 32 + (swz % 64) / 2; }
__device__ __forceinline__ int perm32(int rho) { const int n = rho >> 4, i = rho & 15; return 8 * (i >> 2) + 4 * n + (i & 3); }

struct Unit { int pm, pn, e, cnt; };

template <bool FP8, class Prob, class Epi>
__device__ __forceinline__ void gemm_phase(LAS unsigned char* lds, const Prob& S, const Epi& E) {
    constexpr int KB = FP8 ? 1024 : 2048, NT = KB / 128;
    const int tid = threadIdx.x, wid = __builtin_amdgcn_readfirstlane(tid >> 6), lane = tid & 63, wr = wid >> 2, wc = wid & 3, fr = lane & 15, fq = lane >> 4;
    unsigned voffB[2];
#pragma unroll
    for (int i = 0; i < 2; ++i) { int R, C; stage_rc(tid * 16 + i * 8192, R, C); const int Rb = Epi::COLMAP ? (64 * (R >> 5) + perm32(R & 31)) : (Epi::PERM ? ((R & ~31) + perm32(R & 31)) : R); voffB[i] = (unsigned)(Rb * KB + C * 2); }
#define G8_AOFF(dst, U) do { _Pragma("unroll") for (int i_ = 0; i_ < 2; ++i_) { int R_, C_; stage_rc(tid * 16 + i_ * 8192, R_, C_); \
        _Pragma("unroll") for (int h_ = 0; h_ < 2; ++h_) dst[h_][i_] = S.a_off(U, h_ * HALF + R_) + (unsigned)(C_ * 2); } } while (0)
    const unsigned ldsw = (unsigned)wid * 1024u;
    const int aoff = lds_byte(wr * 64 + fr, fq * 8), boff = lds_byte(wc * 32 + fr, fq * 8);
    const char* const Abase = S.Abase;
#define G8_SA(b, h) (((b) * 2 + (h)) * HTB)
#define G8_SB(b, h) ((4 + (b) * 2 + (h)) * HTB)
#define G8_GLDS(gp, bufoff, i) __builtin_amdgcn_global_load_lds((const unsigned*)(gp), (LAS unsigned*)(lds + (bufoff) + ldsw + (i) * 8192), 16, 0, 0)
#define G8_STA(bufoff, AO, h, kb) do { const char* ak_ = Abase + (kb); G8_GLDS(ak_ + (AO)[h][0], bufoff, 0); G8_GLDS(ak_ + (AO)[h][1], bufoff, 1); } while (0)
#define G8_STB(bufoff, bp) do { G8_GLDS((bp) + voffB[0], bufoff, 0); G8_GLDS((bp) + voffB[1], bufoff, 1); } while (0)
#define G8_LDA(dst, b, h) do { _Pragma("unroll") for (int m = 0; m < 4; ++m) _Pragma("unroll") for (int k = 0; k < 2; ++k) dst[m][k] = *(const LAS bf16x8*)(lds + G8_SA(b, h) + aoff + m * 2048 + k * 1024); } while (0)
#define G8_LDB(dst, b, h) do { _Pragma("unroll") for (int n = 0; n < 2; ++n) _Pragma("unroll") for (int k = 0; k < 2; ++k) dst[n][k] = *(const LAS bf16x8*)(lds + G8_SB(b, h) + boff + n * 2048 + k * 1024); } while (0)
#define G8_MMA(ai, bj, At, Bt) do { __builtin_amdgcn_s_setprio(1); \
        if (FP8) { i32x8 wf_[2], xf_[4]; \
            _Pragma("unroll") for (int n = 0; n < 2; ++n) wf_[n] = __builtin_shufflevector(__builtin_bit_cast(i32x4v, Bt[n][0]), __builtin_bit_cast(i32x4v, Bt[n][1]), 0, 1, 2, 3, 4, 5, 6, 7); \
            _Pragma("unroll") for (int m = 0; m < 4; ++m) xf_[m] = __builtin_shufflevector(__builtin_bit_cast(i32x4v, At[m][0]), __builtin_bit_cast(i32x4v, At[m][1]), 0, 1, 2, 3, 4, 5, 6, 7); \
            asm volatile("s_nop 1" ::: "memory"); \
            _Pragma("unroll") for (int m = 0; m < 4; ++m) _Pragma("unroll") for (int n = 0; n < 2; ++n) \
                asm volatile("v_mfma_f32_16x16x128_f8f6f4 %0, %1, %2, %0" : "+v"(acc[ai][bj][m][n]) : "v"(wf_[n]), "v"(xf_[m])); } \
        else { _Pragma("unroll") for (int m = 0; m < 4; ++m) _Pragma("unroll") for (int n = 0; n < 2; ++n) _Pragma("unroll") for (int k = 0; k < 2; ++k) \
            acc[ai][bj][m][n] = __builtin_amdgcn_mfma_f32_16x16x32_bf16(Bt[n][k], At[m][k], acc[ai][bj][m][n], 0, 0, 0); } \
        __builtin_amdgcn_s_setprio(0); } while (0)
#define G8_WAIT_V(n) asm volatile("s_waitcnt vmcnt(" #n ")" ::: "memory")
#define G8_WAIT_L(n) asm volatile("s_waitcnt lgkmcnt(" #n ")" ::: "memory")
#define G8_BAR __builtin_amdgcn_s_barrier()
#define G8_SCHED __builtin_amdgcn_sched_barrier(0)
    Unit cur, nxt; int ui = 0;
    if (!S.next(0, cur)) return;
    f32x4 acc[2][2][4][2];
#pragma unroll
    for (int a = 0; a < 2; ++a)
#pragma unroll
        for (int b = 0; b < 2; ++b)
#pragma unroll
            for (int m = 0; m < 4; ++m)
#pragma unroll
                for (int n = 0; n < 2; ++n) acc[a][b][m][n] = (f32x4){0.f, 0.f, 0.f, 0.f};
    bf16x8 At[4][2], B0[2][2], B1[2][2];
    unsigned ao[2][2], nao[2][2];
    G8_AOFF(ao, cur);
    const char* cB[2] = {S.template b_ptr<Epi::COLMAP>(cur, 0), S.template b_ptr<Epi::COLMAP>(cur, 1)};
    G8_STB(G8_SB(0, 0), cB[0]); G8_STA(G8_SA(0, 0), ao, 0, 0); G8_STB(G8_SB(0, 1), cB[1]); G8_STA(G8_SA(0, 1), ao, 1, 0);
    if (wr == 1) G8_BAR;
    G8_WAIT_V(4); G8_BAR;
    G8_STB(G8_SB(1, 0), cB[0] + 128); G8_STA(G8_SA(1, 0), ao, 0, 128); G8_STB(G8_SB(1, 1), cB[1] + 128);
    G8_WAIT_V(6); G8_BAR;
    for (;;) {
        E.prefetch(cur, lds + STAGE_BYTES + wid * 2048, wid, lane);
        const bool has_next = S.next(ui + 1, nxt);
        const char* nB[2];
        if (has_next) {
            G8_AOFF(nao, nxt);
            nB[0] = S.template b_ptr<Epi::COLMAP>(nxt, 0); nB[1] = S.template b_ptr<Epi::COLMAP>(nxt, 1);
        } else {
#pragma unroll
            for (int h = 0; h < 2; ++h)
#pragma unroll
                for (int i = 0; i < 2; ++i) nao[h][i] = ao[h][i];
            nB[0] = cB[0]; nB[1] = cB[1];
        }
#pragma nounroll
        for (int t = 0; t < NT; t += 2) {
            const bool last = (t == NT - 2);
            const int kb1 = (t + 1) * 128, kb2 = last ? 0 : (t + 2) * 128;
            unsigned a2[2][2];
#pragma unroll
            for (int h = 0; h < 2; ++h)
#pragma unroll
                for (int i = 0; i < 2; ++i) a2[h][i] = last ? nao[h][i] : ao[h][i];
            const char* b20 = last ? nB[0] : cB[0] + (t + 2) * 128; const char* b21 = last ? nB[1] : cB[1] + (t + 2) * 128;
            G8_LDB(B0, 0, 0); G8_SCHED; G8_LDA(At, 0, 0); G8_STA(G8_SA(1, 1), ao, 1, kb1);
            G8_WAIT_L(8); G8_BAR; G8_WAIT_L(0); G8_MMA(0, 0, At, B0); G8_BAR; G8_SCHED;
            G8_LDB(B1, 0, 1); G8_STB(G8_SB(0, 0), b20);
            G8_BAR; G8_WAIT_L(0); G8_MMA(0, 1, At, B1); G8_BAR;
            G8_LDA(At, 0, 1); G8_STA(G8_SA(0, 0), a2, 0, kb2);
            G8_BAR; G8_WAIT_L(0); G8_MMA(1, 0, At, B0); G8_BAR; G8_SCHED;
            G8_STB(G8_SB(0, 1), b21);
            G8_WAIT_V(6); G8_BAR; G8_MMA(1, 1, At, B1); G8_BAR;
            G8_LDB(B0, 1, 0); G8_SCHED; G8_LDA(At, 1, 0); G8_STA(G8_SA(0, 1), a2, 1, kb2);
            G8_WAIT_L(8); G8_BAR; G8_WAIT_L(0); G8_MMA(0, 0, At, B0); G8_BAR; G8_SCHED;
            G8_LDB(B1, 1, 1); G8_STB(G8_SB(1, 0), b20 + 128);
            G8_BAR; G8_WAIT_L(0); G8_MMA(0, 1, At, B1); G8_BAR;
            G8_LDA(At, 1, 1); G8_STA(G8_SA(1, 0), a2, 0, kb2 + 128);
            G8_BAR; G8_WAIT_L(0); G8_MMA(1, 0, At, B0); G8_BAR; G8_SCHED;
            G8_STB(G8_SB(1, 1), b21 + 128);
            G8_WAIT_V(6); G8_BAR; G8_MMA(1, 1, At, B1); G8_BAR;
        }
        if (FP8) asm volatile("s_nop 15\n\ts_nop 15" ::: "memory");
        E(acc, cur, wr, wc, fr, fq, lds + STAGE_BYTES + wid * 2048);
        if (!has_next) break;
#pragma unroll
        for (int a = 0; a < 2; ++a)
#pragma unroll
            for (int b = 0; b < 2; ++b)
#pragma unroll
                for (int m = 0; m < 4; ++m)
#pragma unroll
                    for (int n = 0; n < 2; ++n) acc[a][b][m][n] = (f32x4){0.f, 0.f, 0.f, 0.f};
        cur = nxt; cB[0] = nB[0]; cB[1] = nB[1]; ++ui;
#pragma unroll
        for (int h = 0; h < 2; ++h)
#pragma unroll
            for (int i = 0; i < 2; ++i) ao[h][i] = nao[h][i];
    }
    G8_WAIT_V(0);
    if (wr == 0) G8_BAR;
    G8_BAR;
#undef G8_SA
#undef G8_AOFF
#undef G8_SB
#undef G8_GLDS
#undef G8_STA
#undef G8_STB
#undef G8_LDA
#undef G8_LDB
#undef G8_MMA
#undef G8_WAIT_V
#undef G8_WAIT_L
#undef G8_BAR
#undef G8_SCHED
}

struct DenseProb {
    const char* Abase; const char* Bt; int nM, nN, nwg, G, c;
    __device__ __forceinline__ void init(const void* A, const void* B, int M, int N, int G_, int c_) { Abase = (const char*)A; Bt = (const char*)B; nM = M / BM; nN = N / BM; nwg = nM * nN; G = G_; c = c_; }
    __device__ __forceinline__ bool next(int i, Unit& u) const {
        const long L = (long)i * G + c; if (L >= nwg) return false;
        int wgid = (int)L; { const int q = nwg / 8, r = nwg % 8, xcd = wgid % 8, off = wgid / 8; wgid = (xcd < r ? xcd * (q + 1) : r * (q + 1) + (xcd - r) * q) + off; }
        const int nig = 8 * nN, gid = wgid / nig, fm = gid * 8, gsz = (nM - fm) < 8 ? (nM - fm) : 8;
        u.pm = fm + ((wgid % nig) % gsz); u.pn = (wgid % nig) / gsz; u.e = 0; u.cnt = 256; return true;
    }
    __device__ __forceinline__ unsigned a_off(const Unit& u, int row) const { return (unsigned)(u.pm * BM + row) * 2048u; }
    template <bool CM> __device__ __forceinline__ const char* b_ptr(const Unit& u, int half) const { return Bt + (size_t)(u.pn * BM + half * (CM ? 32 : HALF)) * 2048; }
};
}

struct EpiZ {
    static constexpr bool PERM = true, COLMAP = true;
    bf16_t* O;
    __device__ __forceinline__ void prefetch(const g8::Unit&, LAS unsigned char*, int, int) const {}
    __device__ __forceinline__ void operator()(const f32x4 (&acc)[2][2][4][2], const g8::Unit& u, int wr, int wc, int fr, int fq, LAS unsigned char*) const {
        const bool odd = (fr & 1) != 0;
        const int rowA = u.pm * 256 + wr * 64 + (fr & ~1), colS = u.pn * 256 + wc * 64 + 8 * fq + (odd ? 32 : 0);
#pragma unroll
        for (int ai = 0; ai < 2; ++ai)
#pragma unroll
            for (int m = 0; m < 4; ++m) { bf16_t* rowp = O + (size_t)(rowA + ai * 128 + m * 16) * INW + colS;
                u32x4 w[2];
#pragma unroll
                for (int bj = 0; bj < 2; ++bj) { const f32x4 v0 = acc[ai][bj][m][0], v1 = acc[ai][bj][m][1];
                    w[bj].x = cvt_pk_bf16(v0[0], v0[1]); w[bj].y = cvt_pk_bf16(v0[2], v0[3]); w[bj].z = cvt_pk_bf16(v1[0], v1[1]); w[bj].w = cvt_pk_bf16(v1[2], v1[3]); }
                const u32x4 snd = odd ? w[0] : w[1]; const u32x4 rcv = xchg1(snd);
                *(u32x4*)rowp = odd ? rcv : w[0]; *(u32x4*)(rowp + INW) = odd ? w[1] : rcv; }
    }
};
struct EpiX1 {
    static constexpr bool PERM = true, COLMAP = true;
    const float* X; bf16_t* O;
    __device__ __forceinline__ void prefetch(const g8::Unit&, LAS unsigned char*, int, int) const {}
    __device__ __forceinline__ void operator()(const f32x4 (&acc)[2][2][4][2], const g8::Unit& u, int wr, int wc, int fr, int fq, LAS unsigned char*) const {
        const bool odd = (fr & 1) != 0;
        const int row0 = u.pm * 256 + wr * 64 + fr, col0 = u.pn * 256 + wc * 64 + 8 * fq;
        const int rowA = u.pm * 256 + wr * 64 + (fr & ~1), colS = col0 + (odd ? 32 : 0);
#pragma unroll
        for (int ai = 0; ai < 2; ++ai) {
            f32x4 xv[4][2][2];
#pragma unroll
            for (int m = 0; m < 4; ++m) { const size_t off = (size_t)(row0 + ai * 128 + m * 16) * DM + col0;
#pragma unroll
                for (int bj = 0; bj < 2; ++bj) { xv[m][bj][0] = *(const f32x4*)(X + off + bj * 32); xv[m][bj][1] = *(const f32x4*)(X + off + bj * 32 + 4); } }
#pragma unroll
            for (int m = 0; m < 4; ++m) { bf16_t* rowp = O + (size_t)(rowA + ai * 128 + m * 16) * DM + colS;
                u32x4 w[2];
#pragma unroll
                for (int bj = 0; bj < 2; ++bj) { const f32x4 v0 = xv[m][bj][0] + acc[ai][bj][m][0], v1 = xv[m][bj][1] + acc[ai][bj][m][1];
                    w[bj].x = cvt_pk_bf16(v0[0], v0[1]); w[bj].y = cvt_pk_bf16(v0[2], v0[3]); w[bj].z = cvt_pk_bf16(v1[0], v1[1]); w[bj].w = cvt_pk_bf16(v1[2], v1[3]); }
                const u32x4 snd = odd ? w[0] : w[1]; const u32x4 rcv = xchg1(snd);
                *(u32x4*)rowp = odd ? rcv : w[0]; *(u32x4*)(rowp + DM) = odd ? w[1] : rcv; }
            asm volatile("" ::: "memory");
        }
    }
};

__device__ __forceinline__ f32x4 ld_bf4(const bf16_t* p) { const u32x2 w = *(const u32x2*)p; return (f32x4){bf_lo(w.x), bf_hi(w.x), bf_lo(w.y), bf_hi(w.y)}; }
__device__ __forceinline__ void ld_bf8(const bf16_t* p, float (&o)[8]) { const u32x4 w = *(const u32x4*)p; o[0] = bf_lo(w.x); o[1] = bf_hi(w.x); o[2] = bf_lo(w.y); o[3] = bf_hi(w.y); o[4] = bf_lo(w.z); o[5] = bf_hi(w.z); o[6] = bf_lo(w.w); o[7] = bf_hi(w.w); }
__device__ __forceinline__ void rwkv_lora_act(const Params& p) {
    const bf16_t* z = (const bf16_t*)(p.ws + WS_Z); bf16_t* act = (bf16_t*)(p.ws + WS_LACT);
    const int sub = threadIdx.x & 31;
    const int col = 8 * sub;
    const f32x4 m0 = *(const f32x4*)(p.shift_mu + 1536 + col), m1 = *(const f32x4*)(p.shift_mu + 1536 + col + 4);
    for (int tok0 = blockIdx.x * 16 + (threadIdx.x >> 5); tok0 < NTOK; tok0 += gridDim.x * 64) {
        u32x4 cw[4], pw[4];
#pragma unroll
        for (int q = 0; q < 4; ++q) { const int tok = tok0 + q * gridDim.x * 16; const bf16_t* zt = z + (size_t)tok * INW + 3072 + col;
            cw[q] = *(const u32x4*)zt; pw[q] = *(const u32x4*)(zt - ((tok & (SEQ - 1)) != 0 ? INW : 0)); }
#pragma unroll
        for (int q = 0; q < 4; ++q) { const int tok = tok0 + q * gridDim.x * 16;
            const float hm = (tok & (SEQ - 1)) != 0 ? 1.0f : 0.0f;
            const float c[8] = {bf_lo(cw[q].x), bf_hi(cw[q].x), bf_lo(cw[q].y), bf_hi(cw[q].y), bf_lo(cw[q].z), bf_hi(cw[q].z), bf_lo(cw[q].w), bf_hi(cw[q].w)};
            const float pv[8] = {bf_lo(pw[q].x), bf_hi(pw[q].x), bf_lo(pw[q].y), bf_hi(pw[q].y), bf_lo(pw[q].z), bf_hi(pw[q].z), bf_lo(pw[q].w), bf_hi(pw[q].w)};
            float v[8];
#pragma unroll
            for (int j = 0; j < 8; ++j) { const float mm = j < 4 ? m0[j] : m1[j - 4]; float x = c[j] + (pv[j] * hm - c[j]) * mm;
                if (col < 64) x = ftanh(x); else if (col >= 128) x = sigmoidf_(x); v[j] = x; }
            u32x4 w; w.x = cvt_pk_bf16(v[0], v[1]); w.y = cvt_pk_bf16(v[2], v[3]); w.z = cvt_pk_bf16(v[4], v[5]); w.w = cvt_pk_bf16(v[6], v[7]);
            *(u32x4*)(act + (size_t)tok * 256 + col) = w; }
    }
}
constexpr int C_MUR = 256, C_MUK = 320, C_MUV = 384, C_DB = 448, C_IB = 512, C_KK = 576, C_KA = 640, C_RK = 704, C_LW = 768, C_LB = 832, C_N = 896;
__device__ __forceinline__ f32x4 up4(u32x2 w) { return (f32x4){bf_lo(w.x), bf_hi(w.x), bf_lo(w.y), bf_hi(w.y)}; }
__device__ __forceinline__ f32x4 lerp4r(u32x2 cur, u32x2 prv, float hm, f32x4 m) { const f32x4 c = up4(cur); return c + (up4(prv) * hm - c) * m; }
constexpr int CK = 16, NIV = SEQ / (CK * 8);
constexpr int CS = 72;
constexpr int SL_VV = 0, SL_RH = 2304, SL_BB = 4608, SL_KB = 6912, SL_AB = 9216  , SL_WT = 12288  , SL_ABR = 14336, SL_AKR = 14848, SL_GC = 15360  ,
              SL_Y = 15616  , SL_SIZE = 17920;
constexpr int RC_CST = 8 * SL_SIZE;
static_assert(RC_CST + C_N * 4 <= 159 * 1024, "chunked rwkv lds");
typedef short s16x4v __attribute__((ext_vector_type(4)));
typedef __bf16 bf16x2t __attribute__((ext_vector_type(2)));
__device__ __forceinline__ unsigned pkv(float lo, float hi) { return __builtin_bit_cast(unsigned, __builtin_convertvector((f32x2){lo, hi}, bf16x2t)); }
__device__ __forceinline__ s16x4v pk4(f32x4 v) { u32x2 w; w.x = pkv(v[0], v[1]); w.y = pkv(v[2], v[3]); return __builtin_bit_cast(s16x4v, w); }
__device__ __forceinline__ f32x4 mm16(s16x4v a, s16x4v b, f32x4 c) { return __builtin_amdgcn_mfma_f32_16x16x16bf16_1k(a, b, c, 0, 0, 0); }
__device__ __forceinline__ s16x4v trread(unsigned addr) { s16x4v r; asm volatile("ds_read_b64_tr_b16 %0, %1\n\ts_waitcnt lgkmcnt(0)" : "=&v"(r) : "v"(addr) : "memory"); return r; }
template <int SH> __device__ __forceinline__ float dpp_shr(float v) { return __int_as_float(__builtin_amdgcn_update_dpp(0, __float_as_int(v), 0x110 + SH, 0xf, 0xf, true)); }

__device__ __forceinline__ void phase_rwkv(const Params& p, LAS unsigned char* lds) {
    const int tid = threadIdx.x, wid = __builtin_amdgcn_readfirstlane(tid >> 6), lane0 = tid & 63;
    const bf16_t* z = (const bf16_t*)(p.ws + WS_Z); const bf16_t* act = (const bf16_t*)(p.ws + WS_LACT);
    const bf16_t* decT = (const bf16_t*)(p.ws + WS_DECUP); const bf16_t* iclT = (const bf16_t*)(p.ws + WS_ICLUP); const bf16_t* gatT = (const bf16_t*)(p.ws + WS_GATUP);
    const f32x4 zero4 = (f32x4){0.f, 0.f, 0.f, 0.f};
    for (int bh = blockIdx.x; bh < 256; bh += gridDim.x) {
        const int b = bh >> 3, h = bh & 7;
        {
            LAS float* C = (LAS float*)(lds + RC_CST);
            for (int i = tid; i < C_N; i += 512) {
                float v;
                if (i < 256) v = 0.f;
                else if (i < 320) v = p.shift_mu[64 * h + (i - 256)];
                else if (i < 384) v = p.shift_mu[512 + 64 * h + (i - 320)];
                else if (i < 448) v = p.shift_mu[1024 + 64 * h + (i - 384)];
                else if (i < 512) v = p.decay_bias[64 * h + (i - 448)];
                else if (i < 576) v = p.iclr_bias[64 * h + (i - 512)];
                else if (i < 640) v = p.k_k[64 * h + (i - 576)];
                else if (i < 704) v = p.k_a[64 * h + (i - 640)];
                else if (i < 768) v = p.r_k[64 * h + (i - 704)];
                else if (i < 832) v = p.lnx_w[64 * h + (i - 768)];
                else v = p.lnx_b[64 * h + (i - 832)];
                C[i] = v;
            }
        }
        __syncthreads();
        const LAS float* CS_ = (const LAS float*)(lds + RC_CST);
        LAS unsigned char* slot = lds + wid * SL_SIZE;
        f32x4 ST[4] = {zero4, zero4, zero4, zero4};
        u32x4 zw[7];
#define RW_LOADZ(iv_, lane_, I0, I1) do { const int t0_ = CK * ((iv_) * 8 + wid); \
            _Pragma("unroll") for (int i = I0; i < I1; ++i) { const int idx_ = 64 * i + (lane_); int pz_ = idx_ >> 3; pz_ = pz_ > 50 ? 50 : pz_; const int a_ = pz_ >= 34 ? 2 : (pz_ >= 17 ? 1 : 0); \
                int tr_ = t0_ - 1 + pz_ - 17 * a_; tr_ = tr_ < 0 ? 0 : tr_; \
                zw[i] = *(const u32x4*)(z + (size_t)(b * SEQ + tr_) * INW + RW_OFF + 64 * h + 512 * a_ + 8 * (idx_ & 7)); } } while (0)
        RW_LOADZ(0, lane0, 0, 5);
#pragma nounroll
        for (int iv = 0; iv < NIV; ++iv) {
            int lane = lane0; asm volatile("" : "+v"(lane));
            const int n = lane & 15, g = lane >> 4;
            const int c = iv * 8 + wid, t = CK * c + n;
            f32x4 gate4[4], v4[4]; float bonus;
            {
                const bf16_t* zt = z + (size_t)(b * SEQ + t) * INW; const bf16_t* zp = zt - (t > 0 ? INW : 0);
                const float hm = t > 0 ? 1.0f : 0.0f;
                const bf16_t* at = act + (size_t)(b * SEQ + t) * 256 + 8 * g;
                const bf16_t* bt = zt + RW_OFF + 64 * h + 4 * g; const bf16_t* bp = zp + RW_OFF + 64 * h + 4 * g;
                f32x4 r4[4], k4[4], lw4[4], an4[4], bn4[4], kn4[4]; float ssq = 0.f;
                bf16x8 xw_[2], xa_[2], xg_[4];
#pragma unroll
                for (int s2 = 0; s2 < 2; ++s2) { xw_[s2] = *(const bf16x8*)(at + 32 * s2); xa_[s2] = *(const bf16x8*)(at + 64 + 32 * s2); }
#pragma unroll
                for (int s2 = 0; s2 < 4; ++s2) xg_[s2] = *(const bf16x8*)(at + 128 + 32 * s2);
                RW_LOADZ(iv, lane, 5, 7);
#define RW_PARK(I0, I1) do { _Pragma("unroll") for (int i = I0; i < I1; ++i) { const int idx = 64 * i + lane; int pz = idx >> 3; pz = pz > 50 ? 50 : pz; *(LAS u32x4*)(slot + pz * 144 + (idx & 7) * 16) = zw[i]; } } while (0)
                RW_PARK(0, 5);
                asm volatile("s_waitcnt lgkmcnt(0)" ::: "memory");
                const LAS unsigned char* zs = slot + n * 144 + 8 * g;
                u32x2 zk[4][2];
#pragma unroll
                for (int ct = 0; ct < 4; ++ct) { zk[ct][1] = *(const LAS u32x2*)(zs + 17 * 144 + 32 * ct); zk[ct][0] = *(const LAS u32x2*)(zs + 18 * 144 + 32 * ct); }
                bf16x8 wD[2][4];
#pragma unroll
                for (int s2 = 0; s2 < 2; ++s2)
#pragma unroll
                    for (int ct = 0; ct < 4; ++ct) wD[s2][ct] = *(const bf16x8*)(decT + (size_t)(((4 * h + ct) * 2 + s2) * 64 + lane) * 8);
                asm volatile("" ::: "memory");
#pragma unroll
                for (int ct = 0; ct < 4; ++ct) { const int cl = 16 * ct + 4 * g;
                    k4[ct] = lerp4r(zk[ct][0], zk[ct][1], hm, *(const LAS f32x4*)(CS_ + C_MUK + cl));
                    const f32x4 kk4 = k4[ct] * *(const LAS f32x4*)(CS_ + C_KK + cl); ssq += (kk4[0] * kk4[0] + kk4[1] * kk4[1]) + (kk4[2] * kk4[2] + kk4[3] * kk4[3]); }
                ssq += __shfl_xor(ssq, 16); ssq += __shfl_xor(ssq, 32);
                const float inv = frcp(fmaxf(sqrtf(ssq), 1e-12f));
                bf16x8 wI[2][4];
                {   f32x4 aw[4] = {zero4, zero4, zero4, zero4};
#pragma unroll
                    for (int s2 = 0; s2 < 2; ++s2) { const bf16x8 xw = xw_[s2];
#pragma unroll
                        for (int ct = 0; ct < 4; ++ct) aw[ct] = __builtin_amdgcn_mfma_f32_16x16x32_bf16(wD[s2][ct], xw, aw[ct], 0, 0, 0); }
#pragma unroll
                    for (int s2 = 0; s2 < 2; ++s2)
#pragma unroll
                        for (int ct = 0; ct < 4; ++ct) wI[s2][ct] = *(const bf16x8*)(iclT + (size_t)(((4 * h + ct) * 2 + s2) * 64 + lane) * 8);
                    asm volatile("" ::: "memory");
#pragma unroll
                    for (int ct = 0; ct < 4; ++ct) { const f32x4 db = *(const LAS f32x4*)(CS_ + C_DB + 16 * ct + 4 * g);
#pragma unroll
                        for (int i = 0; i < 4; ++i) { const float xm = -(db[i] + aw[ct][i]), sp = fmaxf(xm, 0.f) + 0.6931471805599453f * __builtin_amdgcn_logf(1.0f + fexp(-fabsf(xm))); lw4[ct][i] = -fexp(-sp - 0.5f); } } }
                asm volatile("" ::: "memory");
                float bon = 0.f;
                {   f32x4 aa[4] = {zero4, zero4, zero4, zero4};
#pragma unroll
                    for (int s2 = 0; s2 < 2; ++s2) { const bf16x8 xa = xa_[s2];
#pragma unroll
                        for (int ct = 0; ct < 4; ++ct) aa[ct] = __builtin_amdgcn_mfma_f32_16x16x32_bf16(wI[s2][ct], xa, aa[ct], 0, 0, 0); }
#pragma unroll
                    for (int ct = 0; ct < 4; ++ct) { const int cl = 16 * ct + 4 * g;
                        r4[ct] = lerp4r(*(const LAS u32x2*)(zs + 144 + 32 * ct), *(const LAS u32x2*)(zs + 32 * ct), hm, *(const LAS f32x4*)(CS_ + C_MUR + cl));
                        const f32x4 ib = *(const LAS f32x4*)(CS_ + C_IB + cl), kkw = *(const LAS f32x4*)(CS_ + C_KK + cl), kaw = *(const LAS f32x4*)(CS_ + C_KA + cl), rkw = *(const LAS f32x4*)(CS_ + C_RK + cl);
#pragma unroll
                        for (int i = 0; i < 4; ++i) { const float a = sigmoidf_(ib[i] + aa[ct][i]); const float kk = k4[ct][i] * kkw[i] * inv;
                            kn4[ct][i] = k4[ct][i] * (1.0f + (a - 1.0f) * kaw[i]); an4[ct][i] = -kk; bn4[ct][i] = kk * a; bon += r4[ct][i] * kn4[ct][i] * rkw[i]; } } }
                bon += __shfl_xor(bon, 16); bon += __shfl_xor(bon, 32); bonus = bon;
                asm volatile("" ::: "memory");
                RW_PARK(5, 7);
                asm volatile("s_waitcnt lgkmcnt(0)" ::: "memory");
#pragma unroll
                for (int ct = 0; ct < 4; ++ct) v4[ct] = lerp4r(*(const LAS u32x2*)(zs + 35 * 144 + 32 * ct), *(const LAS u32x2*)(zs + 34 * 144 + 32 * ct), hm, *(const LAS f32x4*)(CS_ + C_MUV + 16 * ct + 4 * g));
                asm volatile("s_waitcnt lgkmcnt(0)" ::: "memory");
                f32x4 lg4[4];
#pragma unroll
                for (int ct = 0; ct < 4; ++ct)
#pragma unroll
                    for (int i = 0; i < 4; ++i) { float x = lw4[ct][i]; x += dpp_shr<1>(x); x += dpp_shr<2>(x); x += dpp_shr<4>(x); x += dpp_shr<8>(x); lg4[ct][i] = x; }
                s16x4v fAh[4], fBh[4], fKh[4], fRh[4];
                LAS bf16_t* imVV = (LAS bf16_t*)(slot + SL_VV); LAS bf16_t* imRH = (LAS bf16_t*)(slot + SL_RH); LAS bf16_t* imBB = (LAS bf16_t*)(slot + SL_BB); LAS bf16_t* imKB = (LAS bf16_t*)(slot + SL_KB); LAS bf16_t* imAH = (LAS bf16_t*)(slot + SL_Y);
#pragma unroll
                for (int ct = 0; ct < 4; ++ct) { f32x4 gg, gp, gi, gr, gc;
#pragma unroll
                    for (int i = 0; i < 4; ++i) { gg[i] = fexp(lg4[ct][i]); gi[i] = frcp(gg[i]); const float sh = dpp_shr<1>(gg[i]); gp[i] = n == 0 ? 1.0f : sh;
                        gc[i] = __shfl(gg[i], (lane & 48) | 15); gr[i] = gc[i] * gi[i]; }
                    fAh[ct] = pk4(an4[ct] * gp); fBh[ct] = pk4(bn4[ct] * gi); fKh[ct] = pk4(kn4[ct] * gi); fRh[ct] = pk4(r4[ct] * gg);
                    const int o = n * CS + 16 * ct + 4 * g;
                    *(LAS s16x4v*)(imAH + o) = fAh[ct]; *(LAS s16x4v*)(imRH + o) = fRh[ct]; *(LAS s16x4v*)(imVV + o) = pk4(v4[ct]);
                    *(LAS s16x4v*)(imBB + o) = pk4(bn4[ct] * gr); *(LAS s16x4v*)(imKB + o) = pk4(kn4[ct] * gr);
                    if (n == 15) *(LAS f32x4*)(slot + SL_GC + (16 * ct + 4 * g) * 4) = gc; }
                bf16x8 wG[4][4];
#pragma unroll
                for (int s2 = 0; s2 < 4; ++s2)
#pragma unroll
                    for (int ct = 0; ct < 4; ++ct) wG[s2][ct] = *(const bf16x8*)(gatT + (size_t)(((4 * h + ct) * 4 + s2) * 64 + lane) * 8);
                asm volatile("" ::: "memory");
                f32x4 dA = zero4, dAt = zero4, dKbT = zero4, dBr = zero4, dKr = zero4;
#pragma unroll
                for (int ct = 0; ct < 4; ++ct) { dA = mm16(fBh[ct], fAh[ct], dA); dAt = mm16(fAh[ct], fBh[ct], dAt); dKbT = mm16(fAh[ct], fKh[ct], dKbT); dBr = mm16(fBh[ct], fRh[ct], dBr); dKr = mm16(fKh[ct], fRh[ct], dKr); }
                f32x4 idn;
#pragma unroll
                for (int i = 0; i < 4; ++i) { const int m = 4 * g + i;
                    dA[i] = m < n ? dA[i] : 0.f; dAt[i] = n < m ? dAt[i] : 0.f; dKbT[i] = n < m ? dKbT[i] : 0.f; dBr[i] = m <= n ? dBr[i] : 0.f; dKr[i] = m <= n ? dKr[i] : 0.f; idn[i] = m == n ? 1.0f : 0.f; }
                const s16x4v pA = pk4(dA), pAt = pk4(dAt);
                const f32x4 dA2 = mm16(pAt, pA, zero4), dA2t = mm16(pA, pAt, zero4);
                const s16x4v pA2 = pk4(dA2), pA2t = pk4(dA2t);
                const f32x4 dA4 = mm16(pA2t, pA2, zero4), dA4t = mm16(pA2, pA2t, zero4);
                const s16x4v pA4 = pk4(dA4), pA4t = pk4(dA4t);
                const f32x4 dA8 = mm16(pA4t, pA4, zero4);
                const f32x4 dT1 = mm16(pAt, pA2, idn + dA + dA2), dT1t = mm16(pA2, pAt, idn + dAt + dA2t);
                const s16x4v pT1 = pk4(dT1), pT1t = pk4(dT1t);
                const f32x4 dT2 = mm16(pT1t, pA4, dT1), dT2t = mm16(pA4, pT1t, dT1t);
                const f32x4 dT = mm16(pk4(dT2t), pk4(dA8), dT2);
                const s16x4v pT = pk4(dT);
                const f32x4 dX = mm16(pk4(dKbT), pT, zero4);
                const s16x4v pX = pk4(dX);
                *(LAS s16x4v*)(slot + SL_ABR + lane * 8) = pk4(dBr); *(LAS s16x4v*)(slot + SL_AKR + lane * 8) = pk4(dKr);
                asm volatile("s_waitcnt lgkmcnt(0)" ::: "memory");
                const unsigned aAH = (unsigned)(size_t)(imAH + (4 * g + (n >> 2)) * CS + 4 * (n & 3)), aVV = (unsigned)(size_t)(imVV + (4 * g + (n >> 2)) * CS + 4 * (n & 3));
#pragma unroll
                for (int jt = 0; jt < 4; ++jt) {
                    const f32x4 d = mm16(pT, trread(aAH + 32 * jt), zero4);
                    *(LAS s16x4v*)(slot + SL_AB + ((16 * jt + n) * 24 + 4 * g) * 2) = pk4(d); }
#pragma unroll
                for (int it = 0; it < 4; ++it) {
                    const f32x4 d = mm16(pX, trread(aVV + 32 * it), zero4);
                    *(LAS s16x4v*)(slot + SL_WT + (it * 64 + lane) * 8) = pk4(d); }
                asm volatile("" ::: "memory");
                gate4[0] = zero4; gate4[1] = zero4; gate4[2] = zero4; gate4[3] = zero4;
#pragma unroll
                for (int s2 = 0; s2 < 4; ++s2) { const bf16x8 xg = xg_[s2];
#pragma unroll
                    for (int ct = 0; ct < 4; ++ct) gate4[ct] = __builtin_amdgcn_mfma_f32_16x16x32_bf16(wG[s2][ct], xg, gate4[ct], 0, 0, 0); }
            }
            __syncthreads();
            if (iv + 1 < NIV) RW_LOADZ(iv + 1, lane, 0, 5);
            if (wid < 4) {
                const int it = wid;
                struct Ops { s16x4v ab[4], bb[4], kb[4], vf, rh[4], abr, akr; u32x2 wt; f32x4 gc[4]; };
                const unsigned oAB = (unsigned)(size_t)(lds + SL_AB + ((4 * g + (n >> 2)) * 24 + 4 * (n & 3)) * 2);
                const unsigned oBB = (unsigned)(size_t)((LAS bf16_t*)(lds + SL_BB) + (4 * g + (n >> 2)) * CS + 4 * (n & 3));
                const unsigned oKB = (unsigned)(size_t)((LAS bf16_t*)(lds + SL_KB) + (4 * g + (n >> 2)) * CS + 4 * (n & 3));
                const unsigned oVV = (unsigned)(size_t)((LAS bf16_t*)(lds + SL_VV) + (4 * g + (n >> 2)) * CS + 16 * it + 4 * (n & 3));
#define CH_ISSUE(P, sl_) do { const unsigned so_ = (unsigned)((sl_) * SL_SIZE); LAS unsigned char* S8 = lds + (sl_) * SL_SIZE; \
                    asm volatile("ds_read_b64_tr_b16 %0, %13\n\tds_read_b64_tr_b16 %1, %13 offset:768\n\tds_read_b64_tr_b16 %2, %13 offset:1536\n\tds_read_b64_tr_b16 %3, %13 offset:2304\n\t" \
                                 "ds_read_b64_tr_b16 %4, %14\n\tds_read_b64_tr_b16 %5, %14 offset:32\n\tds_read_b64_tr_b16 %6, %14 offset:64\n\tds_read_b64_tr_b16 %7, %14 offset:96\n\t" \
                                 "ds_read_b64_tr_b16 %8, %15\n\tds_read_b64_tr_b16 %9, %15 offset:32\n\tds_read_b64_tr_b16 %10, %15 offset:64\n\tds_read_b64_tr_b16 %11, %15 offset:96\n\t" \
                                 "ds_read_b64_tr_b16 %12, %16" \
                                 : "=&v"(P.ab[0]), "=&v"(P.ab[1]), "=&v"(P.ab[2]), "=&v"(P.ab[3]), "=&v"(P.bb[0]), "=&v"(P.bb[1]), "=&v"(P.bb[2]), "=&v"(P.bb[3]), \
                                   "=&v"(P.kb[0]), "=&v"(P.kb[1]), "=&v"(P.kb[2]), "=&v"(P.kb[3]), "=&v"(P.vf) \
                                 : "v"(oAB + so_), "v"(oBB + so_), "v"(oKB + so_), "v"(oVV + so_) : "memory"); \
                    const LAS bf16_t* rh_ = (const LAS bf16_t*)(S8 + SL_RH) + n * CS + 4 * g; \
                    P.rh[0] = *(const LAS s16x4v*)(rh_); P.rh[1] = *(const LAS s16x4v*)(rh_ + 16); P.rh[2] = *(const LAS s16x4v*)(rh_ + 32); P.rh[3] = *(const LAS s16x4v*)(rh_ + 48); \
                    P.abr = *(const LAS s16x4v*)(S8 + SL_ABR + lane * 8); P.akr = *(const LAS s16x4v*)(S8 + SL_AKR + lane * 8); P.wt = *(const LAS u32x2*)(S8 + SL_WT + (it * 64 + lane) * 8); \
                    _Pragma("unroll") for (int jt = 0; jt < 4; ++jt) P.gc[jt] = *(const LAS f32x4*)(S8 + SL_GC + (16 * jt + 4 * g) * 4); } while (0)
#define CH_WAIT(P) asm volatile("s_waitcnt lgkmcnt(0)" : "+v"(P.ab[0]), "+v"(P.ab[1]), "+v"(P.ab[2]), "+v"(P.ab[3]), "+v"(P.bb[0]), "+v"(P.bb[1]), "+v"(P.bb[2]), "+v"(P.bb[3]), \
                                   "+v"(P.kb[0]), "+v"(P.kb[1]), "+v"(P.kb[2]), "+v"(P.kb[3]), "+v"(P.vf) :: "memory")
#define CH_COMPUTE(P, sl_) do { \
                    const s16x4v sf0 = pk4(ST[0]), sf1 = pk4(ST[1]), sf2 = pk4(ST[2]), sf3 = pk4(ST[3]); \
                    f32x4 U = (f32x4){bf_lo(P.wt.x), bf_hi(P.wt.x), bf_lo(P.wt.y), bf_hi(P.wt.y)}; \
                    U = mm16(P.ab[0], sf0, U); U = mm16(P.ab[1], sf1, U); U = mm16(P.ab[2], sf2, U); U = mm16(P.ab[3], sf3, U); \
                    const s16x4v uf = pk4(U); \
                    ST[0] = mm16(P.kb[0], P.vf, mm16(P.bb[0], uf, ST[0] * P.gc[0])); ST[1] = mm16(P.kb[1], P.vf, mm16(P.bb[1], uf, ST[1] * P.gc[1])); \
                    ST[2] = mm16(P.kb[2], P.vf, mm16(P.bb[2], uf, ST[2] * P.gc[2])); ST[3] = mm16(P.kb[3], P.vf, mm16(P.bb[3], uf, ST[3] * P.gc[3])); \
                    f32x4 Y = mm16(P.rh[0], sf0, zero4); Y = mm16(P.rh[1], sf1, Y); Y = mm16(P.rh[2], sf2, Y); Y = mm16(P.rh[3], sf3, Y); \
                    Y = mm16(P.abr, uf, Y); Y = mm16(P.akr, P.vf, Y); \
                    LAS bf16_t* yo = (LAS bf16_t*)(lds + (sl_) * SL_SIZE + SL_Y) + 16 * it + n; const unsigned y01 = pkv(Y[0], Y[1]), y23 = pkv(Y[2], Y[3]); \
                    yo[(4 * g + 0) * CS] = (bf16_t)(y01 & 0xffff); yo[(4 * g + 1) * CS] = (bf16_t)(y01 >> 16); yo[(4 * g + 2) * CS] = (bf16_t)(y23 & 0xffff); yo[(4 * g + 3) * CS] = (bf16_t)(y23 >> 16); } while (0)
                Ops A_, B_;
                CH_ISSUE(A_, 0);
#pragma unroll 1
                for (int sl = 0; sl < 8; sl += 2) {
                    CH_WAIT(A_); CH_ISSUE(B_, sl + 1); CH_COMPUTE(A_, sl);
                    CH_WAIT(B_); if (sl + 2 < 8) CH_ISSUE(A_, sl + 2); CH_COMPUTE(B_, sl + 1);
                }
#undef CH_ISSUE
#undef CH_WAIT
#undef CH_COMPUTE
            }
            __syncthreads();
            {
                const LAS bf16_t* yi = (const LAS bf16_t*)(slot + SL_Y) + n * CS + 4 * g;
                f32x4 y[4]; float sm = 0.f;
#pragma unroll
                for (int ct = 0; ct < 4; ++ct) { y[ct] = up4(*(const LAS u32x2*)(yi + 16 * ct)); sm += (y[ct][0] + y[ct][1]) + (y[ct][2] + y[ct][3]); }
                sm += __shfl_xor(sm, 16); sm += __shfl_xor(sm, 32);
                const float mean = sm * (1.0f / 64.0f); float q = 0.f;
#pragma unroll
                for (int ct = 0; ct < 4; ++ct) { const f32x4 d = y[ct] - mean; q += (d[0] * d[0] + d[1] * d[1]) + (d[2] * d[2] + d[3] * d[3]); }
                q += __shfl_xor(q, 16); q += __shfl_xor(q, 32);
                const float rstd = rsqrtf(q * (1.0f / 64.0f) + GN_EPS);
                bf16_t* ym = (bf16_t*)(p.ws + WS_YMIX) + (size_t)(b * SEQ + t) * DM + 512 + 64 * h;
#pragma unroll
                for (int ct = 0; ct < 4; ++ct) { const int cl = 16 * ct + 4 * g;
                    const f32x4 lw = *(const LAS f32x4*)(CS_ + C_LW + cl), lb = *(const LAS f32x4*)(CS_ + C_LB + cl);
                    const f32x4 o = ((y[ct] - mean) * rstd * lw + lb + bonus * v4[ct]) * gate4[ct];
                    u32x2 w; w.x = cvt_pk_bf16(o[0], o[1]); w.y = cvt_pk_bf16(o[2], o[3]);
                    *(u32x2*)(ym + cl) = w; }
            }
        }
        __syncthreads();
    }
}

constexpr int KSTR = 72;
constexpr int VSTR = 80;
constexpr int A_K = 0;
constexpr int A_VT = 3 * 128 * KSTR * 2;
constexpr int A_END = A_VT + 3 * 128 * VSTR * 2;
constexpr int A_STG = A_END;
static_assert(A_STG + 8 * 2560 <= 159 * 1024, "attn lds");

__device__ __forceinline__ void phase_attn(const Params& p, LAS unsigned char* lds) {
    const int tid = threadIdx.x, w = __builtin_amdgcn_readfirstlane(tid >> 6), lane = tid & 63, ql = lane & 15, g = lane >> 4;
    const bf16_t* z = (const bf16_t*)(p.ws + WS_Z);
    LAS bf16_t* Ks = (LAS bf16_t*)(lds + A_K); LAS bf16_t* VT = (LAS bf16_t*)(lds + A_VT);
    constexpr float SC = 0.125f * 1.4426950408889634f;
    for (int i = tid; i < A_END / 16; i += 512) *(LAS u32x4*)(lds + A_K + i * 16) = (u32x4){0u, 0u, 0u, 0u};
    const int srow = tid >> 3, sc8 = tid & 7;
    for (int bh = blockIdx.x; bh < 256; bh += gridDim.x) {
        const int b = bh >> 3, h = bh & 7;
        const bf16_t* zb = z + (size_t)b * SEQ * INW + 64 * h;
        float* stA_O = (float*)(p.ws + WS_STA + (size_t)bh * ST_BYTES_PER_BH); float* stA_ML = stA_O + SEQ * 64;
        float* stB_O = (float*)(p.ws + WS_STB + (size_t)bh * ST_BYTES_PER_BH); float* stB_ML = stB_O + SEQ * 64;
        u32x4 kq[2], vq[2];
#define ATT_DECODE(u_, pat_, d_, r_, n_) const int pat_ = 2 - (u_) / 16, d_ = pat_ == 0 ? 1 : (pat_ == 1 ? 4 : 16), nb_##u_ = 16 / d_, r_ = ((u_) % 16) / nb_##u_, n_ = ((u_) % 16) % nb_##u_
#define ATT_LOAD(d_, r_, n_) do { _Pragma("unroll") for (int it = 0; it < 2; ++it) { const bf16_t* zr = zb + (size_t)((128 * (n_) + srow + 64 * it) * (d_) + (r_)) * INW + sc8 * 8; \
            kq[it] = *(const u32x4*)(zr + 512); vq[it] = *(const u32x4*)(zr + 1024); } } while (0)
#define ATT_STORE(slot_) ATT_STORE_ROW((slot_) * 128)
#define ATT_STORE_ROW(rb_) do { _Pragma("unroll") for (int it = 0; it < 2; ++it) { const int row = (rb_) + srow + 64 * it; \
            *(LAS u32x4*)(Ks + row * KSTR + sc8 * 8) = kq[it]; *(LAS u32x4*)(VT + row * VSTR + sc8 * 8) = vq[it]; } } while (0)
        LAS unsigned char* stg = lds + A_STG + w * 2560;
#define STG_Q(i_) ((LAS u32x4*)(stg + (i_) * 1024 + lane * 16))
#define STG_ML ((LAS f32x2*)(stg + 2048 + lane * 8))
        __syncthreads();
        { ATT_LOAD(16, 0, 0); ATT_STORE(0);
          const bf16_t* zq0 = zb + (size_t)((16 * w + ql) * 16) * INW;
          *STG_Q(0) = *(const u32x4*)(zq0 + 8 * g); *STG_Q(1) = *(const u32x4*)(zq0 + 32 + 8 * g); }
        __syncthreads();
        int cb = 0, pb = 256, nbk = 128;
        for (int u = 0; u < 48; ++u) {
            ATT_DECODE(u, pat, d, r, n);
            const int tq = (128 * n + 16 * w + ql) * d + r;
            float* outO = pat == 2 ? stA_O : stB_O; float* outML = pat == 2 ? stA_ML : stB_ML;
            const bf16x8 qf0 = __builtin_bit_cast(bf16x8, *STG_Q(0)), qf1 = __builtin_bit_cast(bf16x8, *STG_Q(1));
            float m_prev = -INFINITY, l_prev = 0.f;
            f32x4 accO[4];
#pragma unroll
            for (int dt = 0; dt < 4; ++dt) accO[dt] = (f32x4){0.f, 0.f, 0.f, 0.f};
            const bool oddq = (ql & 1) != 0;
            const int tqA = (128 * n + 16 * w + (ql & ~1)) * d + r;
            if (pat != 2) { const f32x2 ml = *STG_ML; m_prev = ml.x; l_prev = ml.y; const unsigned char* inO = (const unsigned char*)(pat == 1 ? stA_O : stB_O) + (oddq ? 64 : 0) + 16 * g;
                const u32x4 la = *(const u32x4*)(inO + (size_t)tqA * 128), lb = *(const u32x4*)(inO + (size_t)(tqA + d) * 128);
                const u32x4 rcv = xchg1(oddq ? la : lb); const u32x4 w0 = oddq ? rcv : la, w1 = oddq ? lb : rcv;
                accO[0] = (f32x4){bf_lo(w0.x), bf_hi(w0.x), bf_lo(w0.y), bf_hi(w0.y)}; accO[1] = (f32x4){bf_lo(w0.z), bf_hi(w0.z), bf_lo(w0.w), bf_hi(w0.w)};
                accO[2] = (f32x4){bf_lo(w1.x), bf_hi(w1.x), bf_lo(w1.y), bf_hi(w1.y)}; accO[3] = (f32x4){bf_lo(w1.z), bf_hi(w1.z), bf_lo(w1.w), bf_hi(w1.w)}; }
            asm volatile("s_waitcnt lgkmcnt(0)" ::: "memory");
            u32x4 nq0 = (u32x4){0u, 0u, 0u, 0u}, nq1 = nq0; f32x2 nml = (f32x2){0.f, 0.f};
            bool nstate = false;
            if (u + 1 < 48) { const int u1 = u + 1; ATT_DECODE(u1, pat1, d1, r1, n1); ATT_LOAD(d1, r1, n1);
                const int tq1 = (128 * n1 + 16 * w + ql) * d1 + r1;
                const bf16_t* zq1 = zb + (size_t)tq1 * INW;
                nq0 = *(const u32x4*)(zq1 + 8 * g); nq1 = *(const u32x4*)(zq1 + 32 + 8 * g);
                if (pat1 != 2) { nstate = true; const float* inML = pat1 == 1 ? stA_ML : stB_ML; nml = *(const f32x2*)(inML + tq1 * 2); } }
            int rbx[9];
#pragma unroll
            for (int x = 0; x < 9; ++x) rbx[x] = (x <= 7 - w) ? pb + 16 * (w + x) : cb + 16 * (x - (8 - w));
            u32x2 vt[9][4];
#define ATT_VISSUE(x0_) do { const unsigned a0_ = (unsigned)(size_t)(VT + (rbx[x0_] + 4 * g + (ql >> 2)) * VSTR + 4 * (ql & 3)), a1_ = (unsigned)(size_t)(VT + (rbx[x0_ + 1] + 4 * g + (ql >> 2)) * VSTR + 4 * (ql & 3)), \
                                                   a2_ = (unsigned)(size_t)(VT + (rbx[x0_ + 2] + 4 * g + (ql >> 2)) * VSTR + 4 * (ql & 3)); \
                asm volatile("ds_read_b64_tr_b16 %0, %12\n\tds_read_b64_tr_b16 %1, %12 offset:32\n\tds_read_b64_tr_b16 %2, %12 offset:64\n\tds_read_b64_tr_b16 %3, %12 offset:96\n\t" \
                             "ds_read_b64_tr_b16 %4, %13\n\tds_read_b64_tr_b16 %5, %13 offset:32\n\tds_read_b64_tr_b16 %6, %13 offset:64\n\tds_read_b64_tr_b16 %7, %13 offset:96\n\t" \
                             "ds_read_b64_tr_b16 %8, %14\n\tds_read_b64_tr_b16 %9, %14 offset:32\n\tds_read_b64_tr_b16 %10, %14 offset:64\n\tds_read_b64_tr_b16 %11, %14 offset:96" \
                             : "=&v"(vt[x0_][0]), "=&v"(vt[x0_][1]), "=&v"(vt[x0_][2]), "=&v"(vt[x0_][3]), "=&v"(vt[x0_ + 1][0]), "=&v"(vt[x0_ + 1][1]), "=&v"(vt[x0_ + 1][2]), "=&v"(vt[x0_ + 1][3]), \
                               "=&v"(vt[x0_ + 2][0]), "=&v"(vt[x0_ + 2][1]), "=&v"(vt[x0_ + 2][2]), "=&v"(vt[x0_ + 2][3]) : "v"(a0_), "v"(a1_), "v"(a2_) : "memory"); } while (0)
            ATT_VISSUE(0); ATT_VISSUE(3); ATT_VISSUE(6);
#undef ATT_VISSUE
            bf16x8 kf0[9], kf1[9];
#pragma unroll
            for (int x = 0; x < 9; ++x) { const LAS bf16_t* kp = Ks + (rbx[x] + ql) * KSTR + 8 * g; kf0[x] = *(const LAS bf16x8*)kp; kf1[x] = *(const LAS bf16x8*)(kp + 32); }
            f32x4 sc[9];
#pragma unroll
            for (int x = 0; x < 9; ++x) {
                const bool prev = (x <= 7 - w);
                f32x4 a = (f32x4){0.f, 0.f, 0.f, 0.f};
                a = __builtin_amdgcn_mfma_f32_16x16x32_bf16(kf0[x], qf0, a, 0, 0, 0);
                a = __builtin_amdgcn_mfma_f32_16x16x32_bf16(kf1[x], qf1, a, 0, 0, 0);
#pragma unroll
                for (int i = 0; i < 4; ++i) { const int kl = 4 * g + i; bool ok = true;
                    if (prev) ok = (n > 0) && (x > 0 || kl >= ql); else ok = (x < 8) || (kl <= ql);
                    a[i] = ok ? a[i] * SC : -INFINITY; }
                sc[x] = a;
            }
            float mx = -INFINITY;
#pragma unroll
            for (int x = 0; x < 9; ++x) mx = fmaxf(mx, fmaxf(fmaxf(sc[x][0], sc[x][1]), fmaxf(sc[x][2], sc[x][3])));
            mx = fmaxf(mx, __shfl_xor(mx, 16)); mx = fmaxf(mx, __shfl_xor(mx, 32));
            const float m_new = fmaxf(m_prev, mx);
            float ls = 0.f;
#pragma unroll
            for (int x = 0; x < 9; ++x)
#pragma unroll
                for (int i = 0; i < 4; ++i) { const float e = __builtin_amdgcn_exp2f(sc[x][i] - m_new); sc[x][i] = e; ls += e; }
            ls += __shfl_xor(ls, 16); ls += __shfl_xor(ls, 32);
            const float alpha = __builtin_amdgcn_exp2f(m_prev - m_new);
            const float l_new = l_prev * alpha + ls;
#pragma unroll
            for (int dt = 0; dt < 4; ++dt) accO[dt] = accO[dt] * alpha;
            asm volatile("s_waitcnt lgkmcnt(0)" : "+v"(vt[0][0]), "+v"(vt[0][1]), "+v"(vt[0][2]), "+v"(vt[0][3]), "+v"(vt[1][0]), "+v"(vt[1][1]), "+v"(vt[1][2]), "+v"(vt[1][3]), "+v"(vt[2][0]), "+v"(vt[2][1]), "+v"(vt[2][2]), "+v"(vt[2][3]),
                                                   "+v"(vt[3][0]), "+v"(vt[3][1]), "+v"(vt[3][2]), "+v"(vt[3][3]), "+v"(vt[4][0]), "+v"(vt[4][1]), "+v"(vt[4][2]), "+v"(vt[4][3]) :: "memory");
            asm volatile("" : "+v"(vt[5][0]), "+v"(vt[5][1]), "+v"(vt[5][2]), "+v"(vt[5][3]), "+v"(vt[6][0]), "+v"(vt[6][1]), "+v"(vt[6][2]), "+v"(vt[6][3]), "+v"(vt[7][0]), "+v"(vt[7][1]), "+v"(vt[7][2]), "+v"(vt[7][3]),
                             "+v"(vt[8][0]), "+v"(vt[8][1]), "+v"(vt[8][2]), "+v"(vt[8][3]) :: "memory");
#pragma unroll
            for (int s2 = 0; s2 < 5; ++s2) {
                const int x0 = 2 * s2, x1 = 2 * s2 + 1;
                u32x4 pw; pw.x = cvt_pk_bf16(sc[x0][0], sc[x0][1]); pw.y = cvt_pk_bf16(sc[x0][2], sc[x0][3]);
                if (x1 < 9) { pw.z = cvt_pk_bf16(sc[x1 < 9 ? x1 : 8][0], sc[x1 < 9 ? x1 : 8][1]); pw.w = cvt_pk_bf16(sc[x1 < 9 ? x1 : 8][2], sc[x1 < 9 ? x1 : 8][3]); } else { pw.z = 0u; pw.w = 0u; }
                const bf16x8 pf = __builtin_bit_cast(bf16x8, pw);
#pragma unroll
                for (int dt = 0; dt < 4; ++dt) {
                    const u32x2 lo = vt[x0][dt], hi = x1 < 9 ? vt[x1 < 9 ? x1 : 8][dt] : (u32x2){0u, 0u};
                    const u32x4 vw = (u32x4){lo.x, lo.y, hi.x, hi.y};
                    accO[dt] = __builtin_amdgcn_mfma_f32_16x16x32_bf16(__builtin_bit_cast(bf16x8, vw), pf, accO[dt], 0, 0, 0);
                }
            }
            if (pat != 0) {
                u32x4 w0, w1;
                w0.x = cvt_pk_bf16(accO[0][0], accO[0][1]); w0.y = cvt_pk_bf16(accO[0][2], accO[0][3]); w0.z = cvt_pk_bf16(accO[1][0], accO[1][1]); w0.w = cvt_pk_bf16(accO[1][2], accO[1][3]);
                w1.x = cvt_pk_bf16(accO[2][0], accO[2][1]); w1.y = cvt_pk_bf16(accO[2][2], accO[2][3]); w1.z = cvt_pk_bf16(accO[3][0], accO[3][1]); w1.w = cvt_pk_bf16(accO[3][2], accO[3][3]);
                const u32x4 rcv = xchg1(oddq ? w0 : w1);
                unsigned char* oO = (unsigned char*)outO + (oddq ? 64 : 0) + 16 * g;
                *(u32x4*)(oO + (size_t)tqA * 128) = oddq ? rcv : w0; *(u32x4*)(oO + (size_t)(tqA + d) * 128) = oddq ? w1 : rcv;
                if (g == 0) { outML[tq * 2] = m_new; outML[tq * 2 + 1] = l_new; }
            } else {
                const float il = frcp(l_new); float ss = 0.f;
#pragma unroll
                for (int dt = 0; dt < 4; ++dt) { accO[dt] = accO[dt] * il; ss += (accO[dt][0] * accO[dt][0] + accO[dt][1] * accO[dt][1]) + (accO[dt][2] * accO[dt][2] + accO[dt][3] * accO[dt][3]); }
                ss += __shfl_xor(ss, 16); ss += __shfl_xor(ss, 32);
                const float rs = rsqrtf(ss * (1.0f / 64.0f) + NORM_EPS);
                bf16_t* ym = (bf16_t*)(p.ws + WS_YMIX) + (size_t)(b * SEQ + tq) * DM + 64 * h;
#pragma unroll
                for (int dt = 0; dt < 4; ++dt) { const f32x4 gn = *(const f32x4*)(p.attn_out_gain + 64 * h + 16 * dt + 4 * g); const f32x4 o = accO[dt] * rs * gn;
                    u32x2 wv; wv.x = cvt_pk_bf16(o[0], o[1]); wv.y = cvt_pk_bf16(o[2], o[3]); *(u32x2*)(ym + 16 * dt + 4 * g) = wv; }
            }
            if (u + 1 < 48) { ATT_STORE_ROW(nbk); *STG_Q(0) = nq0; *STG_Q(1) = nq1;
                if (nstate) *STG_ML = nml; }
            { const int t_ = pb; pb = cb; cb = nbk; nbk = t_; }
            __syncthreads();
        }
#undef ATT_DECODE
#undef ATT_LOAD
#undef ATT_STORE
#undef ATT_STORE_ROW
#undef STG_Q
#undef STG_ML
        asm volatile("s_waitcnt vmcnt(0)" ::: "memory");
    }
}

constexpr int P4_WH = 0;
constexpr int P4_WL = 65536;
constexpr int P4_GN = 131072;
constexpr int P4_LG = P4_GN + 4096;
constexpr int P4_RS = P4_LG + 16384;
constexpr int P4_CNT = P4_RS + 512;
constexpr int P4_ASG = P4_CNT + 256;
constexpr int P4_GT = P4_ASG + 4096;
constexpr int P4_END = P4_GT + 4096;
static_assert(P4_END <= 158 * 1024, "router lds");

__device__ __forceinline__ void phase_router(const Params& p, LAS unsigned char* lds) {
    const int tid = threadIdx.x, wid = __builtin_amdgcn_readfirstlane(tid >> 6), lane = tid & 63, n = lane & 15, g = lane >> 4;
    LAS float* GN = (LAS float*)(lds + P4_GN); LAS float* LG = (LAS float*)(lds + P4_LG) + wid * 512; LAS float* RSD = (LAS float*)(lds + P4_RS) + wid * 16;
    LAS unsigned* cnt = (LAS unsigned*)(lds + P4_CNT); LAS unsigned* bas = cnt + 32; LAS unsigned* asg = (LAS unsigned*)(lds + P4_ASG);
    unsigned* ctl = (unsigned*)(p.ws + WS_CTL);
    int* list = (int*)(p.ws + WS_LIST); float* glist = (float*)(p.ws + WS_GLIST);
    LAS float* gtl = (LAS float*)(lds + P4_GT);
    unsigned char* h2 = p.ws + WS_H;
    const bf16_t* x1 = (const bf16_t*)(p.ws + WS_X1);
    for (int i = tid; i < 1024; i += 512) GN[i] = p.norm2_gain[i];
    for (int i0 = tid; i0 < 32 * 1024; i0 += 8 * 512) {
        float wv[8], gv[8];
#pragma unroll
        for (int j = 0; j < 8; ++j) { const int i = i0 + 512 * j; wv[j] = p.router_w[i]; gv[j] = p.norm2_gain[i >> 5]; }
#pragma unroll
        for (int j = 0; j < 8; ++j) { const int i = i0 + 512 * j, k = i >> 5, e = i & 31; const float w = wv[j] * gv[j];
            const unsigned hb = cvt_pk_bf16(w, 0.f) & 0xffffu; const float hf = __uint_as_float(hb << 16); const unsigned lb = cvt_pk_bf16(w - hf, 0.f) & 0xffffu;
            const int off = e * 2048 + ((((k >> 3) ^ (e & 15)) << 4) | ((k & 7) << 1));
            *(LAS bf16_t*)(lds + P4_WH + off) = (bf16_t)hb; *(LAS bf16_t*)(lds + P4_WL + off) = (bf16_t)lb; } }
    const float rb0 = p.router_b[lane & 31];
    for (int panel = blockIdx.x; panel < NTOK / 256; panel += gridDim.x) {
        if (tid < 32) cnt[tid] = 0u;
        __syncthreads();
        for (int tile = 0; tile < 2; ++tile) {
            const int tl0 = wid * 32 + tile * 16, tok0 = panel * 256 + tl0;
            bf16x8 raw[32];
            const bf16_t* xp = x1 + (size_t)(tok0 + n) * DM + 8 * g;
#pragma unroll
            for (int s2 = 0; s2 < 32; ++s2) raw[s2] = *(const bf16x8*)(xp + 32 * s2);
            f32x4 aq = (f32x4){0.f, 0.f, 0.f, 0.f};
#pragma unroll
            for (int s2 = 0; s2 < 32; ++s2) aq = __builtin_amdgcn_mfma_f32_16x16x32_bf16(raw[s2], raw[s2], aq, 0, 0, 0);
            { const int i = n & 3; const float d = i == 0 ? aq[0] : (i == 1 ? aq[1] : (i == 2 ? aq[2] : aq[3]));
              if (g == (n >> 2)) RSD[n] = rsqrtf(d * (1.0f / DM) + NORM_EPS); }
            asm volatile("s_waitcnt lgkmcnt(0)" ::: "memory");
            const float rs = RSD[n];
            f32x4 al[2] = {{0.f, 0.f, 0.f, 0.f}, {0.f, 0.f, 0.f, 0.f}};
            unsigned char* hp = h2 + (size_t)(tok0 + n) * DM + 8 * g;
#pragma unroll
            for (int s2 = 0; s2 < 32; ++s2) {
#pragma unroll
                for (int et = 0; et < 2; ++et) { const int e = 16 * et + n; const int off = e * 2048 + (((4 * s2 + g) ^ (e & 15)) << 4);
                    const bf16x8 wh = *(const LAS bf16x8*)(lds + P4_WH + off), wl = *(const LAS bf16x8*)(lds + P4_WL + off);
                    al[et] = __builtin_amdgcn_mfma_f32_16x16x32_bf16(raw[s2], wh, al[et], 0, 0, 0);
                    al[et] = __builtin_amdgcn_mfma_f32_16x16x32_bf16(raw[s2], wl, al[et], 0, 0, 0); }
                const f32x4 g0 = *(const LAS f32x4*)(GN + 32 * s2 + 8 * g), g1 = *(const LAS f32x4*)(GN + 32 * s2 + 8 * g + 4);
                const u32x4 rw = __builtin_bit_cast(u32x4, raw[s2]);
                const f32x4 v0 = (f32x4){bf_lo(rw.x), bf_hi(rw.x), bf_lo(rw.y), bf_hi(rw.y)} * g0 * rs, v1 = (f32x4){bf_lo(rw.z), bf_hi(rw.z), bf_lo(rw.w), bf_hi(rw.w)} * g1 * rs;
                *(u32x2*)(hp + 32 * s2) = (u32x2){pk4_fp8(v0[0], v0[1], v0[2], v0[3]), pk4_fp8(v1[0], v1[1], v1[2], v1[3])};
            }
            const float rbv0 = __shfl(rb0, n), rbv1 = __shfl(rb0, 16 + n);
#pragma unroll
            for (int i = 0; i < 4; ++i) { const float rsi = RSD[4 * g + i]; LG[(4 * g + i) * 32 + n] = al[0][i] * rsi + rbv0; LG[(4 * g + i) * 32 + 16 + n] = al[1][i] * rsi + rbv1; }
            asm volatile("s_waitcnt lgkmcnt(0)" ::: "memory");
            if (lane < 16) {
                float lv[32];
#pragma unroll
                for (int q = 0; q < 8; ++q) { const f32x4 t4 = *(const LAS f32x4*)(LG + lane * 32 + 4 * q); lv[4 * q] = t4[0]; lv[4 * q + 1] = t4[1]; lv[4 * q + 2] = t4[2]; lv[4 * q + 3] = t4[3]; }
                float tv[4]; int te[4];
#pragma unroll
                for (int k = 0; k < 4; ++k) { float bv = -INFINITY; int be = 0;
#pragma unroll
                    for (int e = 0; e < 32; ++e) { const bool taken = (k > 0 && te[0] == e) || (k > 1 && te[1] == e) || (k > 2 && te[2] == e); if (!taken && lv[e] > bv) { bv = lv[e]; be = e; } }
                    tv[k] = bv; te[k] = be; }
                const float e1 = fexp(tv[1] - tv[0]), e2 = fexp(tv[2] - tv[0]), e3 = fexp(tv[3] - tv[0]);
                const float isum = 1.0f / (1.0f + e1 + e2 + e3);
                const float gk[4] = {isum, e1 * isum, e2 * isum, e3 * isum};
                const int tl = tl0 + lane, tok = tok0 + lane;
#pragma unroll
                for (int k = 0; k < 4; ++k) { const unsigned pos = __hip_atomic_fetch_add(&cnt[te[k]], 1u, __ATOMIC_RELAXED, __HIP_MEMORY_SCOPE_WORKGROUP);
                    asg[tl * 4 + k] = ((unsigned)te[k] << 16) | pos; gtl[tl * 4 + k] = gk[k]; }
            }
            asm volatile("s_waitcnt lgkmcnt(0)" ::: "memory");
        }
        __syncthreads();
        if (tid < 32) bas[tid] = __hip_atomic_fetch_add(ctl + CW_CNT + 64 * tid, cnt[tid], __ATOMIC_RELAXED, __HIP_MEMORY_SCOPE_AGENT);
        __syncthreads();
        for (int i = tid; i < 1024; i += 512) { const unsigned a = asg[i]; const int e = a >> 16, pos = a & 0xffff; const size_t li = (size_t)e * NTOK + bas[e] + pos;
            list[li] = (panel * 256 + (i >> 2)) * 4 + (i & 3); glist[li] = gtl[i]; }
        __syncthreads();
    }
}

struct TileTab { int tb[33]; int cn[32]; };
__device__ __forceinline__ void build_tiletab(const Params& p, LAS TileTab* T) {
    if (threadIdx.x < 32) {
        const unsigned* ctl = (const unsigned*)(p.ws + WS_CTL);
        const int e = threadIdx.x, c = (int)__hip_atomic_load(ctl + CW_CNT + 64 * e, __ATOMIC_RELAXED, __HIP_MEMORY_SCOPE_AGENT), nt = (c + 255) >> 8;
        int incl = nt;
#pragma unroll
        for (int o = 1; o < 32; o <<= 1) { const int v = __shfl_up(incl, o); if (e >= o) incl += v; }
        T->cn[e] = c; T->tb[e] = incl - nt; if (e == 31) T->tb[32] = incl;
    }
    __syncthreads();
}
template <int NCT>
struct GroupProb {
    const char* Abase; const char* Bt; const int* list; const LAS TileTab* T; int ntiles, xcd, rank; bool gather;
    static constexpr int RPX = 32 / NCT;
    __device__ __forceinline__ void init(const void* A, const void* B, const int* list_, const LAS TileTab* T_, bool gather_) {
        Abase = (const char*)A; Bt = (const char*)B; list = list_; T = T_; gather = gather_; ntiles = T_->tb[32];
        const int c = blockIdx.x; xcd = c & 7; rank = c >> 3; }
    __device__ __forceinline__ bool next(int i, g8::Unit& u) const {
        if (rank >= 32) return false;
        const int rt = (i * 8 + xcd) * RPX + rank / NCT; if (rt >= ntiles) return false;
        int e = 0;
#pragma unroll
        for (int s = 16; s >= 1; s >>= 1) if (T->tb[e + s] <= rt) e += s;
        u.pm = rt; u.pn = rank % NCT; u.e = e; u.cnt = T->cn[e] - (rt - T->tb[e]) * 256; return true;
    }
    __device__ __forceinline__ unsigned a_off(const g8::Unit& u, int row) const {
        if (gather) { const int rc = row < u.cnt ? row : u.cnt - 1; const int tokn = list[(size_t)u.e * NTOK + (u.pm - T->tb[u.e]) * 256 + rc] >> 2; return (unsigned)tokn * 1024u; }
        return (unsigned)(u.pm * 256 + row) * 1024u;
    }
    template <bool CM> __device__ __forceinline__ const char* b_ptr(const g8::Unit& u, int half) const {
        if (NCT == 8) return Bt + ((size_t)u.e * 2048 + (size_t)half * 1024 + u.pn * 128) * 1024;
        return Bt + ((size_t)u.e * 1024 + u.pn * 256 + half * (CM ? 32 : 128)) * 1024;
    }
};
struct EpiHid {
    static constexpr bool PERM = true, COLMAP = false;
    unsigned char* H; const float* b1;
    __device__ __forceinline__ void prefetch(const g8::Unit& u, LAS unsigned char* my, int wid, int lane) const {
        const float* src = b1 + (size_t)u.e * 2048 + (lane >> 5) * 1024 + u.pn * 128 + (wid & 3) * 32 + (lane & 31);
        __builtin_amdgcn_global_load_lds((const unsigned*)src, (LAS unsigned*)my, 4, 0, 0);
    }
    __device__ __forceinline__ void operator()(const f32x4 (&acc)[2][2][4][2], const g8::Unit& u, int wr, int wc, int fr, int fq, LAS unsigned char* my) const {
        const int row0 = u.pm * 256 + wr * 64 + fr, col0 = u.pn * 128 + wc * 32 + 8 * fq;
        const f32x4 bg0 = *(const LAS f32x4*)(my + 32 * fq), bg1 = *(const LAS f32x4*)(my + 32 * fq + 16), bl0 = *(const LAS f32x4*)(my + 128 + 32 * fq), bl1 = *(const LAS f32x4*)(my + 128 + 32 * fq + 16);
        const f32x2 bg[4] = {{bg0[0], bg0[1]}, {bg0[2], bg0[3]}, {bg1[0], bg1[1]}, {bg1[2], bg1[3]}};
        const f32x2 bl[4] = {{bl0[0] + 1.0f, bl0[1] + 1.0f}, {bl0[2] + 1.0f, bl0[3] + 1.0f}, {bl1[0] + 1.0f, bl1[1] + 1.0f}, {bl1[2] + 1.0f, bl1[3] + 1.0f}};
        const f32x2 sc = {1.0f / W8_SCALE, 1.0f / W8_SCALE}, ce = {-1.702f * 1.4426950408889634f, -1.702f * 1.4426950408889634f}, one = {1.0f, 1.0f};
#pragma unroll
        for (int ai = 0; ai < 2; ++ai)
#pragma unroll
            for (int m = 0; m < 4; ++m) {
                f32x2 o[4];
#pragma unroll
                for (int q = 0; q < 4; ++q) {
                    const f32x4 ga = acc[ai][0][m][q >> 1], la = acc[ai][1][m][q >> 1];
                    const f32x2 gr = (q & 1) ? (f32x2){ga[2], ga[3]} : (f32x2){ga[0], ga[1]}, lr = (q & 1) ? (f32x2){la[2], la[3]} : (f32x2){la[0], la[1]};
                    f32x2 gl = __builtin_elementwise_fma(gr, sc, bg[q]), li = __builtin_elementwise_fma(lr, sc, bl[q]);
                    gl.x = fminf(gl.x, 7.0f); gl.y = fminf(gl.y, 7.0f);
                    li.x = __builtin_amdgcn_fmed3f(li.x, -6.0f, 8.0f); li.y = __builtin_amdgcn_fmed3f(li.y, -6.0f, 8.0f);
                    const f32x2 ex = gl * ce;
                    f32x2 den = {__builtin_amdgcn_exp2f(ex.x), __builtin_amdgcn_exp2f(ex.y)}; den = den + one;
                    const f32x2 rc = {__builtin_amdgcn_rcpf(den.x), __builtin_amdgcn_rcpf(den.y)};
                    o[q] = (gl * rc) * li; }
                u32x2 w; w.x = pk4_fp8(o[0].x, o[0].y, o[1].x, o[1].y); w.y = pk4_fp8(o[2].x, o[2].y, o[3].x, o[3].y);
                *(u32x2*)(H + (size_t)(row0 + ai * 128 + m * 16) * FF + col0) = w; }
    }
};
struct EpiY2 {
    static constexpr bool PERM = true, COLMAP = true;
    unsigned char* Y; const float* b2; const int* list; const float* gate; const LAS TileTab* T;
    __device__ __forceinline__ void prefetch(const g8::Unit& u, LAS unsigned char* my, int wid, int lane) const {
        const size_t lb = (size_t)u.e * NTOK + (u.pm - T->tb[u.e]) * 256;
#pragma unroll
        for (int ai = 0; ai < 2; ++ai) { const int r = ai * 128 + (wid >> 2) * 64 + lane, rc = r < u.cnt ? r : u.cnt - 1;
            __builtin_amdgcn_global_load_lds((const unsigned*)(list + lb + rc), (LAS unsigned*)(my + ai * 256), 4, 0, 0);
            __builtin_amdgcn_global_load_lds((const unsigned*)(gate + lb + rc), (LAS unsigned*)(my + 512 + ai * 256), 4, 0, 0); }
        __builtin_amdgcn_global_load_lds((const unsigned*)(b2 + (size_t)u.e * DM + u.pn * 256 + (wid & 3) * 64 + lane), (LAS unsigned*)(my + 1024), 4, 0, 0);
    }
    __device__ __forceinline__ void operator()(const f32x4 (&acc)[2][2][4][2], const g8::Unit& u, int wr, int wc, int fr, int fq, LAS unsigned char* my) const {
        const bool oddq = (fq & 1) != 0;
        const int colS = u.pn * 256 + wc * 64 + (oddq ? 32 + 8 * (fq - 1) : 8 * fq);
        f32x4 bv[2][2];
#pragma unroll
        for (int bj = 0; bj < 2; ++bj) { bv[bj][0] = *(const LAS f32x4*)(my + 1024 + 128 * bj + 32 * fq); bv[bj][1] = *(const LAS f32x4*)(my + 1024 + 128 * bj + 32 * fq + 16); }
        int dsts[2][4]; float gts[2][4];
#pragma unroll
        for (int ai = 0; ai < 2; ++ai)
#pragma unroll
            for (int m = 0; m < 4; ++m) { dsts[ai][m] = *(const LAS int*)(my + ai * 256 + (m * 16 + fr) * 4); gts[ai][m] = *(const LAS float*)(my + 512 + ai * 256 + (m * 16 + fr) * 4); }
#pragma unroll
        for (int ai = 0; ai < 2; ++ai)
#pragma unroll
            for (int m = 0; m < 4; ++m) { const int r = ai * 128 + wr * 64 + m * 16 + fr; const float gt = gts[ai][m];
                u32x2 pc[2];
#pragma unroll
                for (int bj = 0; bj < 2; ++bj) { const f32x4 v0 = (acc[ai][bj][m][0] * (1.0f / W8_SCALE) + bv[bj][0]) * gt, v1 = (acc[ai][bj][m][1] * (1.0f / W8_SCALE) + bv[bj][1]) * gt;
                    pc[bj] = (u32x2){pk4_fp8(v0[0], v0[1], v0[2], v0[3]), pk4_fp8(v1[0], v1[1], v1[2], v1[3])}; }
                const u32x2 snd = oddq ? pc[0] : pc[1];
                const u32x2 rcv = {(unsigned)__shfl_xor((int)snd.x, 16), (unsigned)__shfl_xor((int)snd.y, 16)};
                const u32x4 dat = oddq ? (u32x4){rcv.x, rcv.y, pc[1].x, pc[1].y} : (u32x4){pc[0].x, pc[0].y, rcv.x, rcv.y};
                if (r < u.cnt) *(u32x4*)(Y + (size_t)dsts[ai][m] * DM + colS) = dat; }
    }
};
__device__ __forceinline__ void phase_final(const Params& p) {
    const int lane = threadIdx.x & 63, wid = threadIdx.x >> 6;
    const unsigned char* y2 = p.ws + WS_Y2;
    f32x4 gn[4];
#pragma unroll
    for (int c = 0; c < 4; ++c) gn[c] = *(const f32x4*)(p.final_norm_gain + 256 * c + 4 * lane);
    for (int tok0 = (blockIdx.x * 8 + wid) * 4; tok0 < NTOK; tok0 += gridDim.x * 32) {
        u32x2 xb[4][4]; int yw[4][4][4];
#pragma unroll
        for (int q = 0; q < 4; ++q) { const bf16_t* x1r = (const bf16_t*)(p.ws + WS_X1) + (size_t)(tok0 + q) * DM;
#pragma unroll
            for (int c = 0; c < 4; ++c) xb[q][c] = *(const u32x2*)(x1r + 256 * c + 4 * lane);
#pragma unroll
            for (int k = 0; k < 4; ++k) { const unsigned char* yr = y2 + ((size_t)(tok0 + q) * 4 + k) * DM;
#pragma unroll
                for (int c = 0; c < 4; ++c) yw[q][k][c] = *(const int*)(yr + 256 * c + 4 * lane); } }
#pragma unroll
        for (int q = 0; q < 4; ++q) {
            f32x4 v[4];
#pragma unroll
            for (int c = 0; c < 4; ++c) v[c] = up4(xb[q][c]);
#pragma unroll
            for (int k = 0; k < 4; ++k)
#pragma unroll
                for (int c = 0; c < 4; ++c) { const int w = yw[q][k][c];
                    const f32x2 lo = __builtin_amdgcn_cvt_pk_f32_fp8(w, false), hi = __builtin_amdgcn_cvt_pk_f32_fp8(w, true);
                    v[c][0] += lo.x; v[c][1] += lo.y; v[c][2] += hi.x; v[c][3] += hi.y; }
            float ss = 0.f;
#pragma unroll
            for (int c = 0; c < 4; ++c) ss += (v[c][0] * v[c][0] + v[c][1] * v[c][1]) + (v[c][2] * v[c][2] + v[c][3] * v[c][3]);
            ss = wave_sum(ss);
            const float rs = rsqrtf(ss * (1.0f / DM) + NORM_EPS);
            float* xr = p.out + (size_t)(tok0 + q) * DM;
#pragma unroll
            for (int c = 0; c < 4; ++c) *(f32x4*)(xr + 256 * c + 4 * lane) = v[c] * rs * gn[c];
        }
    }
}

constexpr int LDS_BYTES = 163840;
constexpr int L_MISC = 159 * 1024;
__global__ void __launch_bounds__(512, 2) mega_fwd(Params p) {
    extern __shared__ __attribute__((aligned(16))) unsigned char lds_raw[];
    LAS unsigned char* lds = (LAS unsigned char*)lds_raw;
    volatile LAS unsigned* misc = (volatile LAS unsigned*)(lds + L_MISC);
    LAS TileTab* TT = (LAS TileTab*)(lds + L_MISC + 64);
    if (threadIdx.x < 4) misc[threadIdx.x] = 0u;
    __syncthreads();
    XcdBarrier bar = xcd_barrier_post((unsigned*)(p.ws + WS_CTL) + CW_BAR, misc);
    const int lo = p.ph_lo, hi = p.ph_hi;
#define IN(k) (lo <= (k) && (k) < hi)
    if (IN(0)) { phase0(p, lds); xcd_barrier(bar); }
    if (IN(1)) {
        g8::DenseProb S; S.init(p.ws + WS_H, p.ws + WS_WIN, NTOK, INW, (int)gridDim.x, (int)blockIdx.x);
        EpiZ E{(bf16_t*)(p.ws + WS_Z)};
        g8::gemm_phase<false>(lds, S, E);
        xcd_barrier(bar);
    }
    if (IN(2)) { rwkv_lora_act(p); xcd_barrier(bar); phase_rwkv(p, lds); __syncthreads(); phase_attn(p, lds); xcd_barrier(bar); }
    if (IN(3)) {
        g8::DenseProb S; S.init(p.ws + WS_YMIX, p.ws + WS_WOUT, NTOK, DM, (int)gridDim.x, (int)blockIdx.x);
        EpiX1 E{p.x, (bf16_t*)(p.ws + WS_X1)};
        g8::gemm_phase<false>(lds, S, E);
        xcd_barrier(bar);
    }
    if (IN(4)) { phase_router(p, lds); xcd_barrier(bar); }
    if (IN(5)) {
        build_tiletab(p, TT);
        GroupProb<8> S; S.init(p.ws + WS_H, p.ws + WS_W1T, (const int*)(p.ws + WS_LIST), TT, true);
        EpiHid E{p.ws + WS_HID, p.expert_b1};
        g8::gemm_phase<true>(lds, S, E);
        xcd_barrier(bar);
    }
    if (IN(6)) {
        build_tiletab(p, TT);
        GroupProb<4> S; S.init(p.ws + WS_HID, p.ws + WS_W2T, (const int*)(p.ws + WS_LIST), TT, false);
        EpiY2 E{p.ws + WS_Y2, p.expert_b2, (const int*)(p.ws + WS_LIST), (const float*)(p.ws + WS_GLIST), TT};
        g8::gemm_phase<true>(lds, S, E);
        xcd_barrier(bar);
    }
    if (IN(7)) phase_final(p);
#undef IN
}

extern "C" void kernel_launch(void* const* d_in, const int* in_sizes, int n_in, void* d_out, int out_size, void* d_ws, size_t ws_size, hipStream_t stream) {
    static int grid = 0;
    if (grid == 0) {
        if (n_in != 24 || out_size != NTOK * DM || ws_size < WS_END) { fprintf(stderr, "kernel_launch: unexpected shapes (n_in %d, out %d, ws %zu < %zu); nothing launched\n", n_in, out_size, ws_size, (size_t)WS_END); grid = -1; return; }
        int dev = 0, cus = 0, per_cu = 0;
        if (hipGetDevice(&dev) != hipSuccess || hipDeviceGetAttribute(&cus, hipDeviceAttributeMultiprocessorCount, dev) != hipSuccess) { grid = -1; return; }
        if (hipFuncSetAttribute((const void*)mega_fwd, hipFuncAttributeMaxDynamicSharedMemorySize, LDS_BYTES) != hipSuccess) { fprintf(stderr, "kernel_launch: hipFuncSetAttribute failed\n"); grid = -1; return; }
        if (hipOccupancyMaxActiveBlocksPerMultiprocessor(&per_cu, (const void*)mega_fwd, 512, LDS_BYTES) != hipSuccess || per_cu < 1) { fprintf(stderr, "kernel_launch: occupancy query says %d\n", per_cu); (void)hipGetLastError(); grid = -1; return; }
        grid = cus;
    }
    if (grid < 0) return;
    if (hipMemsetAsync((char*)d_ws + WS_CTL, 0, CTL_ZERO_BYTES, stream) != hipSuccess) return;
    Params p{};
    const float** pp = (const float**)&p;
    for (int i = 0; i < 24; ++i) pp[i] = (const float*)d_in[i];
    p.out = (float*)d_out; p.ws = (unsigned char*)d_ws;
    p.ph_lo = 0; p.ph_hi = 8;
    hipLaunchKernelGGL(mega_fwd, dim3(grid), dim3(512), LDS_BYTES, stream, p);
}
```

```cpp
#include <hip/hip_runtime.h>
#include <stdint.h>
#include <stdio.h>

#define LAS __attribute__((address_space(3)))
typedef unsigned short bf16_t;
typedef short bf16x8 __attribute__((ext_vector_type(8)));
typedef short s16x4 __attribute__((ext_vector_type(4)));
typedef float f32x4 __attribute__((ext_vector_type(4)));
typedef float f32x2 __attribute__((ext_vector_type(2)));
typedef unsigned u32x4 __attribute__((ext_vector_type(4)));
typedef unsigned u32x2 __attribute__((ext_vector_type(2)));

constexpr int NTOK = 65536, SEQ = 2048, DM = 1024, INW = 3328, NE = 32, FF = 1024, NH = 8;
constexpr int RW_OFF = 1536;
constexpr float NORM_EPS = 1e-5f, GN_EPS = 64e-5f;

constexpr size_t MiB = 1048576;
constexpr size_t WS_CTL   = 0;
constexpr size_t CTL_ZERO_BYTES = 65536;
constexpr size_t WS_WIN   = 2 * MiB;
constexpr size_t WS_WOUT  = WS_WIN + (size_t)INW * DM * 2;
constexpr size_t WS_DECUP = WS_WOUT + (size_t)DM * DM * 2;
constexpr size_t WS_ICLUP = WS_DECUP + 512 * 64 * 2;
constexpr size_t WS_GATUP = WS_ICLUP + 512 * 64 * 2;
constexpr size_t WS_W2T   = 12 * MiB;
constexpr size_t WS_W1T   = 76 * MiB;
constexpr size_t WS_LACT  = 140 * MiB;
constexpr size_t WS_H     = 204 * MiB;
constexpr size_t WS_TAIL  = 332 * MiB;
constexpr size_t WS_Z     = 472 * MiB;
constexpr size_t WS_YMIX  = 888 * MiB;
constexpr size_t WS_END   = 1016 * MiB;
static_assert(WS_GATUP + 512 * 128 * 2 <= WS_W2T, "small weights");
constexpr size_t WS_STA   = WS_H;
constexpr size_t ST_BYTES_PER_BH = (size_t)SEQ * 64 * 4 + (size_t)SEQ * 2 * 4;
constexpr size_t WS_STB   = WS_STA + 256 * ST_BYTES_PER_BH;
static_assert(WS_STB + 256 * ST_BYTES_PER_BH <= WS_Z, "state buffers");
constexpr size_t WS_LIST  = WS_TAIL;
constexpr size_t WS_GATE  = WS_TAIL + 8 * MiB;
constexpr size_t WS_GLIST = WS_TAIL + 16 * MiB;
constexpr size_t WS_HID   = WS_Z;
constexpr size_t WS_X1    = 736 * MiB;
constexpr size_t WS_Y2    = WS_W1T;
constexpr int CW_BAR = 0;
constexpr int CW_CNT = 4096;

#define XB_TMO      128
#define XB_XCNT(j)  (256  + 64 * (j))
#define XB_XSUB(j)  (1280 + 64 * (j))
#define XB_XGEN(j)  (2304 + 64 * (j))
#define XB_TOP      3328
#define XB_TOPGEN   3392
#define XCD_BAR_WORDS 3456
#define XB_SPIN_CAP (1u << 18)

__device__ __forceinline__ unsigned xb_ld(unsigned* p)              { return __hip_atomic_load(p, __ATOMIC_RELAXED, __HIP_MEMORY_SCOPE_AGENT); }
__device__ __forceinline__ unsigned xb_add(unsigned* p, unsigned v) { return __hip_atomic_fetch_add(p, v, __ATOMIC_RELAXED, __HIP_MEMORY_SCOPE_AGENT); }
__device__ __forceinline__ unsigned xb_xcc_id() { return (unsigned)__builtin_amdgcn_s_getreg((3 << 11) | 20) & 0xFu; }
#define XB_SPIN(cond, bar) do { unsigned _sp = 0; while (cond) { __builtin_amdgcn_s_sleep(1); \
    if ((++_sp & 255u) == 0u) { if (xb_ld(&(bar)[XB_TMO])) break; if (_sp > XB_SPIN_CAP) { atomicAdd(&(bar)[XB_TMO], 1u); break; } } } } while (0)

struct XcdBarrier { unsigned* bar; unsigned x; volatile LAS unsigned* st; };

__device__ __forceinline__ XcdBarrier xcd_barrier_post(unsigned* bar, volatile LAS unsigned* st) {
    XcdBarrier b; b.bar = bar; b.x = xb_xcc_id(); b.st = st;
    if (threadIdx.x == 0) (void)xb_add(&bar[XB_XCNT(b.x)], 1u);
    return b;
}
__device__ __forceinline__ void xcd_barrier_complete(unsigned* bar, unsigned x, unsigned& nloc, unsigned& nx) {
    const unsigned G = gridDim.x * gridDim.y * gridDim.z;
    unsigned sum, cnt, mine, sp = 0u;
    for (;;) {
        sum = 0u; cnt = 0u; mine = 0u;
#pragma unroll
        for (unsigned j = 0; j < 16; ++j) { const unsigned c = xb_ld(&bar[XB_XCNT(j)]); sum += c; cnt += (c > 0u) ? 1u : 0u; mine = (j == x) ? c : mine; }
        if (sum == G) break;
        __builtin_amdgcn_s_sleep(1);
        if ((++sp & 255u) == 0u) { if (xb_ld(&bar[XB_TMO])) break; if (sp > XB_SPIN_CAP) { atomicAdd(&bar[XB_TMO], 1u); break; } }
    }
    nloc = mine > 0u ? mine : 1u; nx = cnt > 0u ? cnt : 1u;
}
__device__ __forceinline__ void xcd_barrier(const XcdBarrier& b) {
    asm volatile("s_waitcnt vmcnt(0)" ::: "memory");
    __syncthreads();
    if (threadIdx.x == 0) {
        unsigned* bar = b.bar;
        __builtin_amdgcn_s_waitcnt(0);
        unsigned nloc = b.st[0], nx = b.st[1];
        if (nloc == 0u) { xcd_barrier_complete(bar, b.x, nloc, nx); b.st[0] = nloc; b.st[1] = nx; }
        const unsigned old = xb_add(&bar[XB_XSUB(b.x)], 1u);
        const unsigned gen = old / nloc;
        if (old + 1u == (gen + 1u) * nloc) {
            __builtin_amdgcn_fence(__ATOMIC_RELEASE, "agent");
            asm volatile("s_waitcnt vmcnt(0)" ::: "memory");
            const unsigned og = xb_add(&bar[XB_TOP], 1u);
            const unsigned tg = og / nx;
            if (og + 1u == (tg + 1u) * nx) xb_add(&bar[XB_TOPGEN], 1u);
            else XB_SPIN(xb_ld(&bar[XB_TOPGEN]) == tg, bar);
            __builtin_amdgcn_fence(__ATOMIC_ACQUIRE, "agent");
            xb_add(&bar[XB_XGEN(b.x)], 1u);
            asm volatile("s_waitcnt vmcnt(0)" ::: "memory");
        } else {
            XB_SPIN(xb_ld(&bar[XB_XGEN(b.x)]) == gen, bar);
            __builtin_amdgcn_fence(__ATOMIC_ACQUIRE, "agent");
            asm volatile("s_waitcnt vmcnt(0)" ::: "memory");
        }
    }
    __syncthreads();
}

__device__ __forceinline__ unsigned cvt_pk_bf16(float lo, float hi) { unsigned r; asm volatile("v_cvt_pk_bf16_f32 %0, %1, %2" : "=v"(r) : "v"(lo), "v"(hi)); return r; }
__device__ __forceinline__ float bf_lo(unsigned w) { return __uint_as_float(w << 16); }
__device__ __forceinline__ float bf_hi(unsigned w) { return __uint_as_float(w & 0xffff0000u); }
__device__ __forceinline__ float bf1(bf16_t v) { return __uint_as_float(((unsigned)v) << 16); }
template <int CTRL> __device__ __forceinline__ float dpp_f(float v) { return __int_as_float(__builtin_amdgcn_update_dpp(0, __float_as_int(v), CTRL, 0xf, 0xf, true)); }
__device__ __forceinline__ u32x4 xchg1(u32x4 v) { u32x4 r;
#pragma unroll
    for (int i = 0; i < 4; ++i) r[i] = (unsigned)__builtin_amdgcn_update_dpp(0, (int)v[i], 0xB1, 0xf, 0xf, true);
    return r; }
__device__ __forceinline__ float red8(float v)  { v += dpp_f<0xB1>(v); v += dpp_f<0x4E>(v); v += dpp_f<0x141>(v); return v; }
__device__ __forceinline__ float red16(float v) { v = red8(v); v += dpp_f<0x140>(v); return v; }
__device__ __forceinline__ float wave_sum(float v) { v = red16(v); v += __shfl_xor(v, 16); v += __shfl_xor(v, 32); return v; }
__device__ __forceinline__ float fexp(float x) { return __builtin_amdgcn_exp2f(x * 1.4426950408889634f); }
__device__ __forceinline__ float frcp(float x) { return __builtin_amdgcn_rcpf(x); }
__device__ __forceinline__ float sigmoidf_(float x) { return frcp(1.0f + fexp(-x)); }
__device__ __forceinline__ float ftanh(float x) { return 1.0f - 2.0f * frcp(1.0f + fexp(2.0f * x)); }

struct Params {
    const float *x, *norm1_gain, *w_in, *shift_mu, *decay_up, *decay_bias, *iclr_up, *iclr_bias, *gate_up,
                *k_k, *k_a, *r_k, *lnx_w, *lnx_b, *attn_out_gain, *w_out, *norm2_gain, *router_w, *router_b,
                *expert_w1, *expert_b1, *expert_w2, *expert_b2, *final_norm_gain;
    float* out;
    unsigned char* ws;
    int ph_lo, ph_hi;
};

__device__ __forceinline__ unsigned pk4_fp8(float a, float b, float c, float d) { int w = 0; w = __builtin_amdgcn_cvt_pk_fp8_f32(a, b, w, false); w = __builtin_amdgcn_cvt_pk_fp8_f32(c, d, w, true); return (unsigned)w; }
constexpr float W8_SCALE = 64.0f;
constexpr int SC_ONE = 0x7f7f7f7f, SC_W = 0x79797979;
struct TJob { const float* src; unsigned char* dst; int N, K, k0, n0, fp8; };
__device__ __forceinline__ TJob tjob(const Params& p, int j) {
    unsigned char* ws = p.ws; TJob t;
    constexpr int J_W1 = 32 * 16 * 8, J_W2 = 32 * 16 * 4, J_WIN = 16 * 13, J_WOUT = 16 * 4, J_DEC = 2, J_ICL = 2;
    if (j < J_W1) { const int e = j / 128, r = j % 128; t = TJob{p.expert_w1 + (size_t)e * DM * 2048, ws + WS_W1T + (size_t)e * 2048 * DM, 2048, DM, (r / 8) * 64, (r % 8) * 256, 1}; return t; }
    j -= J_W1;
    if (j < J_W2) { const int e = j / 64, r = j % 64; t = TJob{p.expert_w2 + (size_t)e * FF * DM, ws + WS_W2T + (size_t)e * DM * FF, DM, FF, (r / 4) * 64, (r % 4) * 256, 1}; return t; }
    j -= J_W2;
    if (j < J_WIN) { t = TJob{p.w_in, ws + WS_WIN, INW, DM, (j / 13) * 64, (j % 13) * 256, 0}; return t; }
    j -= J_WIN;
    if (j < J_WOUT) { t = TJob{p.w_out, ws + WS_WOUT, DM, DM, (j / 4) * 64, (j % 4) * 256, 0}; return t; }
    j -= J_WOUT;
    if (j < J_DEC) { t = TJob{p.decay_up, ws + WS_DECUP, 512, 64, 0, j * 256, 2}; return t; }
    j -= J_DEC;
    if (j < J_ICL) { t = TJob{p.iclr_up, ws + WS_ICLUP, 512, 64, 0, j * 256, 2}; return t; }
    j -= J_ICL;
    t = TJob{p.gate_up, ws + WS_GATUP, 512, 128, (j / 2) * 64, (j % 2) * 256, 2}; return t;
}
constexpr int T_NJOBS = 32 * 16 * 8 + 32 * 16 * 4 + 16 * 13 + 16 * 4 + 2 + 2 + 4;
constexpr int T_STR = 260;
__device__ __forceinline__ void phase0(const Params& p, LAS unsigned char* lds) {
    unsigned char* ws = p.ws;
    const int tid = threadIdx.x, lane = tid & 63, wid = tid >> 6;
    {
        f32x4 g[4];
        g[0] = *(const f32x4*)(p.norm1_gain + lane * 8); g[1] = *(const f32x4*)(p.norm1_gain + lane * 8 + 4);
        g[2] = *(const f32x4*)(p.norm1_gain + 512 + lane * 8); g[3] = *(const f32x4*)(p.norm1_gain + 512 + lane * 8 + 4);
        bf16_t* o = (bf16_t*)(ws + WS_H);
        for (int row0 = (blockIdx.x * 8 + wid) * 4; row0 < NTOK; row0 += gridDim.x * 32) {
            f32x4 v[4][4];
#pragma unroll
            for (int r = 0; r < 4; ++r) { const float* xr = p.x + (size_t)(row0 + r) * DM;
                v[r][0] = __builtin_nontemporal_load((const f32x4*)(xr + lane * 8)); v[r][1] = __builtin_nontemporal_load((const f32x4*)(xr + lane * 8 + 4)); v[r][2] = __builtin_nontemporal_load((const f32x4*)(xr + 512 + lane * 8)); v[r][3] = __builtin_nontemporal_load((const f32x4*)(xr + 512 + lane * 8 + 4)); }
#pragma unroll
            for (int r = 0; r < 4; ++r) {
                float ss = 0.f;
#pragma unroll
                for (int i = 0; i < 4; ++i) ss += v[r][i][0] * v[r][i][0] + v[r][i][1] * v[r][i][1] + v[r][i][2] * v[r][i][2] + v[r][i][3] * v[r][i][3];
                ss = wave_sum(ss);
                const float rs = rsqrtf(ss * (1.0f / DM) + NORM_EPS);
                f32x4 q[4];
#pragma unroll
                for (int i = 0; i < 4; ++i) q[i] = v[r][i] * rs * g[i];
                u32x4 w0, w1;
                w0.x = cvt_pk_bf16(q[0][0], q[0][1]); w0.y = cvt_pk_bf16(q[0][2], q[0][3]); w0.z = cvt_pk_bf16(q[1][0], q[1][1]); w0.w = cvt_pk_bf16(q[1][2], q[1][3]);
                w1.x = cvt_pk_bf16(q[2][0], q[2][1]); w1.y = cvt_pk_bf16(q[2][2], q[2][3]); w1.z = cvt_pk_bf16(q[3][0], q[3][1]); w1.w = cvt_pk_bf16(q[3][2], q[3][3]);
                *(u32x4*)(o + (size_t)(row0 + r) * DM + lane * 8) = w0;
                *(u32x4*)(o + (size_t)(row0 + r) * DM + 512 + lane * 8) = w1;
            }
        }
    }
    LAS float* T0 = (LAS float*)lds; LAS float* T1 = T0 + 64 * T_STR;
    f32x4 rg[8];
    const int lr = tid >> 6, lc = (tid & 63) * 4;
#define T_LOAD(J) do { const TJob t_ = tjob(p, (J)); _Pragma("unroll") for (int i = 0; i < 8; ++i) rg[i] = __builtin_nontemporal_load((const f32x4*)(t_.src + (size_t)(t_.k0 + lr + 8 * i) * t_.N + t_.n0 + lc)); } while (0)
#define T_PARK(T) do { _Pragma("unroll") for (int i = 0; i < 8; ++i) *(LAS f32x4*)((T) + (lr + 8 * i) * T_STR + lc) = rg[i]; } while (0)
    int j = blockIdx.x;
    if (j < T_NJOBS) { T_LOAD(j); T_PARK(T0); }
    __syncthreads();
    for (int it = 0; j < T_NJOBS; j += gridDim.x, ++it) {
        const int jn = j + gridDim.x;
        if (jn < T_NJOBS) T_LOAD(jn);
        const TJob t = tjob(p, j);
        const LAS float* T = (it & 1) ? T1 : T0;
        {   const int n = tid >> 1, kh = tid & 1;
            float v[32];
#pragma unroll
            for (int i = 0; i < 32; ++i) v[i] = T[(32 * kh + i) * T_STR + n];
            if (t.fp8 == 1) {
                u32x4 w0, w1;
                w0.x = pk4_fp8(v[0] * W8_SCALE, v[1] * W8_SCALE, v[2] * W8_SCALE, v[3] * W8_SCALE); w0.y = pk4_fp8(v[4] * W8_SCALE, v[5] * W8_SCALE, v[6] * W8_SCALE, v[7] * W8_SCALE);
                w0.z = pk4_fp8(v[8] * W8_SCALE, v[9] * W8_SCALE, v[10] * W8_SCALE, v[11] * W8_SCALE); w0.w = pk4_fp8(v[12] * W8_SCALE, v[13] * W8_SCALE, v[14] * W8_SCALE, v[15] * W8_SCALE);
                w1.x = pk4_fp8(v[16] * W8_SCALE, v[17] * W8_SCALE, v[18] * W8_SCALE, v[19] * W8_SCALE); w1.y = pk4_fp8(v[20] * W8_SCALE, v[21] * W8_SCALE, v[22] * W8_SCALE, v[23] * W8_SCALE);
                w1.z = pk4_fp8(v[24] * W8_SCALE, v[25] * W8_SCALE, v[26] * W8_SCALE, v[27] * W8_SCALE); w1.w = pk4_fp8(v[28] * W8_SCALE, v[29] * W8_SCALE, v[30] * W8_SCALE, v[31] * W8_SCALE);
                unsigned char* d = t.dst + (size_t)(t.n0 + n) * t.K + t.k0 + 32 * kh;
                *(u32x4*)d = w0; *(u32x4*)(d + 16) = w1;
            } else {
                const int r = t.n0 + n;
                bf16_t* d = t.fp8 == 2 ? (bf16_t*)t.dst + ((size_t)(((r >> 4) * (t.K >> 5) + (t.k0 >> 5) + kh) * 64 + (r & 15))) * 8 : (bf16_t*)t.dst + (size_t)r * t.K + t.k0 + 32 * kh;
                const int qs = t.fp8 == 2 ? 128 : 8;
#pragma unroll
                for (int q = 0; q < 4; ++q) { u32x4 w; w.x = cvt_pk_bf16(v[8 * q], v[8 * q + 1]); w.y = cvt_pk_bf16(v[8 * q + 2], v[8 * q + 3]); w.z = cvt_pk_bf16(v[8 * q + 4], v[8 * q + 5]); w.w = cvt_pk_bf16(v[8 * q + 6], v[8 * q + 7]);
                    *(u32x4*)(d + qs * q) = w; }
            }
        }
        if (jn < T_NJOBS) { if (it & 1) T_PARK(T0); else T_PARK(T1); }
        __syncthreads();
    }
#undef T_LOAD
#undef T_PARK
}

namespace g8 {
constexpr int BM = 256, BK = 64, HALF = 128, HTB = HALF * BK * 2, STAGE_BYTES = 8 * HTB;
typedef int i32x8 __attribute__((ext_vector_type(8)));
typedef int i32x4v __attribute__((ext_vector_type(4)));
__device__ __forceinline__ int lds_byte(int r, int c) { const int st = (r >> 4) * 2 + (c >> 5), rr = r & 15, cc = c & 31, ob = rr * 64 + cc * 2; return st * 1024 + (ob ^ (((ob >> 9) & 1) << 5)); }
__device__ __forceinline__ void stage_rc(int b, int& R, int& C) { const int st = b / 1024, sb = b % 1024, swz = sb ^ (((sb >> 9) & 1) << 5); R = (st >> 1) * 16 + swz / 64; C = (st & 1) * 32 + (swz % 64) / 2; }
__device__ __forceinline__ int perm32(int rho) { const int n = rho >> 4, i = rho & 15; return 8 * (i >> 2) + 4 * n + (i & 3); }

struct Unit { int pm, pn, e, cnt; };

template <bool FP8, class Prob, class Epi>
__device__ __forceinline__ void gemm_phase(LAS unsigned char* lds, const Prob& S, const Epi& E) {
    constexpr int KB = FP8 ? 1024 : 2048, NT = KB / 128;
    const int tid = threadIdx.x, wid = __builtin_amdgcn_readfirstlane(tid >> 6), lane = tid & 63, wr = wid >> 2, wc = wid & 3, fr = lane & 15, fq = lane >> 4;
    unsigned voffB[2];
#pragma unroll
    for (int i = 0; i < 2; ++i) { int R, C; stage_rc(tid * 16 + i * 8192, R, C); const int Rb = Epi::COLMAP ? (64 * (R >> 5) + perm32(R & 31)) : (Epi::PERM ? ((R & ~31) + perm32(R & 31)) : R); voffB[i] = (unsigned)(Rb * KB + C * 2); }
#define G8_AOFF(dst, U) do { _Pragma("unroll") for (int i_ = 0; i_ < 2; ++i_) { int R_, C_; stage_rc(tid * 16 + i_ * 8192, R_, C_); \
        _Pragma("unroll") for (int h_ = 0; h_ < 2; ++h_) dst[h_][i_] = S.a_off(U, h_ * HALF + R_) + (unsigned)(C_ * 2); } } while (0)
    const unsigned ldsw = (unsigned)wid * 1024u;
    const int aoff = lds_byte(wr * 64 + fr, fq * 8), boff = lds_byte(wc * 32 + fr, fq * 8);
    const char* const Abase = S.Abase;
#define G8_SA(b, h) (((b) * 2 + (h)) * HTB)
#define G8_SB(b, h) ((4 + (b) * 2 + (h)) * HTB)
#define G8_GLDS(gp, bufoff, i) __builtin_amdgcn_global_load_lds((const unsigned*)(gp), (LAS unsigned*)(lds + (bufoff) + ldsw + (i) * 8192), 16, 0, 0)
#define G8_STA(bufoff, AO, h, kb) do { const char* ak_ = Abase + (kb); G8_GLDS(ak_ + (AO)[h][0], bufoff, 0); G8_GLDS(ak_ + (AO)[h][1], bufoff, 1); } while (0)
#define G8_STB(bufoff, bp) do { G8_GLDS((bp) + voffB[0], bufoff, 0); G8_GLDS((bp) + voffB[1], bufoff, 1); } while (0)
#define G8_LDA(dst, b, h) do { _Pragma("unroll") for (int m = 0; m < 4; ++m) _Pragma("unroll") for (int k = 0; k < 2; ++k) dst[m][k] = *(const LAS bf16x8*)(lds + G8_SA(b, h) + aoff + m * 2048 + k * 1024); } while (0)
#define G8_LDB(dst, b, h) do { _Pragma("unroll") for (int n = 0; n < 2; ++n) _Pragma("unroll") for (int k = 0; k < 2; ++k) dst[n][k] = *(const LAS bf16x8*)(lds + G8_SB(b, h) + boff + n * 2048 + k * 1024); } while (0)
#define G8_MMA(ai, bj, At, Bt) do { __builtin_amdgcn_s_setprio(1); \
        if (FP8) { i32x8 wf_[2], xf_[4]; \
            _Pragma("unroll") for (int n = 0; n < 2; ++n) wf_[n] = __builtin_shufflevector(__builtin_bit_cast(i32x4v, Bt[n][0]), __builtin_bit_cast(i32x4v, Bt[n][1]), 0, 1, 2, 3, 4, 5, 6, 7); \
            _Pragma("unroll") for (int m = 0; m < 4; ++m) xf_[m] = __builtin_shufflevector(__builtin_bit_cast(i32x4v, At[m][0]), __builtin_bit_cast(i32x4v, At[m][1]), 0, 1, 2, 3, 4, 5, 6, 7); \
            asm volatile("s_nop 1" ::: "memory"); \
            _Pragma("unroll") for (int m = 0; m < 4; ++m) _Pragma("unroll") for (int n = 0; n < 2; ++n) \
                asm volatile("v_mfma_f32_16x16x128_f8f6f4 %0, %1, %2, %0" : "+v"(acc[ai][bj][m][n]) : "v"(wf_[n]), "v"(xf_[m])); } \
        else { _Pragma("unroll") for (int m = 0; m < 4; ++m) _Pragma("unroll") for (int n = 0; n < 2; ++n) _Pragma("unroll") for (int k = 0; k < 2; ++k) \
            acc[ai][bj][m][n] = __builtin_amdgcn_mfma_f32_16x16x32_bf16(Bt[n][k], At[m][k], acc[ai][bj][m][n], 0, 0, 0); } \
        __builtin_amdgcn_s_setprio(0); } while (0)
#define G8_WAIT_V(n) asm volatile("s_waitcnt vmcnt(" #n ")" ::: "memory")
#define G8_WAIT_L(n) asm volatile("s_waitcnt lgkmcnt(" #n ")" ::: "memory")
#define G8_BAR __builtin_amdgcn_s_barrier()
#define G8_SCHED __builtin_amdgcn_sched_barrier(0)
    Unit cur, nxt; int ui = 0;
    if (!S.next(0, cur)) return;
    f32x4 acc[2][2][4][2];
#pragma unroll
    for (int a = 0; a < 2; ++a)
#pragma unroll
        for (int b = 0; b < 2; ++b)
#pragma unroll
            for (int m = 0; m < 4; ++m)
#pragma unroll
                for (int n = 0; n < 2; ++n) acc[a][b][m][n] = (f32x4){0.f, 0.f, 0.f, 0.f};
    bf16x8 At[4][2], B0[2][2], B1[2][2];
    unsigned ao[2][2], nao[2][2];
    G8_AOFF(ao, cur);
    const char* cB[2] = {S.template b_ptr<Epi::COLMAP>(cur, 0), S.template b_ptr<Epi::COLMAP>(cur, 1)};
    G8_STB(G8_SB(0, 0), cB[0]); G8_STA(G8_SA(0, 0), ao, 0, 0); G8_STB(G8_SB(0, 1), cB[1]); G8_STA(G8_SA(0, 1), ao, 1, 0);
    if (wr == 1) G8_BAR;
    G8_WAIT_V(4); G8_BAR;
    G8_STB(G8_SB(1, 0), cB[0] + 128); G8_STA(G8_SA(1, 0), ao, 0, 128); G8_STB(G8_SB(1, 1), cB[1] + 128);
    G8_WAIT_V(6); G8_BAR;
    for (;;) {
        E.prefetch(cur, lds + STAGE_BYTES + wid * 2048, wid, lane);
        const bool has_next = S.next(ui + 1, nxt);
        const char* nB[2];
        if (has_next) {
            G8_AOFF(nao, nxt);
            nB[0] = S.template b_ptr<Epi::COLMAP>(nxt, 0); nB[1] = S.template b_ptr<Epi::COLMAP>(nxt, 1);
        } else {
#pragma unroll
            for (int h = 0; h < 2; ++h)
#pragma unroll
                for (int i = 0; i < 2; ++i) nao[h][i] = ao[h][i];
            nB[0] = cB[0]; nB[1] = cB[1];
        }
#pragma nounroll
        for (int t = 0; t < NT; t += 2) {
            const bool last = (t == NT - 2);
            const int kb1 = (t + 1) * 128, kb2 = last ? 0 : (t + 2) * 128;
            unsigned a2[2][2];
#pragma unroll
            for (int h = 0; h < 2; ++h)
#pragma unroll
                for (int i = 0; i < 2; ++i) a2[h][i] = last ? nao[h][i] : ao[h][i];
            const char* b20 = last ? nB[0] : cB[0] + (t + 2) * 128; const char* b21 = last ? nB[1] : cB[1] + (t + 2) * 128;
            G8_LDB(B0, 0, 0); G8_SCHED; G8_LDA(At, 0, 0); G8_STA(G8_SA(1, 1), ao, 1, kb1);
            G8_WAIT_L(8); G8_BAR; G8_WAIT_L(0); G8_MMA(0, 0, At, B0); G8_BAR; G8_SCHED;
            G8_LDB(B1, 0, 1); G8_STB(G8_SB(0, 0), b20);
            G8_BAR; G8_WAIT_L(0); G8_MMA(0, 1, At, B1); G8_BAR;
            G8_LDA(At, 0, 1); G8_STA(G8_SA(0, 0), a2, 0, kb2);
            G8_BAR; G8_WAIT_L(0); G8_MMA(1, 0, At, B0); G8_BAR; G8_SCHED;
            G8_STB(G8_SB(0, 1), b21);
            G8_WAIT_V(6); G8_BAR; G8_MMA(1, 1, At, B1); G8_BAR;
            G8_LDB(B0, 1, 0); G8_SCHED; G8_LDA(At, 1, 0); G8_STA(G8_SA(0, 1), a2, 1, kb2);
            G8_WAIT_L(8); G8_BAR; G8_WAIT_L(0); G8_MMA(0, 0, At, B0); G8_BAR; G8_SCHED;
            G8_LDB(B1, 1, 1); G8_STB(G8_SB(1, 0), b20 + 128);
            G8_BAR; G8_WAIT_L(0); G8_MMA(0, 1, At, B1); G8_BAR;
            G8_LDA(At, 1, 1); G8_STA(G8_SA(1, 0), a2, 0, kb2 + 128);
            G8_BAR; G8_WAIT_L(0); G8_MMA(1, 0, At, B0); G8_BAR; G8_SCHED;
            G8_STB(G8_SB(1, 1), b21 + 128);
            G8_WAIT_V(6); G8_BAR; G8_MMA(1, 1, At, B1); G8_BAR;
        }
        if (FP8) asm volatile("s_nop 15\n\ts_nop 15" ::: "memory");
        E(acc, cur, wr, wc, fr, fq, lds + STAGE_BYTES + wid * 2048);
        if (!has_next) break;
#pragma unroll
        for (int a = 0; a < 2; ++a)
#pragma unroll
            for (int b = 0; b < 2; ++b)
#pragma unroll
                for (int m = 0; m < 4; ++m)
#pragma unroll
                    for (int n = 0; n < 2; ++n) acc[a][b][m][n] = (f32x4){0.f, 0.f, 0.f, 0.f};
        cur = nxt; cB[0] = nB[0]; cB[1] = nB[1]; ++ui;
#pragma unroll
        for (int h = 0; h < 2; ++h)
#pragma unroll
            for (int i = 0; i < 2; ++i) ao[h][i] = nao[h][i];
    }
    G8_WAIT_V(0);
    if (wr == 0) G8_BAR;
    G8_BAR;
#undef G8_SA
#undef G8_AOFF
#undef G8_SB
#undef G8_GLDS
#undef G8_STA
#undef G8_STB
#undef G8_LDA
#undef G8_LDB
#undef G8_MMA
#undef G8_WAIT_V
#undef G8_WAIT_L
#undef G8_BAR
#undef G8_SCHED
}

struct DenseProb {
    const char* Abase; const char* Bt; int nM, nN, nwg, G, c;
    __device__ __forceinline__ void init(const void* A, const void* B, int M, int N, int G_, int c_) { Abase = (const char*)A; Bt = (const char*)B; nM = M / BM; nN = N / BM; nwg = nM * nN; G = G_; c = c_; }
    __device__ __forceinline__ bool next(int i, Unit& u) const {
        const long L = (long)i * G + c; if (L >= nwg) return false;
        int wgid = (int)L; { const int q = nwg / 8, r = nwg % 8, xcd = wgid % 8, off = wgid / 8; wgid = (xcd < r ? xcd * (q + 1) : r * (q + 1) + (xcd - r) * q) + off; }
        const int nig = 8 * nN, gid = wgid / nig, fm = gid * 8, gsz = (nM - fm) < 8 ? (nM - fm) : 8;
        u.pm = fm + ((wgid % nig) % gsz); u.pn = (wgid % nig) / gsz; u.e = 0; u.cnt = 256; return true;
    }
    __device__ __forceinline__ unsigned a_off(const Unit& u, int row) const { return (unsigned)(u.pm * BM + row) * 2048u; }
    template <bool CM> __device__ __forceinline__ const char* b_ptr(const Unit& u, int half) const { return Bt + (size_t)(u.pn * BM + half * (CM ? 32 : HALF)) * 2048; }
};
}

struct EpiZ {
    static constexpr bool PERM = true, COLMAP = true;
    bf16_t* O;
    __device__ __forceinline__ void prefetch(const g8::Unit&, LAS unsigned char*, int, int) const {}
    __device__ __forceinline__ void operator()(const f32x4 (&acc)[2][2][4][2], const g8::Unit& u, int wr, int wc, int fr, int fq, LAS unsigned char*) const {
        const bool odd = (fr & 1) != 0;
        const int rowA = u.pm * 256 + wr * 64 + (fr & ~1), colS = u.pn * 256 + wc * 64 + 8 * fq + (odd ? 32 : 0);
#pragma unroll
        for (int ai = 0; ai < 2; ++ai)
#pragma unroll
            for (int m = 0; m < 4; ++m) { bf16_t* rowp = O + (size_t)(rowA + ai * 128 + m * 16) * INW + colS;
                u32x4 w[2];
#pragma unroll
                for (int bj = 0; bj < 2; ++bj) { const f32x4 v0 = acc[ai][bj][m][0], v1 = acc[ai][bj][m][1];
                    w[bj].x = cvt_pk_bf16(v0[0], v0[1]); w[bj].y = cvt_pk_bf16(v0[2], v0[3]); w[bj].z = cvt_pk_bf16(v1[0], v1[1]); w[bj].w = cvt_pk_bf16(v1[2], v1[3]); }
                const u32x4 snd = odd ? w[0] : w[1]; const u32x4 rcv = xchg1(snd);
                *(u32x4*)rowp = odd ? rcv : w[0]; *(u32x4*)(rowp + INW) = odd ? w[1] : rcv; }
    }
};
struct EpiX1 {
    static constexpr bool PERM = true, COLMAP = true;
    const float* X; bf16_t* O;
    __device__ __forceinline__ void prefetch(const g8::Unit&, LAS unsigned char*, int, int) const {}
    __device__ __forceinline__ void operator()(const f32x4 (&acc)[2][2][4][2], const g8::Unit& u, int wr, int wc, int fr, int fq, LAS unsigned char*) const {
        const bool odd = (fr & 1) != 0;
        const int row0 = u.pm * 256 + wr * 64 + fr, col0 = u.pn * 256 + wc * 64 + 8 * fq;
        const int rowA = u.pm * 256 + wr * 64 + (fr & ~1), colS = col0 + (odd ? 32 : 0);
#pragma unroll
        for (int ai = 0; ai < 2; ++ai) {
            f32x4 xv[4][2][2];
#pragma unroll
            for (int m = 0; m < 4; ++m) { const size_t off = (size_t)(row0 + ai * 128 + m * 16) * DM + col0;
#pragma unroll
                for (int bj = 0; bj < 2; ++bj) { xv[m][bj][0] = *(const f32x4*)(X + off + bj * 32); xv[m][bj][1] = *(const f32x4*)(X + off + bj * 32 + 4); } }
#pragma unroll
            for (int m = 0; m < 4; ++m) { bf16_t* rowp = O + (size_t)(rowA + ai * 128 + m * 16) * DM + colS;
                u32x4 w[2];
#pragma unroll
                for (int bj = 0; bj < 2; ++bj) { const f32x4 v0 = xv[m][bj][0] + acc[ai][bj][m][0], v1 = xv[m][bj][1] + acc[ai][bj][m][1];
                    w[bj].x = cvt_pk_bf16(v0[0], v0[1]); w[bj].y = cvt_pk_bf16(v0[2], v0[3]); w[bj].z = cvt_pk_bf16(v1[0], v1[1]); w[bj].w = cvt_pk_bf16(v1[2], v1[3]); }
                const u32x4 snd = odd ? w[0] : w[1]; const u32x4 rcv = xchg1(snd);
                *(u32x4*)rowp = odd ? rcv : w[0]; *(u32x4*)(rowp + DM) = odd ? w[1] : rcv; }
            asm volatile("" ::: "memory");
        }
    }
};

__device__ __forceinline__ f32x4 ld_bf4(const bf16_t* p) { const u32x2 w = *(const u32x2*)p; return (f32x4){bf_lo(w.x), bf_hi(w.x), bf_lo(w.y), bf_hi(w.y)}; }
__device__ __forceinline__ void ld_bf8(const bf16_t* p, float (&o)[8]) { const u32x4 w = *(const u32x4*)p; o[0] = bf_lo(w.x); o[1] = bf_hi(w.x); o[2] = bf_lo(w.y); o[3] = bf_hi(w.y); o[4] = bf_lo(w.z); o[5] = bf_hi(w.z); o[6] = bf_lo(w.w); o[7] = bf_hi(w.w); }
__device__ __forceinline__ void rwkv_lora_act(const Params& p) {
    const bf16_t* z = (const bf16_t*)(p.ws + WS_Z); bf16_t* act = (bf16_t*)(p.ws + WS_LACT);
    const int sub = threadIdx.x & 31;
    const int col = 8 * sub;
    const f32x4 m0 = *(const f32x4*)(p.shift_mu + 1536 + col), m1 = *(const f32x4*)(p.shift_mu + 1536 + col + 4);
    for (int tok0 = blockIdx.x * 16 + (threadIdx.x >> 5); tok0 < NTOK; tok0 += gridDim.x * 64) {
        u32x4 cw[4], pw[4];
#pragma unroll
        for (int q = 0; q < 4; ++q) { const int tok = tok0 + q * gridDim.x * 16; const bf16_t* zt = z + (size_t)tok * INW + 3072 + col;
            cw[q] = *(const u32x4*)zt; pw[q] = *(const u32x4*)(zt - ((tok & (SEQ - 1)) != 0 ? INW : 0)); }
#pragma unroll
        for (int q = 0; q < 4; ++q) { const int tok = tok0 + q * gridDim.x * 16;
            const float hm = (tok & (SEQ - 1)) != 0 ? 1.0f : 0.0f;
            const float c[8] = {bf_lo(cw[q].x), bf_hi(cw[q].x), bf_lo(cw[q].y), bf_hi(cw[q].y), bf_lo(cw[q].z), bf_hi(cw[q].z), bf_lo(cw[q].w), bf_hi(cw[q].w)};
            const float pv[8] = {bf_lo(pw[q].x), bf_hi(pw[q].x), bf_lo(pw[q].y), bf_hi(pw[q].y), bf_lo(pw[q].z), bf_hi(pw[q].z), bf_lo(pw[q].w), bf_hi(pw[q].w)};
            float v[8];
#pragma unroll
            for (int j = 0; j < 8; ++j) { const float mm = j < 4 ? m0[j] : m1[j - 4]; float x = c[j] + (pv[j] * hm - c[j]) * mm;
                if (col < 64) x = ftanh(x); else if (col >= 128) x = sigmoidf_(x); v[j] = x; }
            u32x4 w; w.x = cvt_pk_bf16(v[0], v[1]); w.y = cvt_pk_bf16(v[2], v[3]); w.z = cvt_pk_bf16(v[4], v[5]); w.w = cvt_pk_bf16(v[6], v[7]);
            *(u32x4*)(act + (size_t)tok * 256 + col) = w; }
    }
}
constexpr int C_MUR = 256, C_MUK = 320, C_MUV = 384, C_DB = 448, C_IB = 512, C_KK = 576, C_KA = 640, C_RK = 704, C_LW = 768, C_LB = 832, C_N = 896;
__device__ __forceinline__ f32x4 up4(u32x2 w) { return (f32x4){bf_lo(w.x), bf_hi(w.x), bf_lo(w.y), bf_hi(w.y)}; }
__device__ __forceinline__ f32x4 lerp4r(u32x2 cur, u32x2 prv, float hm, f32x4 m) { const f32x4 c = up4(cur); return c + (up4(prv) * hm - c) * m; }
constexpr int CK = 16, NIV = SEQ / (CK * 8);
constexpr int CS = 72;
constexpr int SL_VV = 0, SL_RH = 2304, SL_BB = 4608, SL_KB = 6912, SL_AB = 9216  , SL_WT = 12288  , SL_ABR = 14336, SL_AKR = 14848, SL_GC = 15360  ,
              SL_Y = 15616  , SL_SIZE = 17920;
constexpr int RC_CST = 8 * SL_SIZE;
static_assert(RC_CST + C_N * 4 <= 159 * 1024, "chunked rwkv lds");
typedef short s16x4v __attribute__((ext_vector_type(4)));
typedef __bf16 bf16x2t __attribute__((ext_vector_type(2)));
__device__ __forceinline__ unsigned pkv(float lo, float hi) { return __builtin_bit_cast(unsigned, __builtin_convertvector((f32x2){lo, hi}, bf16x2t)); }
__device__ __forceinline__ s16x4v pk4(f32x4 v) { u32x2 w; w.x = pkv(v[0], v[1]); w.y = pkv(v[2], v[3]); return __builtin_bit_cast(s16x4v, w); }
__device__ __forceinline__ f32x4 mm16(s16x4v a, s16x4v b, f32x4 c) { return __builtin_amdgcn_mfma_f32_16x16x16bf16_1k(a, b, c, 0, 0, 0); }
__device__ __forceinline__ bf16x8 cat8(s16x4v a, s16x4v b) { return __builtin_shufflevector(a, b, 0, 1, 2, 3, 4, 5, 6, 7); }
__device__ __forceinline__ f32x4 mm32(bf16x8 a, bf16x8 b, f32x4 c) { return __builtin_amdgcn_mfma_f32_16x16x32_bf16(a, b, c, 0, 0, 0); }
__device__ __forceinline__ s16x4v trread(unsigned addr) { s16x4v r; asm volatile("ds_read_b64_tr_b16 %0, %1\n\ts_waitcnt lgkmcnt(0)" : "=&v"(r) : "v"(addr) : "memory"); return r; }
template <int SH> __device__ __forceinline__ float dpp_shr(float v) { return __int_as_float(__builtin_amdgcn_update_dpp(0, __float_as_int(v), 0x110 + SH, 0xf, 0xf, true)); }

__device__ __forceinline__ void phase_rwkv(const Params& p, LAS unsigned char* lds) {
    const int tid = threadIdx.x, wid = __builtin_amdgcn_readfirstlane(tid >> 6), lane0 = tid & 63;
    const bf16_t* z = (const bf16_t*)(p.ws + WS_Z); const bf16_t* act = (const bf16_t*)(p.ws + WS_LACT);
    const bf16_t* decT = (const bf16_t*)(p.ws + WS_DECUP); const bf16_t* iclT = (const bf16_t*)(p.ws + WS_ICLUP); const bf16_t* gatT = (const bf16_t*)(p.ws + WS_GATUP);
    const f32x4 zero4 = (f32x4){0.f, 0.f, 0.f, 0.f};
    for (int bh = blockIdx.x; bh < 256; bh += gridDim.x) {
        const int b = bh >> 3, h = bh & 7;
        {
            LAS float* C = (LAS float*)(lds + RC_CST);
            for (int i = tid; i < C_N; i += 512) {
                float v;
                if (i < 256) v = 0.f;
                else if (i < 320) v = p.shift_mu[64 * h + (i - 256)];
                else if (i < 384) v = p.shift_mu[512 + 64 * h + (i - 320)];
                else if (i < 448) v = p.shift_mu[1024 + 64 * h + (i - 384)];
                else if (i < 512) v = p.decay_bias[64 * h + (i - 448)];
                else if (i < 576) v = p.iclr_bias[64 * h + (i - 512)];
                else if (i < 640) v = p.k_k[64 * h + (i - 576)];
                else if (i < 704) v = p.k_a[64 * h + (i - 640)];
                else if (i < 768) v = p.r_k[64 * h + (i - 704)];
                else if (i < 832) v = p.lnx_w[64 * h + (i - 768)];
                else v = p.lnx_b[64 * h + (i - 832)];
                C[i] = v;
            }
        }
        __syncthreads();
        const LAS float* CS_ = (const LAS float*)(lds + RC_CST);
        LAS unsigned char* slot = lds + wid * SL_SIZE;
        f32x4 ST[4] = {zero4, zero4, zero4, zero4};
        u32x4 zw[7];
#define RW_LOADZ(iv_, lane_, I0, I1) do { const int t0_ = CK * ((iv_) * 8 + wid); \
            _Pragma("unroll") for (int i = I0; i < I1; ++i) { const int idx_ = 64 * i + (lane_); int pz_ = idx_ >> 3; pz_ = pz_ > 50 ? 50 : pz_; const int a_ = pz_ >= 34 ? 2 : (pz_ >= 17 ? 1 : 0); \
                int tr_ = t0_ - 1 + pz_ - 17 * a_; tr_ = tr_ < 0 ? 0 : tr_; \
                zw[i] = *(const u32x4*)(z + (size_t)(b * SEQ + tr_) * INW + RW_OFF + 64 * h + 512 * a_ + 8 * (idx_ & 7)); } } while (0)
        RW_LOADZ(0, lane0, 0, 5);
#pragma nounroll
        for (int iv = 0; iv < NIV; ++iv) {
            int lane = lane0; asm volatile("" : "+v"(lane));
            const int n = lane & 15, g = lane >> 4;
            const int c = iv * 8 + wid, t = CK * c + n;
            f32x4 gate4[4], v4[4]; float bonus;
            {
                const bf16_t* zt = z + (size_t)(b * SEQ + t) * INW; const bf16_t* zp = zt - (t > 0 ? INW : 0);
                const float hm = t > 0 ? 1.0f : 0.0f;
                const bf16_t* at = act + (size_t)(b * SEQ + t) * 256 + 8 * g;
                const bf16_t* bt = zt + RW_OFF + 64 * h + 4 * g; const bf16_t* bp = zp + RW_OFF + 64 * h + 4 * g;
                f32x4 r4[4], k4[4], lw4[4], an4[4], bn4[4], kn4[4]; float ssq = 0.f;
                bf16x8 xw_[2], xa_[2], xg_[4];
#pragma unroll
                for (int s2 = 0; s2 < 2; ++s2) { xw_[s2] = *(const bf16x8*)(at + 32 * s2); xa_[s2] = *(const bf16x8*)(at + 64 + 32 * s2); }
#pragma unroll
                for (int s2 = 0; s2 < 4; ++s2) xg_[s2] = *(const bf16x8*)(at + 128 + 32 * s2);
                RW_LOADZ(iv, lane, 5, 7);
#define RW_PARK(I0, I1) do { _Pragma("unroll") for (int i = I0; i < I1; ++i) { const int idx = 64 * i + lane; int pz = idx >> 3; pz = pz > 50 ? 50 : pz; *(LAS u32x4*)(slot + pz * 144 + (idx & 7) * 16) = zw[i]; } } while (0)
                RW_PARK(0, 5);
                asm volatile("s_waitcnt lgkmcnt(0)" ::: "memory");
                const LAS unsigned char* zs = slot + n * 144 + 8 * g;
                u32x2 zk[4][2];
#pragma unroll
                for (int ct = 0; ct < 4; ++ct) { zk[ct][1] = *(const LAS u32x2*)(zs + 17 * 144 + 32 * ct); zk[ct][0] = *(const LAS u32x2*)(zs + 18 * 144 + 32 * ct); }
                bf16x8 wD[2][4];
#pragma unroll
                for (int s2 = 0; s2 < 2; ++s2)
#pragma unroll
                    for (int ct = 0; ct < 4; ++ct) wD[s2][ct] = *(const bf16x8*)(decT + (size_t)(((4 * h + ct) * 2 + s2) * 64 + lane) * 8);
                asm volatile("" ::: "memory");
#pragma unroll
                for (int ct = 0; ct < 4; ++ct) { const int cl = 16 * ct + 4 * g;
                    k4[ct] = lerp4r(zk[ct][0], zk[ct][1], hm, *(const LAS f32x4*)(CS_ + C_MUK + cl));
                    const f32x4 kk4 = k4[ct] * *(const LAS f32x4*)(CS_ + C_KK + cl); ssq += (kk4[0] * kk4[0] + kk4[1] * kk4[1]) + (kk4[2] * kk4[2] + kk4[3] * kk4[3]); }
                ssq += __shfl_xor(ssq, 16); ssq += __shfl_xor(ssq, 32);
                const float inv = frcp(fmaxf(sqrtf(ssq), 1e-12f));
                bf16x8 wI[2][4];
                {   f32x4 aw[4] = {zero4, zero4, zero4, zero4};
#pragma unroll
                    for (int s2 = 0; s2 < 2; ++s2) { const bf16x8 xw = xw_[s2];
#pragma unroll
                        for (int ct = 0; ct < 4; ++ct) aw[ct] = __builtin_amdgcn_mfma_f32_16x16x32_bf16(wD[s2][ct], xw, aw[ct], 0, 0, 0); }
#pragma unroll
                    for (int s2 = 0; s2 < 2; ++s2)
#pragma unroll
                        for (int ct = 0; ct < 4; ++ct) wI[s2][ct] = *(const bf16x8*)(iclT + (size_t)(((4 * h + ct) * 2 + s2) * 64 + lane) * 8);
                    asm volatile("" ::: "memory");
#pragma unroll
                    for (int ct = 0; ct < 4; ++ct) { const f32x4 db = *(const LAS f32x4*)(CS_ + C_DB + 16 * ct + 4 * g);
#pragma unroll
                        for (int i = 0; i < 4; ++i) { const float xm = -(db[i] + aw[ct][i]), sp = fmaxf(xm, 0.f) + 0.6931471805599453f * __builtin_amdgcn_logf(1.0f + fexp(-fabsf(xm))); lw4[ct][i] = -fexp(-sp - 0.5f); } } }
                asm volatile("" ::: "memory");
                float bon = 0.f;
                {   f32x4 aa[4] = {zero4, zero4, zero4, zero4};
#pragma unroll
                    for (int s2 = 0; s2 < 2; ++s2) { const bf16x8 xa = xa_[s2];
#pragma unroll
                        for (int ct = 0; ct < 4; ++ct) aa[ct] = __builtin_amdgcn_mfma_f32_16x16x32_bf16(wI[s2][ct], xa, aa[ct], 0, 0, 0); }
#pragma unroll
                    for (int ct = 0; ct < 4; ++ct) { const int cl = 16 * ct + 4 * g;
                        r4[ct] = lerp4r(*(const LAS u32x2*)(zs + 144 + 32 * ct), *(const LAS u32x2*)(zs + 32 * ct), hm, *(const LAS f32x4*)(CS_ + C_MUR + cl));
                        const f32x4 ib = *(const LAS f32x4*)(CS_ + C_IB + cl), kkw = *(const LAS f32x4*)(CS_ + C_KK + cl), kaw = *(const LAS f32x4*)(CS_ + C_KA + cl), rkw = *(const LAS f32x4*)(CS_ + C_RK + cl);
#pragma unroll
                        for (int i = 0; i < 4; ++i) { const float a = sigmoidf_(ib[i] + aa[ct][i]); const float kk = k4[ct][i] * kkw[i] * inv;
                            kn4[ct][i] = k4[ct][i] * (1.0f + (a - 1.0f) * kaw[i]); an4[ct][i] = -kk; bn4[ct][i] = kk * a; bon += r4[ct][i] * kn4[ct][i] * rkw[i]; } } }
                bon += __shfl_xor(bon, 16); bon += __shfl_xor(bon, 32); bonus = bon;
                asm volatile("" ::: "memory");
                RW_PARK(5, 7);
                asm volatile("s_waitcnt lgkmcnt(0)" ::: "memory");
#pragma unroll
                for (int ct = 0; ct < 4; ++ct) v4[ct] = lerp4r(*(const LAS u32x2*)(zs + 35 * 144 + 32 * ct), *(const LAS u32x2*)(zs + 34 * 144 + 32 * ct), hm, *(const LAS f32x4*)(CS_ + C_MUV + 16 * ct + 4 * g));
                asm volatile("s_waitcnt lgkmcnt(0)" ::: "memory");
                f32x4 lg4[4];
#pragma unroll
                for (int ct = 0; ct < 4; ++ct)
#pragma unroll
                    for (int i = 0; i < 4; ++i) { float x = lw4[ct][i]; x += dpp_shr<1>(x); x += dpp_shr<2>(x); x += dpp_shr<4>(x); x += dpp_shr<8>(x); lg4[ct][i] = x; }
                s16x4v fAh[4], fBh[4], fKh[4], fRh[4];
                LAS bf16_t* imVV = (LAS bf16_t*)(slot + SL_VV); LAS bf16_t* imRH = (LAS bf16_t*)(slot + SL_RH); LAS bf16_t* imBB = (LAS bf16_t*)(slot + SL_BB); LAS bf16_t* imKB = (LAS bf16_t*)(slot + SL_KB); LAS bf16_t* imAH = (LAS bf16_t*)(slot + SL_Y);
#pragma unroll
                for (int ct = 0; ct < 4; ++ct) { f32x4 gg, gp, gi, gr, gc;
#pragma unroll
                    for (int i = 0; i < 4; ++i) { gg[i] = fexp(lg4[ct][i]); gi[i] = frcp(gg[i]); const float sh = dpp_shr<1>(gg[i]); gp[i] = n == 0 ? 1.0f : sh;
                        gc[i] = __shfl(gg[i], (lane & 48) | 15); gr[i] = gc[i] * gi[i]; }
                    fAh[ct] = pk4(an4[ct] * gp); fBh[ct] = pk4(bn4[ct] * gi); fKh[ct] = pk4(kn4[ct] * gi); fRh[ct] = pk4(r4[ct] * gg);
                    const int o = n * CS + 16 * ct + 4 * g;
                    *(LAS s16x4v*)(imAH + o) = fAh[ct]; *(LAS s16x4v*)(imRH + o) = fRh[ct]; *(LAS s16x4v*)(imVV + o) = pk4(v4[ct]);
                    *(LAS s16x4v*)(imBB + o) = pk4(bn4[ct] * gr); *(LAS s16x4v*)(imKB + o) = pk4(kn4[ct] * gr);
                    if (n == 15) *(LAS f32x4*)(slot + SL_GC + (16 * ct + 4 * g) * 4) = gc; }
                bf16x8 wG[4][4];
#pragma unroll
                for (int s2 = 0; s2 < 4; ++s2)
#pragma unroll
                    for (int ct = 0; ct < 4; ++ct) wG[s2][ct] = *(const bf16x8*)(gatT + (size_t)(((4 * h + ct) * 4 + s2) * 64 + lane) * 8);
                asm volatile("" ::: "memory");
                f32x4 dA = zero4, dAt = zero4, dKbT = zero4, dBr = zero4, dKr = zero4;
#pragma unroll
                for (int ct = 0; ct < 4; ct += 2) { const bf16x8 a8 = cat8(fAh[ct], fAh[ct + 1]), b8 = cat8(fBh[ct], fBh[ct + 1]), k8 = cat8(fKh[ct], fKh[ct + 1]), r8 = cat8(fRh[ct], fRh[ct + 1]);
                    dA = mm32(b8, a8, dA); dAt = mm32(a8, b8, dAt); dKbT = mm32(a8, k8, dKbT); dBr = mm32(b8, r8, dBr); dKr = mm32(k8, r8, dKr); }
                f32x4 idn;
#pragma unroll
                for (int i = 0; i < 4; ++i) { const int m = 4 * g + i;
                    dA[i] = m < n ? dA[i] : 0.f; dAt[i] = n < m ? dAt[i] : 0.f; dKbT[i] = n < m ? dKbT[i] : 0.f; dBr[i] = m <= n ? dBr[i] : 0.f; dKr[i] = m <= n ? dKr[i] : 0.f; idn[i] = m == n ? 1.0f : 0.f; }
                const s16x4v pA = pk4(dA), pAt = pk4(dAt);
                const f32x4 dA2 = mm16(pAt, pA, zero4), dA2t = mm16(pA, pAt, zero4);
                const s16x4v pA2 = pk4(dA2), pA2t = pk4(dA2t);
                const f32x4 dA4 = mm16(pA2t, pA2, zero4), dA4t = mm16(pA2, pA2t, zero4);
                const s16x4v pA4 = pk4(dA4), pA4t = pk4(dA4t);
                const f32x4 dA8 = mm16(pA4t, pA4, zero4);
                const f32x4 dT1 = mm16(pAt, pA2, idn + dA + dA2), dT1t = mm16(pA2, pAt, idn + dAt + dA2t);
                const s16x4v pT1 = pk4(dT1), pT1t = pk4(dT1t);
                const f32x4 dT2 = mm16(pT1t, pA4, dT1), dT2t = mm16(pA4, pT1t, dT1t);
                const f32x4 dT = mm16(pk4(dT2t), pk4(dA8), dT2);
                const s16x4v pT = pk4(dT);
                const f32x4 dX = mm16(pk4(dKbT), pT, zero4);
                const s16x4v pX = pk4(dX);
                *(LAS s16x4v*)(slot + SL_ABR + lane * 8) = pk4(dBr); *(LAS s16x4v*)(slot + SL_AKR + lane * 8) = pk4(dKr);
                asm volatile("s_waitcnt lgkmcnt(0)" ::: "memory");
                const unsigned aAH = (unsigned)(size_t)(imAH + (4 * g + (n >> 2)) * CS + 4 * (n & 3)), aVV = (unsigned)(size_t)(imVV + (4 * g + (n >> 2)) * CS + 4 * (n & 3));
#pragma unroll
                for (int jt = 0; jt < 4; ++jt) {
                    const f32x4 d = mm16(pT, trread(aAH + 32 * jt), zero4);
                    *(LAS s16x4v*)(slot + SL_AB + ((16 * jt + n) * 24 + 4 * g) * 2) = pk4(d); }
#pragma unroll
                for (int it = 0; it < 4; ++it) {
                    const f32x4 d = mm16(pX, trread(aVV + 32 * it), zero4);
                    *(LAS s16x4v*)(slot + SL_WT + (it * 64 + lane) * 8) = pk4(d); }
                asm volatile("" ::: "memory");
                gate4[0] = zero4; gate4[1] = zero4; gate4[2] = zero4; gate4[3] = zero4;
#pragma unroll
                for (int s2 = 0; s2 < 4; ++s2) { const bf16x8 xg = xg_[s2];
#pragma unroll
                    for (int ct = 0; ct < 4; ++ct) gate4[ct] = __builtin_amdgcn_mfma_f32_16x16x32_bf16(wG[s2][ct], xg, gate4[ct], 0, 0, 0); }
            }
            __syncthreads();
            if (iv + 1 < NIV) RW_LOADZ(iv + 1, lane, 0, 5);
            if (wid < 4) {
                const int it = wid;
                struct Ops { s16x4v ab[4], bb[4], kb[4], vf, rh[4], abr, akr; u32x2 wt; f32x4 gc[4]; };
                const unsigned oAB = (unsigned)(size_t)(lds + SL_AB + ((4 * g + (n >> 2)) * 24 + 4 * (n & 3)) * 2);
                const unsigned oBB = (unsigned)(size_t)((LAS bf16_t*)(lds + SL_BB) + (4 * g + (n >> 2)) * CS + 4 * (n & 3));
                const unsigned oKB = (unsigned)(size_t)((LAS bf16_t*)(lds + SL_KB) + (4 * g + (n >> 2)) * CS + 4 * (n & 3));
                const unsigned oVV = (unsigned)(size_t)((LAS bf16_t*)(lds + SL_VV) + (4 * g + (n >> 2)) * CS + 16 * it + 4 * (n & 3));
                const unsigned oRH = (unsigned)(size_t)((LAS bf16_t*)(lds + SL_RH) + n * CS + 4 * g), oABR = (unsigned)(size_t)(lds + SL_ABR + lane * 8);
                const unsigned oWT = (unsigned)(size_t)(lds + SL_WT + (it * 64 + lane) * 8), oGC = (unsigned)(size_t)(lds + SL_GC + 16 * g);
#define CH_ISSUE(P, sl_) do { const unsigned so_ = (unsigned)((sl_) * SL_SIZE); \
                    asm volatile("ds_read_b64_tr_b16 %0, %13\n\tds_read_b64_tr_b16 %1, %13 offset:768\n\tds_read_b64_tr_b16 %2, %13 offset:1536\n\tds_read_b64_tr_b16 %3, %13 offset:2304\n\t" \
                                 "ds_read_b64_tr_b16 %4, %14\n\tds_read_b64_tr_b16 %5, %14 offset:32\n\tds_read_b64_tr_b16 %6, %14 offset:64\n\tds_read_b64_tr_b16 %7, %14 offset:96\n\t" \
                                 "ds_read_b64_tr_b16 %8, %15\n\tds_read_b64_tr_b16 %9, %15 offset:32\n\tds_read_b64_tr_b16 %10, %15 offset:64\n\tds_read_b64_tr_b16 %11, %15 offset:96\n\t" \
                                 "ds_read_b64_tr_b16 %12, %16" \
                                 : "=&v"(P.ab[0]), "=&v"(P.ab[1]), "=&v"(P.ab[2]), "=&v"(P.ab[3]), "=&v"(P.bb[0]), "=&v"(P.bb[1]), "=&v"(P.bb[2]), "=&v"(P.bb[3]), \
                                   "=&v"(P.kb[0]), "=&v"(P.kb[1]), "=&v"(P.kb[2]), "=&v"(P.kb[3]), "=&v"(P.vf) \
                                 : "v"(oAB + so_), "v"(oBB + so_), "v"(oKB + so_), "v"(oVV + so_) : "memory"); \
                      \
                    asm volatile("ds_read_b64 %0, %11\n\tds_read_b64 %1, %11 offset:32\n\tds_read_b64 %2, %11 offset:64\n\tds_read_b64 %3, %11 offset:96\n\t" \
                                 "ds_read_b64 %4, %12\n\tds_read_b64 %5, %12 offset:512\n\tds_read_b64 %6, %13\n\t" \
                                 "ds_read_b128 %7, %14\n\tds_read_b128 %8, %14 offset:64\n\tds_read_b128 %9, %14 offset:128\n\tds_read_b128 %10, %14 offset:192" \
                                 : "=&v"(P.rh[0]), "=&v"(P.rh[1]), "=&v"(P.rh[2]), "=&v"(P.rh[3]), "=&v"(P.abr), "=&v"(P.akr), "=&v"(P.wt), "=&v"(P.gc[0]), "=&v"(P.gc[1]), "=&v"(P.gc[2]), "=&v"(P.gc[3]) \
                                 : "v"(oRH + so_), "v"(oABR + so_), "v"(oWT + so_), "v"(oGC + so_) : "memory"); } while (0)
#define CH_WAIT(P) asm volatile("s_waitcnt lgkmcnt(0)" : "+v"(P.ab[0]), "+v"(P.ab[1]), "+v"(P.ab[2]), "+v"(P.ab[3]), "+v"(P.bb[0]), "+v"(P.bb[1]), "+v"(P.bb[2]), "+v"(P.bb[3]), \
                                   "+v"(P.kb[0]), "+v"(P.kb[1]), "+v"(P.kb[2]), "+v"(P.kb[3]), "+v"(P.vf), "+v"(P.rh[0]), "+v"(P.rh[1]), "+v"(P.rh[2]), "+v"(P.rh[3]), "+v"(P.abr), "+v"(P.akr), "+v"(P.wt), \
                                   "+v"(P.gc[0]), "+v"(P.gc[1]), "+v"(P.gc[2]), "+v"(P.gc[3]) :: "memory")
#define CH_COMPUTE(P, sl_) do { \
                    const s16x4v sf0 = pk4(ST[0]), sf1 = pk4(ST[1]), sf2 = pk4(ST[2]), sf3 = pk4(ST[3]); \
                    f32x4 U = (f32x4){bf_lo(P.wt.x), bf_hi(P.wt.x), bf_lo(P.wt.y), bf_hi(P.wt.y)}; \
                    const bf16x8 sf01 = cat8(sf0, sf1), sf23 = cat8(sf2, sf3); \
                    U = mm32(cat8(P.ab[0], P.ab[1]), sf01, U); U = mm32(cat8(P.ab[2], P.ab[3]), sf23, U); \
                    const bf16x8 ufvf = cat8(pk4(U), P.vf); \
                    ST[0] = mm32(cat8(P.bb[0], P.kb[0]), ufvf, ST[0] * P.gc[0]); ST[1] = mm32(cat8(P.bb[1], P.kb[1]), ufvf, ST[1] * P.gc[1]); \
                    ST[2] = mm32(cat8(P.bb[2], P.kb[2]), ufvf, ST[2] * P.gc[2]); ST[3] = mm32(cat8(P.bb[3], P.kb[3]), ufvf, ST[3] * P.gc[3]); \
                    f32x4 Y = mm32(cat8(P.rh[0], P.rh[1]), sf01, zero4); Y = mm32(cat8(P.rh[2], P.rh[3]), sf23, Y); Y = mm32(cat8(P.abr, P.akr), ufvf, Y); \
                    LAS bf16_t* yo = (LAS bf16_t*)(lds + (sl_) * SL_SIZE + SL_Y) + 16 * it + n; const unsigned y01 = pkv(Y[0], Y[1]), y23 = pkv(Y[2], Y[3]); \
                    yo[(4 * g + 0) * CS] = (bf16_t)(y01 & 0xffff); yo[(4 * g + 1) * CS] = (bf16_t)(y01 >> 16); yo[(4 * g + 2) * CS] = (bf16_t)(y23 & 0xffff); yo[(4 * g + 3) * CS] = (bf16_t)(y23 >> 16); } while (0)
                Ops A_, B_;
                CH_ISSUE(A_, 0);
#pragma unroll 1
                for (int sl = 0; sl < 8; sl += 2) {
                    CH_WAIT(A_); CH_ISSUE(B_, sl + 1); CH_COMPUTE(A_, sl);
                    CH_WAIT(B_); if (sl + 2 < 8) CH_ISSUE(A_, sl + 2); CH_COMPUTE(B_, sl + 1);
                }
#undef CH_ISSUE
#undef CH_WAIT
#undef CH_COMPUTE
            }
            __syncthreads();
            {
                const LAS bf16_t* yi = (const LAS bf16_t*)(slot + SL_Y) + n * CS + 4 * g;
                f32x4 y[4]; float sm = 0.f;
#pragma unroll
                for (int ct = 0; ct < 4; ++ct) { y[ct] = up4(*(const LAS u32x2*)(yi + 16 * ct)); sm += (y[ct][0] + y[ct][1]) + (y[ct][2] + y[ct][3]); }
                sm += __shfl_xor(sm, 16); sm += __shfl_xor(sm, 32);
                const float mean = sm * (1.0f / 64.0f); float q = 0.f;
#pragma unroll
                for (int ct = 0; ct < 4; ++ct) { const f32x4 d = y[ct] - mean; q += (d[0] * d[0] + d[1] * d[1]) + (d[2] * d[2] + d[3] * d[3]); }
                q += __shfl_xor(q, 16); q += __shfl_xor(q, 32);
                const float rstd = rsqrtf(q * (1.0f / 64.0f) + GN_EPS);
                bf16_t* ym = (bf16_t*)(p.ws + WS_YMIX) + (size_t)(b * SEQ + t) * DM + 512 + 64 * h;
#pragma unroll
                for (int ct = 0; ct < 4; ++ct) { const int cl = 16 * ct + 4 * g;
                    const f32x4 lw = *(const LAS f32x4*)(CS_ + C_LW + cl), lb = *(const LAS f32x4*)(CS_ + C_LB + cl);
                    const f32x4 o = ((y[ct] - mean) * rstd * lw + lb + bonus * v4[ct]) * gate4[ct];
                    u32x2 w; w.x = cvt_pk_bf16(o[0], o[1]); w.y = cvt_pk_bf16(o[2], o[3]);
                    *(u32x2*)(ym + cl) = w; }
            }
        }
#undef RW_LOADZ
#undef RW_PARK
        __syncthreads();
    }
}

constexpr int KSTR = 72;
constexpr int VSTR = 80;
constexpr int A_K = 0;
constexpr int A_VT = 3 * 128 * KSTR * 2;
constexpr int A_END = A_VT + 3 * 128 * VSTR * 2;
constexpr int A_STG = A_END;
static_assert(A_STG + 8 * 2560 <= 159 * 1024, "attn lds");

__device__ __forceinline__ void phase_attn(const Params& p, LAS unsigned char* lds) {
    const int tid = threadIdx.x, w = __builtin_amdgcn_readfirstlane(tid >> 6), lane = tid & 63, ql = lane & 15, g = lane >> 4;
    const bf16_t* z = (const bf16_t*)(p.ws + WS_Z);
    LAS bf16_t* Ks = (LAS bf16_t*)(lds + A_K); LAS bf16_t* VT = (LAS bf16_t*)(lds + A_VT);
    constexpr float SC = 0.125f * 1.4426950408889634f;
    for (int i = tid; i < A_END / 16; i += 512) *(LAS u32x4*)(lds + A_K + i * 16) = (u32x4){0u, 0u, 0u, 0u};
    const int srow = tid >> 3, sc8 = tid & 7;
    for (int bh = blockIdx.x; bh < 256; bh += gridDim.x) {
        const int b = bh >> 3, h = bh & 7;
        const bf16_t* zb = z + (size_t)b * SEQ * INW + 64 * h;
        float* stA_O = (float*)(p.ws + WS_STA + (size_t)bh * ST_BYTES_PER_BH); float* stA_ML = stA_O + SEQ * 64;
        float* stB_O = (float*)(p.ws + WS_STB + (size_t)bh * ST_BYTES_PER_BH); float* stB_ML = stB_O + SEQ * 64;
        u32x4 kq[2], vq[2];
#define ATT_DECODE(u_, pat_, d_, r_, n_) const int pat_ = 2 - (u_) / 16, d_ = pat_ == 0 ? 1 : (pat_ == 1 ? 4 : 16), nb_##u_ = 16 / d_, r_ = ((u_) % 16) / nb_##u_, n_ = ((u_) % 16) % nb_##u_
#define ATT_LOAD(d_, r_, n_) do { _Pragma("unroll") for (int it = 0; it < 2; ++it) { const bf16_t* zr = zb + (size_t)((128 * (n_) + srow + 64 * it) * (d_) + (r_)) * INW + sc8 * 8; \
            kq[it] = *(const u32x4*)(zr + 512); vq[it] = *(const u32x4*)(zr + 1024); } } while (0)
#define ATT_STORE(slot_) ATT_STORE_ROW((slot_) * 128)
#define ATT_STORE_ROW(rb_) do { _Pragma("unroll") for (int it = 0; it < 2; ++it) { const int row = (rb_) + srow + 64 * it; \
            *(LAS u32x4*)(Ks + row * KSTR + sc8 * 8) = kq[it]; *(LAS u32x4*)(VT + row * VSTR + sc8 * 8) = vq[it]; } } while (0)
        LAS unsigned char* stg = lds + A_STG + w * 2560;
#define STG_Q(i_) ((LAS u32x4*)(stg + (i_) * 1024 + lane * 16))
#define STG_ML ((LAS f32x2*)(stg + 2048 + lane * 8))
        __syncthreads();
        { ATT_LOAD(16, 0, 0); ATT_STORE(0);
          const bf16_t* zq0 = zb + (size_t)((16 * w + ql) * 16) * INW;
          *STG_Q(0) = *(const u32x4*)(zq0 + 8 * g); *STG_Q(1) = *(const u32x4*)(zq0 + 32 + 8 * g); }
        __syncthreads();
        int cb = 0, pb = 256, nbk = 128;
        for (int u = 0; u < 48; ++u) {
            ATT_DECODE(u, pat, d, r, n);
            const int tq = (128 * n + 16 * w + ql) * d + r;
            float* outO = pat == 2 ? stA_O : stB_O; float* outML = pat == 2 ? stA_ML : stB_ML;
            const bf16x8 qf0 = __builtin_bit_cast(bf16x8, *STG_Q(0)), qf1 = __builtin_bit_cast(bf16x8, *STG_Q(1));
            float m_prev = -INFINITY, l_prev = 0.f;
            f32x4 accO[4];
#pragma unroll
            for (int dt = 0; dt < 4; ++dt) accO[dt] = (f32x4){0.f, 0.f, 0.f, 0.f};
            const bool oddq = (ql & 1) != 0;
            const int tqA = (128 * n + 16 * w + (ql & ~1)) * d + r;
            if (pat != 2) { const f32x2 ml = *STG_ML; m_prev = ml.x; l_prev = ml.y; const unsigned char* inO = (const unsigned char*)(pat == 1 ? stA_O : stB_O) + (oddq ? 64 : 0) + 16 * g;
                const u32x4 la = *(const u32x4*)(inO + (size_t)tqA * 128), lb = *(const u32x4*)(inO + (size_t)(tqA + d) * 128);
                const u32x4 rcv = xchg1(oddq ? la : lb); const u32x4 w0 = oddq ? rcv : la, w1 = oddq ? lb : rcv;
                accO[0] = (f32x4){bf_lo(w0.x), bf_hi(w0.x), bf_lo(w0.y), bf_hi(w0.y)}; accO[1] = (f32x4){bf_lo(w0.z), bf_hi(w0.z), bf_lo(w0.w), bf_hi(w0.w)};
                accO[2] = (f32x4){bf_lo(w1.x), bf_hi(w1.x), bf_lo(w1.y), bf_hi(w1.y)}; accO[3] = (f32x4){bf_lo(w1.z), bf_hi(w1.z), bf_lo(w1.w), bf_hi(w1.w)}; }
            asm volatile("s_waitcnt lgkmcnt(0)" ::: "memory");
            u32x4 nq0 = (u32x4){0u, 0u, 0u, 0u}, nq1 = nq0; f32x2 nml = (f32x2){0.f, 0.f};
            bool nstate = false;
            if (u + 1 < 48) { const int u1 = u + 1; ATT_DECODE(u1, pat1, d1, r1, n1); ATT_LOAD(d1, r1, n1);
                const int tq1 = (128 * n1 + 16 * w + ql) * d1 + r1;
                const bf16_t* zq1 = zb + (size_t)tq1 * INW;
                nq0 = *(const u32x4*)(zq1 + 8 * g); nq1 = *(const u32x4*)(zq1 + 32 + 8 * g);
                if (pat1 != 2) { nstate = true; const float* inML = pat1 == 1 ? stA_ML : stB_ML; nml = *(const f32x2*)(inML + tq1 * 2); } }
            int rbx[9];
#pragma unroll
            for (int x = 0; x < 9; ++x) rbx[x] = (x <= 7 - w) ? pb + 16 * (w + x) : cb + 16 * (x - (8 - w));
            u32x2 vt[9][4];
#define ATT_VISSUE(x0_) do { const unsigned a0_ = (unsigned)(size_t)(VT + (rbx[x0_] + 4 * g + (ql >> 2)) * VSTR + 4 * (ql & 3)), a1_ = (unsigned)(size_t)(VT + (rbx[x0_ + 1] + 4 * g + (ql >> 2)) * VSTR + 4 * (ql & 3)), \
                                                   a2_ = (unsigned)(size_t)(VT + (rbx[x0_ + 2] + 4 * g + (ql >> 2)) * VSTR + 4 * (ql & 3)); \
                asm volatile("ds_read_b64_tr_b16 %0, %12\n\tds_read_b64_tr_b16 %1, %12 offset:32\n\tds_read_b64_tr_b16 %2, %12 offset:64\n\tds_read_b64_tr_b16 %3, %12 offset:96\n\t" \
                             "ds_read_b64_tr_b16 %4, %13\n\tds_read_b64_tr_b16 %5, %13 offset:32\n\tds_read_b64_tr_b16 %6, %13 offset:64\n\tds_read_b64_tr_b16 %7, %13 offset:96\n\t" \
                             "ds_read_b64_tr_b16 %8, %14\n\tds_read_b64_tr_b16 %9, %14 offset:32\n\tds_read_b64_tr_b16 %10, %14 offset:64\n\tds_read_b64_tr_b16 %11, %14 offset:96" \
                             : "=&v"(vt[x0_][0]), "=&v"(vt[x0_][1]), "=&v"(vt[x0_][2]), "=&v"(vt[x0_][3]), "=&v"(vt[x0_ + 1][0]), "=&v"(vt[x0_ + 1][1]), "=&v"(vt[x0_ + 1][2]), "=&v"(vt[x0_ + 1][3]), \
                               "=&v"(vt[x0_ + 2][0]), "=&v"(vt[x0_ + 2][1]), "=&v"(vt[x0_ + 2][2]), "=&v"(vt[x0_ + 2][3]) : "v"(a0_), "v"(a1_), "v"(a2_) : "memory"); } while (0)
            ATT_VISSUE(0); ATT_VISSUE(3); ATT_VISSUE(6);
#undef ATT_VISSUE
            bf16x8 kf0[9], kf1[9];
#pragma unroll
            for (int x = 0; x < 9; ++x) { const LAS bf16_t* kp = Ks + (rbx[x] + ql) * KSTR + 8 * g; kf0[x] = *(const LAS bf16x8*)kp; kf1[x] = *(const LAS bf16x8*)(kp + 32); }
            f32x4 sc[9];
#pragma unroll
            for (int x = 0; x < 9; ++x) {
                const bool prev = (x <= 7 - w);
                f32x4 a = (f32x4){0.f, 0.f, 0.f, 0.f};
                a = __builtin_amdgcn_mfma_f32_16x16x32_bf16(kf0[x], qf0, a, 0, 0, 0);
                a = __builtin_amdgcn_mfma_f32_16x16x32_bf16(kf1[x], qf1, a, 0, 0, 0);
#pragma unroll
                for (int i = 0; i < 4; ++i) { const int kl = 4 * g + i; bool ok = true;
                    if (prev) ok = (n > 0) && (x > 0 || kl >= ql); else ok = (x < 8) || (kl <= ql);
                    a[i] = ok ? a[i] * SC : -INFINITY; }
                sc[x] = a;
            }
            float mx = -INFINITY;
#pragma unroll
            for (int x = 0; x < 9; ++x) mx = fmaxf(mx, fmaxf(fmaxf(sc[x][0], sc[x][1]), fmaxf(sc[x][2], sc[x][3])));
            mx = fmaxf(mx, __shfl_xor(mx, 16)); mx = fmaxf(mx, __shfl_xor(mx, 32));
            const float m_new = fmaxf(m_prev, mx);
            float ls = 0.f;
#pragma unroll
            for (int x = 0; x < 9; ++x)
#pragma unroll
                for (int i = 0; i < 4; ++i) { const float e = __builtin_amdgcn_exp2f(sc[x][i] - m_new); sc[x][i] = e; ls += e; }
            ls += __shfl_xor(ls, 16); ls += __shfl_xor(ls, 32);
            const float alpha = __builtin_amdgcn_exp2f(m_prev - m_new);
            const float l_new = l_prev * alpha + ls;
#pragma unroll
            for (int dt = 0; dt < 4; ++dt) accO[dt] = accO[dt] * alpha;
            asm volatile("s_waitcnt lgkmcnt(0)" : "+v"(vt[0][0]), "+v"(vt[0][1]), "+v"(vt[0][2]), "+v"(vt[0][3]), "+v"(vt[1][0]), "+v"(vt[1][1]), "+v"(vt[1][2]), "+v"(vt[1][3]), "+v"(vt[2][0]), "+v"(vt[2][1]), "+v"(vt[2][2]), "+v"(vt[2][3]),
                                                   "+v"(vt[3][0]), "+v"(vt[3][1]), "+v"(vt[3][2]), "+v"(vt[3][3]), "+v"(vt[4][0]), "+v"(vt[4][1]), "+v"(vt[4][2]), "+v"(vt[4][3]) :: "memory");
            asm volatile("" : "+v"(vt[5][0]), "+v"(vt[5][1]), "+v"(vt[5][2]), "+v"(vt[5][3]), "+v"(vt[6][0]), "+v"(vt[6][1]), "+v"(vt[6][2]), "+v"(vt[6][3]), "+v"(vt[7][0]), "+v"(vt[7][1]), "+v"(vt[7][2]), "+v"(vt[7][3]),
                             "+v"(vt[8][0]), "+v"(vt[8][1]), "+v"(vt[8][2]), "+v"(vt[8][3]) :: "memory");
#pragma unroll
            for (int s2 = 0; s2 < 5; ++s2) {
                const int x0 = 2 * s2, x1 = 2 * s2 + 1;
                u32x4 pw; pw.x = cvt_pk_bf16(sc[x0][0], sc[x0][1]); pw.y = cvt_pk_bf16(sc[x0][2], sc[x0][3]);
                if (x1 < 9) { pw.z = cvt_pk_bf16(sc[x1 < 9 ? x1 : 8][0], sc[x1 < 9 ? x1 : 8][1]); pw.w = cvt_pk_bf16(sc[x1 < 9 ? x1 : 8][2], sc[x1 < 9 ? x1 : 8][3]); } else { pw.z = 0u; pw.w = 0u; }
                const bf16x8 pf = __builtin_bit_cast(bf16x8, pw);
#pragma unroll
                for (int dt = 0; dt < 4; ++dt) {
                    const u32x2 lo = vt[x0][dt], hi = x1 < 9 ? vt[x1 < 9 ? x1 : 8][dt] : (u32x2){0u, 0u};
                    const u32x4 vw = (u32x4){lo.x, lo.y, hi.x, hi.y};
                    accO[dt] = __builtin_amdgcn_mfma_f32_16x16x32_bf16(__builtin_bit_cast(bf16x8, vw), pf, accO[dt], 0, 0, 0);
                }
            }
            if (pat != 0) {
                u32x4 w0, w1;
                w0.x = cvt_pk_bf16(accO[0][0], accO[0][1]); w0.y = cvt_pk_bf16(accO[0][2], accO[0][3]); w0.z = cvt_pk_bf16(accO[1][0], accO[1][1]); w0.w = cvt_pk_bf16(accO[1][2], accO[1][3]);
                w1.x = cvt_pk_bf16(accO[2][0], accO[2][1]); w1.y = cvt_pk_bf16(accO[2][2], accO[2][3]); w1.z = cvt_pk_bf16(accO[3][0], accO[3][1]); w1.w = cvt_pk_bf16(accO[3][2], accO[3][3]);
                const u32x4 rcv = xchg1(oddq ? w0 : w1);
                unsigned char* oO = (unsigned char*)outO + (oddq ? 64 : 0) + 16 * g;
                *(u32x4*)(oO + (size_t)tqA * 128) = oddq ? rcv : w0; *(u32x4*)(oO + (size_t)(tqA + d) * 128) = oddq ? w1 : rcv;
                if (g == 0) { outML[tq * 2] = m_new; outML[tq * 2 + 1] = l_new; }
            } else {
                const float il = frcp(l_new); float ss = 0.f;
#pragma unroll
                for (int dt = 0; dt < 4; ++dt) { accO[dt] = accO[dt] * il; ss += (accO[dt][0] * accO[dt][0] + accO[dt][1] * accO[dt][1]) + (accO[dt][2] * accO[dt][2] + accO[dt][3] * accO[dt][3]); }
                ss += __shfl_xor(ss, 16); ss += __shfl_xor(ss, 32);
                const float rs = rsqrtf(ss * (1.0f / 64.0f) + NORM_EPS);
                bf16_t* ym = (bf16_t*)(p.ws + WS_YMIX) + (size_t)(b * SEQ + tq) * DM + 64 * h;
#pragma unroll
                for (int dt = 0; dt < 4; ++dt) { const f32x4 gn = *(const f32x4*)(p.attn_out_gain + 64 * h + 16 * dt + 4 * g); const f32x4 o = accO[dt] * rs * gn;
                    u32x2 wv; wv.x = cvt_pk_bf16(o[0], o[1]); wv.y = cvt_pk_bf16(o[2], o[3]); *(u32x2*)(ym + 16 * dt + 4 * g) = wv; }
            }
            if (u + 1 < 48) { ATT_STORE_ROW(nbk); *STG_Q(0) = nq0; *STG_Q(1) = nq1;
                if (nstate) *STG_ML = nml; }
            { const int t_ = pb; pb = cb; cb = nbk; nbk = t_; }
            __syncthreads();
        }
#undef ATT_DECODE
#undef ATT_LOAD
#undef ATT_STORE
#undef ATT_STORE_ROW
#undef STG_Q
#undef STG_ML
        asm volatile("s_waitcnt vmcnt(0)" ::: "memory");
    }
}

constexpr int P4_WH = 0;
constexpr int P4_WL = 65536;
constexpr int P4_GN = 131072;
constexpr int P4_LG = P4_GN + 4096;
constexpr int P4_RS = P4_LG + 16384;
constexpr int P4_CNT = P4_RS + 512;
constexpr int P4_ASG = P4_CNT + 256;
constexpr int P4_GT = P4_ASG + 4096;
constexpr int P4_END = P4_GT + 4096;
static_assert(P4_END <= 158 * 1024, "router lds");

__device__ __forceinline__ void phase_router(const Params& p, LAS unsigned char* lds) {
    const int tid = threadIdx.x, wid = __builtin_amdgcn_readfirstlane(tid >> 6), lane = tid & 63, n = lane & 15, g = lane >> 4;
    LAS float* GN = (LAS float*)(lds + P4_GN); LAS float* LG = (LAS float*)(lds + P4_LG) + wid * 512; LAS float* RSD = (LAS float*)(lds + P4_RS) + wid * 16;
    LAS unsigned* cnt = (LAS unsigned*)(lds + P4_CNT); LAS unsigned* bas = cnt + 32; LAS unsigned* asg = (LAS unsigned*)(lds + P4_ASG);
    unsigned* ctl = (unsigned*)(p.ws + WS_CTL);
    int* list = (int*)(p.ws + WS_LIST); float* glist = (float*)(p.ws + WS_GLIST);
    LAS float* gtl = (LAS float*)(lds + P4_GT);
    unsigned char* h2 = p.ws + WS_H;
    const bf16_t* x1 = (const bf16_t*)(p.ws + WS_X1);
    for (int i = tid; i < 1024; i += 512) GN[i] = p.norm2_gain[i];
    for (int i0 = tid; i0 < 32 * 1024; i0 += 8 * 512) {
        float wv[8], gv[8];
#pragma unroll
        for (int j = 0; j < 8; ++j) { const int i = i0 + 512 * j; wv[j] = p.router_w[i]; gv[j] = p.norm2_gain[i >> 5]; }
#pragma unroll
        for (int j = 0; j < 8; ++j) { const int i = i0 + 512 * j, k = i >> 5, e = i & 31; const float w = wv[j] * gv[j];
            const unsigned hb = cvt_pk_bf16(w, 0.f) & 0xffffu; const float hf = __uint_as_float(hb << 16); const unsigned lb = cvt_pk_bf16(w - hf, 0.f) & 0xffffu;
            const int off = e * 2048 + ((((k >> 3) ^ (e & 15)) << 4) | ((k & 7) << 1));
            *(LAS bf16_t*)(lds + P4_WH + off) = (bf16_t)hb; *(LAS bf16_t*)(lds + P4_WL + off) = (bf16_t)lb; } }
    const float rb0 = p.router_b[lane & 31];
    for (int panel = blockIdx.x; panel < NTOK / 256; panel += gridDim.x) {
        if (tid < 32) cnt[tid] = 0u;
        __syncthreads();
        for (int tile = 0; tile < 2; ++tile) {
            const int tl0 = wid * 32 + tile * 16, tok0 = panel * 256 + tl0;
            bf16x8 raw[32];
            const bf16_t* xp = x1 + (size_t)(tok0 + n) * DM + 8 * g;
#pragma unroll
            for (int s2 = 0; s2 < 32; ++s2) raw[s2] = *(const bf16x8*)(xp + 32 * s2);
            f32x4 aq = (f32x4){0.f, 0.f, 0.f, 0.f};
#pragma unroll
            for (int s2 = 0; s2 < 32; ++s2) aq = __builtin_amdgcn_mfma_f32_16x16x32_bf16(raw[s2], raw[s2], aq, 0, 0, 0);
            { const int i = n & 3; const float d = i == 0 ? aq[0] : (i == 1 ? aq[1] : (i == 2 ? aq[2] : aq[3]));
              if (g == (n >> 2)) RSD[n] = rsqrtf(d * (1.0f / DM) + NORM_EPS); }
            asm volatile("s_waitcnt lgkmcnt(0)" ::: "memory");
            const float rs = RSD[n];
            f32x4 al[2] = {{0.f, 0.f, 0.f, 0.f}, {0.f, 0.f, 0.f, 0.f}};
            unsigned char* hp = h2 + (size_t)(tok0 + n) * DM + 8 * g;
#pragma unroll
            for (int s2 = 0; s2 < 32; ++s2) {
#pragma unroll
                for (int et = 0; et < 2; ++et) { const int e = 16 * et + n; const int off = e * 2048 + (((4 * s2 + g) ^ (e & 15)) << 4);
                    const bf16x8 wh = *(const LAS bf16x8*)(lds + P4_WH + off), wl = *(const LAS bf16x8*)(lds + P4_WL + off);
                    al[et] = __builtin_amdgcn_mfma_f32_16x16x32_bf16(raw[s2], wh, al[et], 0, 0, 0);
                    al[et] = __builtin_amdgcn_mfma_f32_16x16x32_bf16(raw[s2], wl, al[et], 0, 0, 0); }
                const f32x4 g0 = *(const LAS f32x4*)(GN + 32 * s2 + 8 * g), g1 = *(const LAS f32x4*)(GN + 32 * s2 + 8 * g + 4);
                const u32x4 rw = __builtin_bit_cast(u32x4, raw[s2]);
                const f32x4 v0 = (f32x4){bf_lo(rw.x), bf_hi(rw.x), bf_lo(rw.y), bf_hi(rw.y)} * g0 * rs, v1 = (f32x4){bf_lo(rw.z), bf_hi(rw.z), bf_lo(rw.w), bf_hi(rw.w)} * g1 * rs;
                *(u32x2*)(hp + 32 * s2) = (u32x2){pk4_fp8(v0[0], v0[1], v0[2], v0[3]), pk4_fp8(v1[0], v1[1], v1[2], v1[3])};
            }
            const float rbv0 = __shfl(rb0, n), rbv1 = __shfl(rb0, 16 + n);
#pragma unroll
            for (int i = 0; i < 4; ++i) { const float rsi = RSD[4 * g + i]; LG[(4 * g + i) * 32 + n] = al[0][i] * rsi + rbv0; LG[(4 * g + i) * 32 + 16 + n] = al[1][i] * rsi + rbv1; }
            asm volatile("s_waitcnt lgkmcnt(0)" ::: "memory");
            if (lane < 16) {
                float lv[32];
#pragma unroll
                for (int q = 0; q < 8; ++q) { const f32x4 t4 = *(const LAS f32x4*)(LG + lane * 32 + 4 * q); lv[4 * q] = t4[0]; lv[4 * q + 1] = t4[1]; lv[4 * q + 2] = t4[2]; lv[4 * q + 3] = t4[3]; }
                float tv[4]; int te[4];
#pragma unroll
                for (int k = 0; k < 4; ++k) { float bv = -INFINITY; int be = 0;
#pragma unroll
                    for (int e = 0; e < 32; ++e) { const bool taken = (k > 0 && te[0] == e) || (k > 1 && te[1] == e) || (k > 2 && te[2] == e); if (!taken && lv[e] > bv) { bv = lv[e]; be = e; } }
                    tv[k] = bv; te[k] = be; }
                const float e1 = fexp(tv[1] - tv[0]), e2 = fexp(tv[2] - tv[0]), e3 = fexp(tv[3] - tv[0]);
                const float isum = 1.0f / (1.0f + e1 + e2 + e3);
                const float gk[4] = {isum, e1 * isum, e2 * isum, e3 * isum};
                const int tl = tl0 + lane, tok = tok0 + lane;
#pragma unroll
                for (int k = 0; k < 4; ++k) { const unsigned pos = __hip_atomic_fetch_add(&cnt[te[k]], 1u, __ATOMIC_RELAXED, __HIP_MEMORY_SCOPE_WORKGROUP);
                    asg[tl * 4 + k] = ((unsigned)te[k] << 16) | pos; gtl[tl * 4 + k] = gk[k]; }
            }
            asm volatile("s_waitcnt lgkmcnt(0)" ::: "memory");
        }
        __syncthreads();
        if (tid < 32) bas[tid] = __hip_atomic_fetch_add(ctl + CW_CNT + 64 * tid, cnt[tid], __ATOMIC_RELAXED, __HIP_MEMORY_SCOPE_AGENT);
        __syncthreads();
        for (int i = tid; i < 1024; i += 512) { const unsigned a = asg[i]; const int e = a >> 16, pos = a & 0xffff; const size_t li = (size_t)e * NTOK + bas[e] + pos;
            list[li] = (panel * 256 + (i >> 2)) * 4 + (i & 3); glist[li] = gtl[i]; }
        __syncthreads();
    }
}

struct TileTab { int tb[33]; int cn[32]; };
__device__ __forceinline__ void build_tiletab(const Params& p, LAS TileTab* T) {
    if (threadIdx.x < 32) {
        const unsigned* ctl = (const unsigned*)(p.ws + WS_CTL);
        const int e = threadIdx.x, c = (int)__hip_atomic_load(ctl + CW_CNT + 64 * e, __ATOMIC_RELAXED, __HIP_MEMORY_SCOPE_AGENT), nt = (c + 255) >> 8;
        int incl = nt;
#pragma unroll
        for (int o = 1; o < 32; o <<= 1) { const int v = __shfl_up(incl, o); if (e >= o) incl += v; }
        T->cn[e] = c; T->tb[e] = incl - nt; if (e == 31) T->tb[32] = incl;
    }
    __syncthreads();
}
template <int NCT>
struct GroupProb {
    const char* Abase; const char* Bt; const int* list; const LAS TileTab* T; int ntiles, xcd, rank; bool gather;
    static constexpr int RPX = 32 / NCT;
    __device__ __forceinline__ void init(const void* A, const void* B, const int* list_, const LAS TileTab* T_, bool gather_) {
        Abase = (const char*)A; Bt = (const char*)B; list = list_; T = T_; gather = gather_; ntiles = T_->tb[32];
        const int c = blockIdx.x; xcd = c & 7; rank = c >> 3; }
    __device__ __forceinline__ bool next(int i, g8::Unit& u) const {
        if (rank >= 32) return false;
        const int rt = (i * 8 + xcd) * RPX + rank / NCT; if (rt >= ntiles) return false;
        int e = 0;
#pragma unroll
        for (int s = 16; s >= 1; s >>= 1) if (T->tb[e + s] <= rt) e += s;
        u.pm = rt; u.pn = rank % NCT; u.e = e; u.cnt = T->cn[e] - (rt - T->tb[e]) * 256; return true;
    }
    __device__ __forceinline__ unsigned a_off(const g8::Unit& u, int row) const {
        if (gather) { const int rc = row < u.cnt ? row : u.cnt - 1; const int tokn = list[(size_t)u.e * NTOK + (u.pm - T->tb[u.e]) * 256 + rc] >> 2; return (unsigned)tokn * 1024u; }
        return (unsigned)(u.pm * 256 + row) * 1024u;
    }
    template <bool CM> __device__ __forceinline__ const char* b_ptr(const g8::Unit& u, int half) const {
        if (NCT == 8) return Bt + ((size_t)u.e * 2048 + (size_t)half * 1024 + u.pn * 128) * 1024;
        return Bt + ((size_t)u.e * 1024 + u.pn * 256 + half * (CM ? 32 : 128)) * 1024;
    }
};
struct EpiHid {
    static constexpr bool PERM = true, COLMAP = false;
    unsigned char* H; const float* b1;
    __device__ __forceinline__ void prefetch(const g8::Unit& u, LAS unsigned char* my, int wid, int lane) const {
        const float* src = b1 + (size_t)u.e * 2048 + (lane >> 5) * 1024 + u.pn * 128 + (wid & 3) * 32 + (lane & 31);
        __builtin_amdgcn_global_load_lds((const unsigned*)src, (LAS unsigned*)my, 4, 0, 0);
    }
    __device__ __forceinline__ void operator()(const f32x4 (&acc)[2][2][4][2], const g8::Unit& u, int wr, int wc, int fr, int fq, LAS unsigned char* my) const {
        const int row0 = u.pm * 256 + wr * 64 + fr, col0 = u.pn * 128 + wc * 32 + 8 * fq;
        const f32x4 bg0 = *(const LAS f32x4*)(my + 32 * fq), bg1 = *(const LAS f32x4*)(my + 32 * fq + 16), bl0 = *(const LAS f32x4*)(my + 128 + 32 * fq), bl1 = *(const LAS f32x4*)(my + 128 + 32 * fq + 16);
        const f32x2 bg[4] = {{bg0[0], bg0[1]}, {bg0[2], bg0[3]}, {bg1[0], bg1[1]}, {bg1[2], bg1[3]}};
        const f32x2 bl[4] = {{bl0[0] + 1.0f, bl0[1] + 1.0f}, {bl0[2] + 1.0f, bl0[3] + 1.0f}, {bl1[0] + 1.0f, bl1[1] + 1.0f}, {bl1[2] + 1.0f, bl1[3] + 1.0f}};
        const f32x2 sc = {1.0f / W8_SCALE, 1.0f / W8_SCALE}, ce = {-1.702f * 1.4426950408889634f, -1.702f * 1.4426950408889634f}, one = {1.0f, 1.0f};
#pragma unroll
        for (int ai = 0; ai < 2; ++ai)
#pragma unroll
            for (int m = 0; m < 4; ++m) {
                f32x2 o[4];
#pragma unroll
                for (int q = 0; q < 4; ++q) {
                    const f32x4 ga = acc[ai][0][m][q >> 1], la = acc[ai][1][m][q >> 1];
                    const f32x2 gr = (q & 1) ? (f32x2){ga[2], ga[3]} : (f32x2){ga[0], ga[1]}, lr = (q & 1) ? (f32x2){la[2], la[3]} : (f32x2){la[0], la[1]};
                    f32x2 gl = __builtin_elementwise_fma(gr, sc, bg[q]), li = __builtin_elementwise_fma(lr, sc, bl[q]);
                    gl.x = fminf(gl.x, 7.0f); gl.y = fminf(gl.y, 7.0f);
                    li.x = __builtin_amdgcn_fmed3f(li.x, -6.0f, 8.0f); li.y = __builtin_amdgcn_fmed3f(li.y, -6.0f, 8.0f);
                    const f32x2 ex = gl * ce;
                    f32x2 den = {__builtin_amdgcn_exp2f(ex.x), __builtin_amdgcn_exp2f(ex.y)}; den = den + one;
                    const f32x2 rc = {__builtin_amdgcn_rcpf(den.x), __builtin_amdgcn_rcpf(den.y)};
                    o[q] = (gl * rc) * li; }
                u32x2 w; w.x = pk4_fp8(o[0].x, o[0].y, o[1].x, o[1].y); w.y = pk4_fp8(o[2].x, o[2].y, o[3].x, o[3].y);
                *(u32x2*)(H + (size_t)(row0 + ai * 128 + m * 16) * FF + col0) = w; }
    }
};
struct EpiY2 {
    static constexpr bool PERM = true, COLMAP = true;
    unsigned char* Y; const float* b2; const int* list; const float* gate; const LAS TileTab* T;
    __device__ __forceinline__ void prefetch(const g8::Unit& u, LAS unsigned char* my, int wid, int lane) const {
        const size_t lb = (size_t)u.e * NTOK + (u.pm - T->tb[u.e]) * 256;
#pragma unroll
        for (int ai = 0; ai < 2; ++ai) { const int r = ai * 128 + (wid >> 2) * 64 + lane, rc = r < u.cnt ? r : u.cnt - 1;
            __builtin_amdgcn_global_load_lds((const unsigned*)(list + lb + rc), (LAS unsigned*)(my + ai * 256), 4, 0, 0);
            __builtin_amdgcn_global_load_lds((const unsigned*)(gate + lb + rc), (LAS unsigned*)(my + 512 + ai * 256), 4, 0, 0); }
        __builtin_amdgcn_global_load_lds((const unsigned*)(b2 + (size_t)u.e * DM + u.pn * 256 + (wid & 3) * 64 + lane), (LAS unsigned*)(my + 1024), 4, 0, 0);
    }
    __device__ __forceinline__ void operator()(const f32x4 (&acc)[2][2][4][2], const g8::Unit& u, int wr, int wc, int fr, int fq, LAS unsigned char* my) const {
        const bool oddq = (fq & 1) != 0;
        const int colS = u.pn * 256 + wc * 64 + (oddq ? 32 + 8 * (fq - 1) : 8 * fq);
        f32x4 bv[2][2];
#pragma unroll
        for (int bj = 0; bj < 2; ++bj) { bv[bj][0] = *(const LAS f32x4*)(my + 1024 + 128 * bj + 32 * fq); bv[bj][1] = *(const LAS f32x4*)(my + 1024 + 128 * bj + 32 * fq + 16); }
        int dsts[2][4]; float gts[2][4];
#pragma unroll
        for (int ai = 0; ai < 2; ++ai)
#pragma unroll
            for (int m = 0; m < 4; ++m) { dsts[ai][m] = *(const LAS int*)(my + ai * 256 + (m * 16 + fr) * 4); gts[ai][m] = *(const LAS float*)(my + 512 + ai * 256 + (m * 16 + fr) * 4); }
#pragma unroll
        for (int ai = 0; ai < 2; ++ai)
#pragma unroll
            for (int m = 0; m < 4; ++m) { const int r = ai * 128 + wr * 64 + m * 16 + fr; const float gt = gts[ai][m];
                u32x2 pc[2];
#pragma unroll
                for (int bj = 0; bj < 2; ++bj) { const f32x4 v0 = (acc[ai][bj][m][0] * (1.0f / W8_SCALE) + bv[bj][0]) * gt, v1 = (acc[ai][bj][m][1] * (1.0f / W8_SCALE) + bv[bj][1]) * gt;
                    pc[bj] = (u32x2){pk4_fp8(v0[0], v0[1], v0[2], v0[3]), pk4_fp8(v1[0], v1[1], v1[2], v1[3])}; }
                const u32x2 snd = oddq ? pc[0] : pc[1];
                const u32x2 rcv = {(unsigned)__shfl_xor((int)snd.x, 16), (unsigned)__shfl_xor((int)snd.y, 16)};
                const u32x4 dat = oddq ? (u32x4){rcv.x, rcv.y, pc[1].x, pc[1].y} : (u32x4){pc[0].x, pc[0].y, rcv.x, rcv.y};
                if (r < u.cnt) *(u32x4*)(Y + (size_t)dsts[ai][m] * DM + colS) = dat; }
    }
};
__device__ __forceinline__ void phase_final(const Params& p) {
    const int lane = threadIdx.x & 63, wid = threadIdx.x >> 6;
    const unsigned char* y2 = p.ws + WS_Y2;
    f32x4 gn[4];
#pragma unroll
    for (int c = 0; c < 4; ++c) gn[c] = *(const f32x4*)(p.final_norm_gain + 256 * c + 4 * lane);
    for (int tok0 = (blockIdx.x * 8 + wid) * 4; tok0 < NTOK; tok0 += gridDim.x * 32) {
        u32x2 xb[4][4]; int yw[4][4][4];
#pragma unroll
        for (int q = 0; q < 4; ++q) { const bf16_t* x1r = (const bf16_t*)(p.ws + WS_X1) + (size_t)(tok0 + q) * DM;
#pragma unroll
            for (int c = 0; c < 4; ++c) xb[q][c] = *(const u32x2*)(x1r + 256 * c + 4 * lane);
#pragma unroll
            for (int k = 0; k < 4; ++k) { const unsigned char* yr = y2 + ((size_t)(tok0 + q) * 4 + k) * DM;
#pragma unroll
                for (int c = 0; c < 4; ++c) yw[q][k][c] = *(const int*)(yr + 256 * c + 4 * lane); } }
#pragma unroll
        for (int q = 0; q < 4; ++q) {
            f32x4 v[4];
#pragma unroll
            for (int c = 0; c < 4; ++c) v[c] = up4(xb[q][c]);
#pragma unroll
            for (int k = 0; k < 4; ++k)
#pragma unroll
                for (int c = 0; c < 4; ++c) { const int w = yw[q][k][c];
                    const f32x2 lo = __builtin_amdgcn_cvt_pk_f32_fp8(w, false), hi = __builtin_amdgcn_cvt_pk_f32_fp8(w, true);
                    v[c][0] += lo.x; v[c][1] += lo.y; v[c][2] += hi.x; v[c][3] += hi.y; }
            float ss = 0.f;
#pragma unroll
            for (int c = 0; c < 4; ++c) ss += (v[c][0] * v[c][0] + v[c][1] * v[c][1]) + (v[c][2] * v[c][2] + v[c][3] * v[c][3]);
            ss = wave_sum(ss);
            const float rs = rsqrtf(ss * (1.0f / DM) + NORM_EPS);
            float* xr = p.out + (size_t)(tok0 + q) * DM;
#pragma unroll
            for (int c = 0; c < 4; ++c) *(f32x4*)(xr + 256 * c + 4 * lane) = v[c] * rs * gn[c];
        }
    }
}

constexpr int LDS_BYTES = 163840;
constexpr int L_MISC = 159 * 1024;
__global__ void __launch_bounds__(512, 2) mega_fwd(Params p) {
    extern __shared__ __attribute__((aligned(16))) unsigned char lds_raw[];
    LAS unsigned char* lds = (LAS unsigned char*)lds_raw;
    volatile LAS unsigned* misc = (volatile LAS unsigned*)(lds + L_MISC);
    LAS TileTab* TT = (LAS TileTab*)(lds + L_MISC + 64);
    if (threadIdx.x < 4) misc[threadIdx.x] = 0u;
    __syncthreads();
    XcdBarrier bar = xcd_barrier_post((unsigned*)(p.ws + WS_CTL) + CW_BAR, misc);
    const int lo = p.ph_lo, hi = p.ph_hi;
#define IN(k) (lo <= (k) && (k) < hi)
    if (IN(0)) { phase0(p, lds); xcd_barrier(bar); }
    if (IN(1)) {
        g8::DenseProb S; S.init(p.ws + WS_H, p.ws + WS_WIN, NTOK, INW, (int)gridDim.x, (int)blockIdx.x);
        EpiZ E{(bf16_t*)(p.ws + WS_Z)};
        g8::gemm_phase<false>(lds, S, E);
        xcd_barrier(bar);
    }
    if (IN(2)) { rwkv_lora_act(p); xcd_barrier(bar); phase_rwkv(p, lds); __syncthreads(); phase_attn(p, lds); xcd_barrier(bar); }
    if (IN(3)) {
        g8::DenseProb S; S.init(p.ws + WS_YMIX, p.ws + WS_WOUT, NTOK, DM, (int)gridDim.x, (int)blockIdx.x);
        EpiX1 E{p.x, (bf16_t*)(p.ws + WS_X1)};
        g8::gemm_phase<false>(lds, S, E);
        xcd_barrier(bar);
    }
    if (IN(4)) { phase_router(p, lds); xcd_barrier(bar); }
    if (IN(5)) {
        build_tiletab(p, TT);
        GroupProb<8> S; S.init(p.ws + WS_H, p.ws + WS_W1T, (const int*)(p.ws + WS_LIST), TT, true);
        EpiHid E{p.ws + WS_HID, p.expert_b1};
        g8::gemm_phase<true>(lds, S, E);
        xcd_barrier(bar);
    }
    if (IN(6)) {
        build_tiletab(p, TT);
        GroupProb<4> S; S.init(p.ws + WS_HID, p.ws + WS_W2T, (const int*)(p.ws + WS_LIST), TT, false);
        EpiY2 E{p.ws + WS_Y2, p.expert_b2, (const int*)(p.ws + WS_LIST), (const float*)(p.ws + WS_GLIST), TT};
        g8::gemm_phase<true>(lds, S, E);
        xcd_barrier(bar);
    }
    if (IN(7)) phase_final(p);
#undef IN
}

extern "C" void kernel_launch(void* const* d_in, const int* in_sizes, int n_in, void* d_out, int out_size, void* d_ws, size_t ws_size, hipStream_t stream) {
    static int grid = 0;
    if (grid == 0) {
        if (n_in != 24 || out_size != NTOK * DM || ws_size < WS_END) { fprintf(stderr, "kernel_launch: unexpected shapes (n_in %d, out %d, ws %zu < %zu); nothing launched\n", n_in, out_size, ws_size, (size_t)WS_END); grid = -1; return; }
        int dev = 0, cus = 0, per_cu = 0;
        if (hipGetDevice(&dev) != hipSuccess || hipDeviceGetAttribute(&cus, hipDeviceAttributeMultiprocessorCount, dev) != hipSuccess) { grid = -1; return; }
        if (hipFuncSetAttribute((const void*)mega_fwd, hipFuncAttributeMaxDynamicSharedMemorySize, LDS_BYTES) != hipSuccess) { fprintf(stderr, "kernel_launch: hipFuncSetAttribute failed\n"); grid = -1; return; }
        if (hipOccupancyMaxActiveBlocksPerMultiprocessor(&per_cu, (const void*)mega_fwd, 512, LDS_BYTES) != hipSuccess || per_cu < 1) { fprintf(stderr, "kernel_launch: occupancy query says %d\n", per_cu); (void)hipGetLastError(); grid = -1; return; }
        grid = cus;
    }
    if (grid < 0) return;
    if (hipMemsetAsync((char*)d_ws + WS_CTL, 0, CTL_ZERO_BYTES, stream) != hipSuccess) return;
    Params p{};
    const float** pp = (const float**)&p;
    for (int i = 0; i < 24; ++i) pp[i] = (const float*)d_in[i];
    p.out = (float*)d_out; p.ws = (unsigned char*)d_ws;
    p.ph_lo = 0; p.ph_hi = 8;
    hipLaunchKernelGGL(mega_fwd, dim3(grid), dim3(512), LDS_BYTES, stream, p);
}
```

```cpp
#include <hip/hip_runtime.h>
#include <stdint.h>
#include <stdio.h>

#define LAS __attribute__((address_space(3)))
typedef unsigned short bf16_t;
typedef short bf16x8 __attribute__((ext_vector_type(8)));
typedef short s16x4 __attribute__((ext_vector_type(4)));
typedef float f32x4 __attribute__((ext_vector_type(4)));
typedef float f32x2 __attribute__((ext_vector_type(2)));
typedef unsigned u32x4 __attribute__((ext_vector_type(4)));
typedef unsigned u32x2 __attribute__((ext_vector_type(2)));

constexpr int NTOK = 65536, SEQ = 2048, DM = 1024, INW = 3328, NE = 32, FF = 1024, NH = 8;
constexpr int RW_OFF = 1536;
constexpr int ZG = INW / 64;
__device__ __forceinline__ size_t zoff(int b, int c, int t) { return ((size_t)(b * ZG + c) * SEQ + t) * 64; }
constexpr float NORM_EPS = 1e-5f, GN_EPS = 64e-5f;

constexpr size_t MiB = 1048576;
constexpr size_t WS_CTL   = 0;
constexpr size_t CTL_ZERO_BYTES = 65536;
constexpr size_t WS_WIN   = 2 * MiB;
constexpr size_t WS_WOUT  = WS_WIN + (size_t)INW * DM * 2;
constexpr size_t WS_DECUP = WS_WOUT + (size_t)DM * DM * 2;
constexpr size_t WS_ICLUP = WS_DECUP + 512 * 64 * 2;
constexpr size_t WS_GATUP = WS_ICLUP + 512 * 64 * 2;
constexpr size_t WS_W2T   = 12 * MiB;
constexpr size_t WS_W1T   = 76 * MiB;
constexpr size_t WS_LACT  = 140 * MiB;
constexpr size_t WS_H     = 204 * MiB;
constexpr size_t WS_TAIL  = 332 * MiB;
constexpr size_t WS_Z     = 472 * MiB;
constexpr size_t WS_YMIX  = 888 * MiB;
constexpr size_t WS_END   = 1016 * MiB;
static_assert(WS_GATUP + 512 * 128 * 2 <= WS_W2T, "small weights");
constexpr size_t WS_STA   = WS_H;
constexpr size_t ST_BYTES_PER_BH = (size_t)SEQ * 64 * 4 + (size_t)SEQ * 2 * 4;
constexpr size_t WS_STB   = WS_STA + 256 * ST_BYTES_PER_BH;
static_assert(WS_STB + 256 * ST_BYTES_PER_BH <= WS_Z, "state buffers");
constexpr size_t WS_LIST  = WS_TAIL;
constexpr size_t WS_GATE  = WS_TAIL + 8 * MiB;
constexpr size_t WS_GLIST = WS_TAIL + 16 * MiB;
constexpr size_t WS_HID   = WS_Z;
constexpr size_t WS_X1    = 736 * MiB;
constexpr size_t WS_Y2    = WS_W1T;
constexpr size_t WS_H8    = WS_YMIX;
constexpr size_t WS_WIN8  = WS_TAIL;
constexpr int    N_BF = 1536;
constexpr int CW_BAR = 0;
constexpr int CW_CNT = 4096;

#define XB_TMO      128
#define XB_XCNT(j)  (256  + 64 * (j))
#define XB_XSUB(j)  (1280 + 64 * (j))
#define XB_XGEN(j)  (2304 + 64 * (j))
#define XB_TOP      3328
#define XB_TOPGEN   3392
#define XCD_BAR_WORDS 3456
#define XB_SPIN_CAP (1u << 18)

__device__ __forceinline__ unsigned xb_ld(unsigned* p)              { return __hip_atomic_load(p, __ATOMIC_RELAXED, __HIP_MEMORY_SCOPE_AGENT); }
__device__ __forceinline__ unsigned xb_add(unsigned* p, unsigned v) { return __hip_atomic_fetch_add(p, v, __ATOMIC_RELAXED, __HIP_MEMORY_SCOPE_AGENT); }
__device__ __forceinline__ unsigned xb_xcc_id() { return (unsigned)__builtin_amdgcn_s_getreg((3 << 11) | 20) & 0xFu; }
#define XB_SPIN(cond, bar) do { unsigned _sp = 0; while (cond) { __builtin_amdgcn_s_sleep(1); \
    if ((++_sp & 255u) == 0u) { if (xb_ld(&(bar)[XB_TMO])) break; if (_sp > XB_SPIN_CAP) { atomicAdd(&(bar)[XB_TMO], 1u); break; } } } } while (0)

struct XcdBarrier { unsigned* bar; unsigned x; volatile LAS unsigned* st; };

__device__ __forceinline__ XcdBarrier xcd_barrier_post(unsigned* bar, volatile LAS unsigned* st) {
    XcdBarrier b; b.bar = bar; b.x = xb_xcc_id(); b.st = st;
    if (threadIdx.x == 0) (void)xb_add(&bar[XB_XCNT(b.x)], 1u);
    return b;
}
__device__ __forceinline__ void xcd_barrier_complete(unsigned* bar, unsigned x, unsigned& nloc, unsigned& nx) {
    const unsigned G = gridDim.x * gridDim.y * gridDim.z;
    unsigned sum, cnt, mine, sp = 0u;
    for (;;) {
        sum = 0u; cnt = 0u; mine = 0u;
#pragma unroll
        for (unsigned j = 0; j < 16; ++j) { const unsigned c = xb_ld(&bar[XB_XCNT(j)]); sum += c; cnt += (c > 0u) ? 1u : 0u; mine = (j == x) ? c : mine; }
        if (sum == G) break;
        __builtin_amdgcn_s_sleep(1);
        if ((++sp & 255u) == 0u) { if (xb_ld(&bar[XB_TMO])) break; if (sp > XB_SPIN_CAP) { atomicAdd(&bar[XB_TMO], 1u); break; } }
    }
    nloc = mine > 0u ? mine : 1u; nx = cnt > 0u ? cnt : 1u;
}
__device__ __forceinline__ void xcd_barrier(const XcdBarrier& b) {
    asm volatile("s_waitcnt vmcnt(0)" ::: "memory");
    __syncthreads();
    if (threadIdx.x == 0) {
        unsigned* bar = b.bar;
        __builtin_amdgcn_s_waitcnt(0);
        unsigned nloc = b.st[0], nx = b.st[1];
        if (nloc == 0u) { xcd_barrier_complete(bar, b.x, nloc, nx); b.st[0] = nloc; b.st[1] = nx; }
        const unsigned old = xb_add(&bar[XB_XSUB(b.x)], 1u);
        const unsigned gen = old / nloc;
        if (old + 1u == (gen + 1u) * nloc) {
            __builtin_amdgcn_fence(__ATOMIC_RELEASE, "agent");
            asm volatile("s_waitcnt vmcnt(0)" ::: "memory");
            const unsigned og = xb_add(&bar[XB_TOP], 1u);
            const unsigned tg = og / nx;
            if (og + 1u == (tg + 1u) * nx) xb_add(&bar[XB_TOPGEN], 1u);
            else XB_SPIN(xb_ld(&bar[XB_TOPGEN]) == tg, bar);
            __builtin_amdgcn_fence(__ATOMIC_ACQUIRE, "agent");
            xb_add(&bar[XB_XGEN(b.x)], 1u);
            asm volatile("s_waitcnt vmcnt(0)" ::: "memory");
        } else {
            XB_SPIN(xb_ld(&bar[XB_XGEN(b.x)]) == gen, bar);
            __builtin_amdgcn_fence(__ATOMIC_ACQUIRE, "agent");
            asm volatile("s_waitcnt vmcnt(0)" ::: "memory");
        }
    }
    __syncthreads();
}

__device__ __forceinline__ unsigned cvt_pk_bf16(float lo, float hi) { unsigned r; asm volatile("v_cvt_pk_bf16_f32 %0, %1, %2" : "=v"(r) : "v"(lo), "v"(hi)); return r; }
__device__ __forceinline__ float bf_lo(unsigned w) { return __uint_as_float(w << 16); }
__device__ __forceinline__ float bf_hi(unsigned w) { return __uint_as_float(w & 0xffff0000u); }
__device__ __forceinline__ float bf1(bf16_t v) { return __uint_as_float(((unsigned)v) << 16); }
template <int CTRL> __device__ __forceinline__ float dpp_f(float v) { return __int_as_float(__builtin_amdgcn_update_dpp(0, __float_as_int(v), CTRL, 0xf, 0xf, true)); }
__device__ __forceinline__ u32x4 xchg1(u32x4 v) { u32x4 r;
#pragma unroll
    for (int i = 0; i < 4; ++i) r[i] = (unsigned)__builtin_amdgcn_update_dpp(0, (int)v[i], 0xB1, 0xf, 0xf, true);
    return r; }
__device__ __forceinline__ float red8(float v)  { v += dpp_f<0xB1>(v); v += dpp_f<0x4E>(v); v += dpp_f<0x141>(v); return v; }
__device__ __forceinline__ float red16(float v) { v = red8(v); v += dpp_f<0x140>(v); return v; }
__device__ __forceinline__ float rsum4(float x) {
    const auto a = __builtin_amdgcn_permlane16_swap(__float_as_uint(x), __float_as_uint(x), false, false); const float s = __uint_as_float(a[0]) + __uint_as_float(a[1]);
    const auto b = __builtin_amdgcn_permlane32_swap(__float_as_uint(s), __float_as_uint(s), false, false); return __uint_as_float(b[0]) + __uint_as_float(b[1]); }
__device__ __forceinline__ float rmax4(float x) {
    const auto a = __builtin_amdgcn_permlane16_swap(__float_as_uint(x), __float_as_uint(x), false, false); const float s = fmaxf(__uint_as_float(a[0]), __uint_as_float(a[1]));
    const auto b = __builtin_amdgcn_permlane32_swap(__float_as_uint(s), __float_as_uint(s), false, false); return fmaxf(__uint_as_float(b[0]), __uint_as_float(b[1])); }
__device__ __forceinline__ float wave_sum(float v) { return rsum4(red16(v)); }
__device__ __forceinline__ float fexp(float x) { return __builtin_amdgcn_exp2f(x * 1.4426950408889634f); }
__device__ __forceinline__ float frcp(float x) { return __builtin_amdgcn_rcpf(x); }
__device__ __forceinline__ float sigmoidf_(float x) { return frcp(1.0f + fexp(-x)); }
__device__ __forceinline__ float ftanh(float x) { return 1.0f - 2.0f * frcp(1.0f + fexp(2.0f * x)); }

struct Params {
    const float *x, *norm1_gain, *w_in, *shift_mu, *decay_up, *decay_bias, *iclr_up, *iclr_bias, *gate_up,
                *k_k, *k_a, *r_k, *lnx_w, *lnx_b, *attn_out_gain, *w_out, *norm2_gain, *router_w, *router_b,
                *expert_w1, *expert_b1, *expert_w2, *expert_b2, *final_norm_gain;
    float* out;
    unsigned char* ws;
    int ph_lo, ph_hi;
};

__device__ __forceinline__ unsigned pk4_fp8(float a, float b, float c, float d) { int w = 0; w = __builtin_amdgcn_cvt_pk_fp8_f32(a, b, w, false); w = __builtin_amdgcn_cvt_pk_fp8_f32(c, d, w, true); return (unsigned)w; }
constexpr float W8_SCALE = 64.0f;
constexpr int SC_ONE = 0x7f7f7f7f, SC_W = 0x79797979;
struct TJob { const float* src; unsigned char* dst; int N, K, k0, n0, fp8; };
__device__ __forceinline__ TJob tjob(const Params& p, int j) {
    unsigned char* ws = p.ws; TJob t;
    constexpr int J_W1 = 32 * 16 * 8, J_W2 = 32 * 16 * 4, J_WIN = 16 * 13, J_WOUT = 16 * 4, J_DEC = 2, J_ICL = 2;
    if (j < J_W1) { const int e = j / 128, r = j % 128; t = TJob{p.expert_w1 + (size_t)e * DM * 2048, ws + WS_W1T + (size_t)e * 2048 * DM, 2048, DM, (r / 8) * 64, (r % 8) * 256, 1}; return t; }
    j -= J_W1;
    if (j < J_W2) { const int e = j / 64, r = j % 64; t = TJob{p.expert_w2 + (size_t)e * FF * DM, ws + WS_W2T + (size_t)e * DM * FF, DM, FF, (r / 4) * 64, (r % 4) * 256, 1}; return t; }
    j -= J_W2;
    if (j < J_WIN) { const int ct = j % 13;
        if (ct < N_BF / 256) t = TJob{p.w_in, ws + WS_WIN, INW, DM, (j / 13) * 64, ct * 256, 0};
        else t = TJob{p.w_in, ws + WS_WIN8 - (size_t)N_BF * DM, INW, DM, (j / 13) * 64, ct * 256, 1};
        return t; }
    j -= J_WIN;
    if (j < J_WOUT) { t = TJob{p.w_out, ws + WS_WOUT, DM, DM, (j / 4) * 64, (j % 4) * 256, 0}; return t; }
    j -= J_WOUT;
    if (j < J_DEC) { t = TJob{p.decay_up, ws + WS_DECUP, 512, 64, 0, j * 256, 2}; return t; }
    j -= J_DEC;
    if (j < J_ICL) { t = TJob{p.iclr_up, ws + WS_ICLUP, 512, 64, 0, j * 256, 2}; return t; }
    j -= J_ICL;
    t = TJob{p.gate_up, ws + WS_GATUP, 512, 128, (j / 2) * 64, (j % 2) * 256, 2}; return t;
}
constexpr int T_NJOBS = 32 * 16 * 8 + 32 * 16 * 4 + 16 * 13 + 16 * 4 + 2 + 2 + 4;
constexpr int T_STR = 260;
__device__ __forceinline__ void phase0(const Params& p, LAS unsigned char* lds) {
    unsigned char* ws = p.ws;
    const int tid = threadIdx.x, lane = tid & 63, wid = tid >> 6;
    {
        f32x4 g[4];
        g[0] = *(const f32x4*)(p.norm1_gain + lane * 8); g[1] = *(const f32x4*)(p.norm1_gain + lane * 8 + 4);
        g[2] = *(const f32x4*)(p.norm1_gain + 512 + lane * 8); g[3] = *(const f32x4*)(p.norm1_gain + 512 + lane * 8 + 4);
        bf16_t* o = (bf16_t*)(ws + WS_H);
        for (int row0 = (blockIdx.x * 8 + wid) * 4; row0 < NTOK; row0 += gridDim.x * 32) {
            f32x4 v[4][4];
#pragma unroll
            for (int r = 0; r < 4; ++r) { const float* xr = p.x + (size_t)(row0 + r) * DM;
                v[r][0] = __builtin_nontemporal_load((const f32x4*)(xr + lane * 8)); v[r][1] = __builtin_nontemporal_load((const f32x4*)(xr + lane * 8 + 4)); v[r][2] = __builtin_nontemporal_load((const f32x4*)(xr + 512 + lane * 8)); v[r][3] = __builtin_nontemporal_load((const f32x4*)(xr + 512 + lane * 8 + 4)); }
#pragma unroll
            for (int r = 0; r < 4; ++r) {
                float ss = 0.f;
#pragma unroll
                for (int i = 0; i < 4; ++i) ss += v[r][i][0] * v[r][i][0] + v[r][i][1] * v[r][i][1] + v[r][i][2] * v[r][i][2] + v[r][i][3] * v[r][i][3];
                ss = wave_sum(ss);
                const float rs = rsqrtf(ss * (1.0f / DM) + NORM_EPS);
                f32x4 q[4];
#pragma unroll
                for (int i = 0; i < 4; ++i) q[i] = v[r][i] * rs * g[i];
                u32x4 w0, w1;
                w0.x = cvt_pk_bf16(q[0][0], q[0][1]); w0.y = cvt_pk_bf16(q[0][2], q[0][3]); w0.z = cvt_pk_bf16(q[1][0], q[1][1]); w0.w = cvt_pk_bf16(q[1][2], q[1][3]);
                w1.x = cvt_pk_bf16(q[2][0], q[2][1]); w1.y = cvt_pk_bf16(q[2][2], q[2][3]); w1.z = cvt_pk_bf16(q[3][0], q[3][1]); w1.w = cvt_pk_bf16(q[3][2], q[3][3]);
                *(u32x4*)(o + (size_t)(row0 + r) * DM + lane * 8) = w0;
                *(u32x4*)(o + (size_t)(row0 + r) * DM + 512 + lane * 8) = w1;
                unsigned char* o8 = ws + WS_H8 + (size_t)(row0 + r) * DM;
                *(u32x2*)(o8 + lane * 8) = (u32x2){pk4_fp8(q[0][0], q[0][1], q[0][2], q[0][3]), pk4_fp8(q[1][0], q[1][1], q[1][2], q[1][3])};
                *(u32x2*)(o8 + 512 + lane * 8) = (u32x2){pk4_fp8(q[2][0], q[2][1], q[2][2], q[2][3]), pk4_fp8(q[3][0], q[3][1], q[3][2], q[3][3])};
            }
        }
    }
    LAS float* T0 = (LAS float*)lds; LAS float* T1 = T0 + 64 * T_STR;
    f32x4 rg[8];
    const int lr = tid >> 6, lc = (tid & 63) * 4;
#define T_LOAD(J) do { const TJob t_ = tjob(p, (J)); _Pragma("unroll") for (int i = 0; i < 8; ++i) rg[i] = __builtin_nontemporal_load((const f32x4*)(t_.src + (size_t)(t_.k0 + lr + 8 * i) * t_.N + t_.n0 + lc)); } while (0)
#define T_PARK(T) do { _Pragma("unroll") for (int i = 0; i < 8; ++i) *(LAS f32x4*)((T) + (lr + 8 * i) * T_STR + lc) = rg[i]; } while (0)
    int j = blockIdx.x;
    if (j < T_NJOBS) { T_LOAD(j); T_PARK(T0); }
    __syncthreads();
    for (int it = 0; j < T_NJOBS; j += gridDim.x, ++it) {
        const int jn = j + gridDim.x;
        if (jn < T_NJOBS) T_LOAD(jn);
        const TJob t = tjob(p, j);
        const LAS float* T = (it & 1) ? T1 : T0;
        {   const int n = tid >> 1, kh = tid & 1;
            float v[32];
#pragma unroll
            for (int i = 0; i < 32; ++i) v[i] = T[(32 * kh + i) * T_STR + n];
            if (t.fp8 == 1) {
                u32x4 w0, w1;
                w0.x = pk4_fp8(v[0] * W8_SCALE, v[1] * W8_SCALE, v[2] * W8_SCALE, v[3] * W8_SCALE); w0.y = pk4_fp8(v[4] * W8_SCALE, v[5] * W8_SCALE, v[6] * W8_SCALE, v[7] * W8_SCALE);
                w0.z = pk4_fp8(v[8] * W8_SCALE, v[9] * W8_SCALE, v[10] * W8_SCALE, v[11] * W8_SCALE); w0.w = pk4_fp8(v[12] * W8_SCALE, v[13] * W8_SCALE, v[14] * W8_SCALE, v[15] * W8_SCALE);
                w1.x = pk4_fp8(v[16] * W8_SCALE, v[17] * W8_SCALE, v[18] * W8_SCALE, v[19] * W8_SCALE); w1.y = pk4_fp8(v[20] * W8_SCALE, v[21] * W8_SCALE, v[22] * W8_SCALE, v[23] * W8_SCALE);
                w1.z = pk4_fp8(v[24] * W8_SCALE, v[25] * W8_SCALE, v[26] * W8_SCALE, v[27] * W8_SCALE); w1.w = pk4_fp8(v[28] * W8_SCALE, v[29] * W8_SCALE, v[30] * W8_SCALE, v[31] * W8_SCALE);
                unsigned char* d = t.dst + (size_t)(t.n0 + n) * t.K + t.k0 + 32 * kh;
                *(u32x4*)d = w0; *(u32x4*)(d + 16) = w1;
            } else {
                const int r = t.n0 + n;
                bf16_t* d = t.fp8 == 2 ? (bf16_t*)t.dst + ((size_t)(((r >> 4) * (t.K >> 5) + (t.k0 >> 5) + kh) * 64 + (r & 15))) * 8 : (bf16_t*)t.dst + (size_t)r * t.K + t.k0 + 32 * kh;
                const int qs = t.fp8 == 2 ? 128 : 8;
#pragma unroll
                for (int q = 0; q < 4; ++q) { u32x4 w; w.x = cvt_pk_bf16(v[8 * q], v[8 * q + 1]); w.y = cvt_pk_bf16(v[8 * q + 2], v[8 * q + 3]); w.z = cvt_pk_bf16(v[8 * q + 4], v[8 * q + 5]); w.w = cvt_pk_bf16(v[8 * q + 6], v[8 * q + 7]);
                    *(u32x4*)(d + qs * q) = w; }
            }
        }
        if (jn < T_NJOBS) { if (it & 1) T_PARK(T0); else T_PARK(T1); }
        __syncthreads();
    }
#undef T_LOAD
#undef T_PARK
}

namespace g8 {
constexpr int BM = 256, BK = 64, HALF = 128, HTB = HALF * BK * 2, STAGE_BYTES = 8 * HTB;
typedef int i32x8 __attribute__((ext_vector_type(8)));
typedef int i32x4v __attribute__((ext_vector_type(4)));
__device__ __forceinline__ int lds_byte(int r, int c) { const int st = (r >> 4) * 2 + (c >> 5), rr = r & 15, cc = c & 31, ob = rr * 64 + cc * 2; return st * 1024 + (ob ^ (((ob >> 9) & 1) << 5)); }
__device__ __forceinline__ void stage_rc(int b, int& R, int& C) { const int st = b / 1024, sb = b % 1024, swz = sb ^ (((sb >> 9) & 1) << 5); R = (st >> 1) * 16 + swz / 64; C = (st & 1) * 32 + (swz % 64) / 2; }
__device__ __forceinline__ int perm32(int rho) { const int n = rho >> 4, i = rho & 15; return 8 * (i >> 2) + 4 * n + (i & 3); }

struct Unit { int pm, pn, e, cnt; };

template <bool FP8, class Prob, class Epi>
__device__ __forceinline__ void gemm_phase(LAS unsigned char* lds, const Prob& S, const Epi& E) {
    constexpr int KB = FP8 ? 1024 : 2048, NT = KB / 128;
    int tid_ = threadIdx.x; asm volatile("" : "+v"(tid_));
    const int tid = tid_, wid = __builtin_amdgcn_readfirstlane(tid >> 6), lane = tid & 63, wr = wid >> 2, wc = wid & 3, fr = lane & 15, fq = lane >> 4;
    unsigned voffB[2];
#pragma unroll
    for (int i = 0; i < 2; ++i) { int R, C; stage_rc(tid * 16 + i * 8192, R, C); const int Rb = Epi::COLMAP ? (64 * (R >> 5) + perm32(R & 31)) : (Epi::PERM ? ((R & ~31) + perm32(R & 31)) : R); voffB[i] = (unsigned)(Rb * KB + C * 2); }
#define G8_AOFF(dst, U) do { _Pragma("unroll") for (int i_ = 0; i_ < 2; ++i_) { int R_, C_; stage_rc(tid * 16 + i_ * 8192, R_, C_); \
        _Pragma("unroll") for (int h_ = 0; h_ < 2; ++h_) dst[h_][i_] = S.a_off(U, h_ * HALF + R_) + (unsigned)(C_ * 2); } } while (0)
    const unsigned ldsw = (unsigned)wid * 1024u;
    const int aoff = lds_byte(wr * 64 + fr, fq * 8), boff = lds_byte(wc * 32 + fr, fq * 8);
    const char* const Abase = S.Abase;
#define G8_SA(b, h) (((b) * 2 + (h)) * HTB)
#define G8_SB(b, h) ((4 + (b) * 2 + (h)) * HTB)
#define G8_GLDS(gp, bufoff, i) __builtin_amdgcn_global_load_lds((const unsigned*)(gp), (LAS unsigned*)(lds + (bufoff) + ldsw + (i) * 8192), 16, 0, 0)
#define G8_STA(bufoff, AO, h, kb) do { const char* ak_ = Abase + (size_t)((kb) >> 7) * Prob::A_KSTEP; G8_GLDS(ak_ + (AO)[h][0], bufoff, 0); G8_GLDS(ak_ + (AO)[h][1], bufoff, 1); } while (0)
#define G8_STB(bufoff, bp) do { G8_GLDS((bp) + voffB[0], bufoff, 0); G8_GLDS((bp) + voffB[1], bufoff, 1); } while (0)
#define G8_LDA(dst, b, h) do { _Pragma("unroll") for (int m = 0; m < 4; ++m) _Pragma("unroll") for (int k = 0; k < 2; ++k) dst[m][k] = *(const LAS bf16x8*)(lds + G8_SA(b, h) + aoff + m * 2048 + k * 1024); } while (0)
#define G8_LDB(dst, b, h) do { _Pragma("unroll") for (int n = 0; n < 2; ++n) _Pragma("unroll") for (int k = 0; k < 2; ++k) dst[n][k] = *(const LAS bf16x8*)(lds + G8_SB(b, h) + boff + n * 2048 + k * 1024); } while (0)
#define G8_MMA(ai, bj, At, Bt) do { __builtin_amdgcn_s_setprio(1); \
        if (FP8) { i32x8 wf_[2], xf_[4]; \
            _Pragma("unroll") for (int n = 0; n < 2; ++n) wf_[n] = __builtin_shufflevector(__builtin_bit_cast(i32x4v, Bt[n][0]), __builtin_bit_cast(i32x4v, Bt[n][1]), 0, 1, 2, 3, 4, 5, 6, 7); \
            _Pragma("unroll") for (int m = 0; m < 4; ++m) xf_[m] = __builtin_shufflevector(__builtin_bit_cast(i32x4v, At[m][0]), __builtin_bit_cast(i32x4v, At[m][1]), 0, 1, 2, 3, 4, 5, 6, 7); \
            asm volatile("s_nop 1" ::: "memory"); \
            _Pragma("unroll") for (int m = 0; m < 4; ++m) _Pragma("unroll") for (int n = 0; n < 2; ++n) \
                asm volatile("v_mfma_f32_16x16x128_f8f6f4 %0, %1, %2, %0" : "+v"(acc[ai][bj][m][n]) : "v"(wf_[n]), "v"(xf_[m])); } \
        else { _Pragma("unroll") for (int m = 0; m < 4; ++m) _Pragma("unroll") for (int n = 0; n < 2; ++n) _Pragma("unroll") for (int k = 0; k < 2; ++k) \
            acc[ai][bj][m][n] = __builtin_amdgcn_mfma_f32_16x16x32_bf16(Bt[n][k], At[m][k], acc[ai][bj][m][n], 0, 0, 0); } \
        __builtin_amdgcn_s_setprio(0); } while (0)
#define G8_WAIT_V(n) asm volatile("s_waitcnt vmcnt(" #n ")" ::: "memory")
#define G8_WAIT_L(n) asm volatile("s_waitcnt lgkmcnt(" #n ")" ::: "memory")
#define G8_BAR __builtin_amdgcn_s_barrier()
#define G8_SCHED __builtin_amdgcn_sched_barrier(0)
    Unit cur, nxt; int ui = 0;
    if (!S.next(0, cur)) return;
    f32x4 acc[2][2][4][2];
#pragma unroll
    for (int a = 0; a < 2; ++a)
#pragma unroll
        for (int b = 0; b < 2; ++b)
#pragma unroll
            for (int m = 0; m < 4; ++m)
#pragma unroll
                for (int n = 0; n < 2; ++n) acc[a][b][m][n] = (f32x4){0.f, 0.f, 0.f, 0.f};
    bf16x8 At[4][2], B0[2][2], B1[2][2];
    unsigned ao[2][2], nao[2][2];
    G8_AOFF(ao, cur);
    const char* cB[2] = {S.template b_ptr<Epi::COLMAP>(cur, 0), S.template b_ptr<Epi::COLMAP>(cur, 1)};
    int rot = S.rot(cur) & (NT - 1), nrot;
    { const int kp0 = rot * 128, kp1 = ((rot + 1) & (NT - 1)) * 128;
      G8_STB(G8_SB(0, 0), cB[0] + kp0); G8_STA(G8_SA(0, 0), ao, 0, kp0); G8_STB(G8_SB(0, 1), cB[1] + kp0); G8_STA(G8_SA(0, 1), ao, 1, kp0);
      if (wr == 1) G8_BAR;
      G8_WAIT_V(4); G8_BAR;
      G8_STB(G8_SB(1, 0), cB[0] + kp1); G8_STA(G8_SA(1, 0), ao, 0, kp1); G8_STB(G8_SB(1, 1), cB[1] + kp1);
      G8_WAIT_V(6); G8_BAR; }
    for (;;) {
        E.prefetch(cur, lds + STAGE_BYTES + wid * 2048, wid, lane);
        const bool has_next = S.next(ui + 1, nxt);
        const char* nB[2];
        if (has_next) {
            G8_AOFF(nao, nxt);
            nB[0] = S.template b_ptr<Epi::COLMAP>(nxt, 0); nB[1] = S.template b_ptr<Epi::COLMAP>(nxt, 1); nrot = S.rot(nxt) & (NT - 1);
        } else {
            nrot = rot;
#pragma unroll
            for (int h = 0; h < 2; ++h)
#pragma unroll
                for (int i = 0; i < 2; ++i) nao[h][i] = ao[h][i];
            nB[0] = cB[0]; nB[1] = cB[1];
        }
#pragma nounroll
        for (int t = 0; t < NT; t += 2) {
            const bool last = (t == NT - 2);
            const int kb1 = ((t + 1 + rot) & (NT - 1)) * 128, kb2 = (last ? nrot : ((t + 2 + rot) & (NT - 1))) * 128, kb3 = (last ? ((nrot + 1) & (NT - 1)) : ((t + 3 + rot) & (NT - 1))) * 128;
            unsigned a2[2][2];
#pragma unroll
            for (int h = 0; h < 2; ++h)
#pragma unroll
                for (int i = 0; i < 2; ++i) a2[h][i] = last ? nao[h][i] : ao[h][i];
            const char* bq0 = last ? nB[0] : cB[0]; const char* bq1 = last ? nB[1] : cB[1];
            const char* b20 = bq0 + kb2; const char* b21 = bq1 + kb2; const char* b30 = bq0 + kb3; const char* b31 = bq1 + kb3;
            G8_LDB(B0, 0, 0); G8_SCHED; G8_LDA(At, 0, 0); G8_STA(G8_SA(1, 1), ao, 1, kb1);
            G8_WAIT_L(8); G8_BAR; G8_WAIT_L(0); G8_MMA(0, 0, At, B0); G8_BAR; G8_SCHED;
            G8_LDB(B1, 0, 1); G8_STB(G8_SB(0, 0), b20);
            G8_BAR; G8_WAIT_L(0); G8_MMA(0, 1, At, B1); G8_BAR;
            G8_LDA(At, 0, 1); G8_STA(G8_SA(0, 0), a2, 0, kb2);
            G8_BAR; G8_WAIT_L(0); G8_MMA(1, 0, At, B0); G8_BAR; G8_SCHED;
            G8_STB(G8_SB(0, 1), b21);
            G8_WAIT_V(6); G8_BAR; G8_MMA(1, 1, At, B1); G8_BAR;
            G8_LDB(B0, 1, 0); G8_SCHED; G8_LDA(At, 1, 0); G8_STA(G8_SA(0, 1), a2, 1, kb2);
            G8_WAIT_L(8); G8_BAR; G8_WAIT_L(0); G8_MMA(0, 0, At, B0); G8_BAR; G8_SCHED;
            G8_LDB(B1, 1, 1); G8_STB(G8_SB(1, 0), b30);
            G8_BAR; G8_WAIT_L(0); G8_MMA(0, 1, At, B1); G8_BAR;
            G8_LDA(At, 1, 1); G8_STA(G8_SA(1, 0), a2, 0, kb3);
            G8_BAR; G8_WAIT_L(0); G8_MMA(1, 0, At, B0); G8_BAR; G8_SCHED;
            G8_STB(G8_SB(1, 1), b31);
            G8_WAIT_V(6); G8_BAR; G8_MMA(1, 1, At, B1); G8_BAR;
        }
        if (FP8) asm volatile("s_nop 15\n\ts_nop 15" ::: "memory");
        E(acc, cur, wr, wc, fr, fq, lds + STAGE_BYTES + wid * 2048);
        if (!has_next) break;
#pragma unroll
        for (int a = 0; a < 2; ++a)
#pragma unroll
            for (int b = 0; b < 2; ++b)
#pragma unroll
                for (int m = 0; m < 4; ++m)
#pragma unroll
                    for (int n = 0; n < 2; ++n) acc[a][b][m][n] = (f32x4){0.f, 0.f, 0.f, 0.f};
        cur = nxt; cB[0] = nB[0]; cB[1] = nB[1]; rot = nrot; ++ui;
#pragma unroll
        for (int h = 0; h < 2; ++h)
#pragma unroll
            for (int i = 0; i < 2; ++i) ao[h][i] = nao[h][i];
    }
    G8_WAIT_V(0);
    if (wr == 0) G8_BAR;
    G8_BAR;
#undef G8_SA
#undef G8_AOFF
#undef G8_SB
#undef G8_GLDS
#undef G8_STA
#undef G8_STB
#undef G8_LDA
#undef G8_LDB
#undef G8_MMA
#undef G8_WAIT_V
#undef G8_WAIT_L
#undef G8_BAR
#undef G8_SCHED
}

template <int PITCH, bool APLANES = false>
struct DenseProbT {
    static constexpr size_t A_KSTEP = APLANES ? (size_t)SEQ * 128 : 128;
    const char* Abase; const char* Bt; int nM, nN, nwg, G, c;
    __device__ __forceinline__ void init(const void* A, const void* B, int M, int N, int G_, int c_) { Abase = (const char*)A; Bt = (const char*)B; nM = M / BM; nN = N / BM; nwg = nM * nN; G = G_; c = c_; }
    __device__ __forceinline__ bool next(int i, Unit& u) const {
        const long L = (long)i * G + c; if (L >= nwg) return false;
        int wgid = (int)L; { const int q = nwg / 8, r = nwg % 8, xcd = wgid % 8, off = wgid / 8; wgid = (xcd < r ? xcd * (q + 1) : r * (q + 1) + (xcd - r) * q) + off; }
        const int nig = 8 * nN, gid = wgid / nig, fm = gid * 8, gsz = (nM - fm) < 8 ? (nM - fm) : 8;
        u.pm = fm + ((wgid % nig) % gsz); u.pn = (wgid % nig) / gsz; u.e = 0; u.cnt = 256; return true;
    }
    __device__ __forceinline__ int rot(const Unit&) const { return 0; }
    __device__ __forceinline__ unsigned a_off(const Unit& u, int row) const { return APLANES ? (unsigned)(((u.pm >> 3) * (PITCH / 128)) * SEQ + (u.pm & 7) * BM + row) * 128u : (unsigned)(u.pm * BM + row) * (unsigned)PITCH; }
    template <bool CM> __device__ __forceinline__ const char* b_ptr(const Unit& u, int half) const { return Bt + (size_t)(u.pn * BM + half * (CM ? 32 : HALF)) * PITCH; }
};
typedef DenseProbT<2048> DenseProb;
}

template <bool SCALED>
struct EpiZT {
    static constexpr bool PERM = true, COLMAP = true;
    bf16_t* O; int c0;
    __device__ __forceinline__ void prefetch(const g8::Unit&, LAS unsigned char*, int, int) const {}
    __device__ __forceinline__ void operator()(const f32x4 (&acc)[2][2][4][2], const g8::Unit& u, int wr, int wc, int fr, int fq, LAS unsigned char*) const {
        const bool odd = (fr & 1) != 0;
        const int tA = (u.pm & 7) * 256 + wr * 64 + (fr & ~1);
        bf16_t* plane = O + zoff(u.pm >> 3, (c0 >> 6) + u.pn * 4 + wc, tA) + 8 * fq + (odd ? 32 : 0);
        const float sc = SCALED ? 1.0f / W8_SCALE : 1.0f;
#pragma unroll
        for (int ai = 0; ai < 2; ++ai)
#pragma unroll
            for (int m = 0; m < 4; ++m) { bf16_t* rowp = plane + (ai * 128 + m * 16) * 64;
                u32x4 w[2];
#pragma unroll
                for (int bj = 0; bj < 2; ++bj) { const f32x4 v0 = SCALED ? acc[ai][bj][m][0] * sc : acc[ai][bj][m][0], v1 = SCALED ? acc[ai][bj][m][1] * sc : acc[ai][bj][m][1];
                    w[bj].x = cvt_pk_bf16(v0[0], v0[1]); w[bj].y = cvt_pk_bf16(v0[2], v0[3]); w[bj].z = cvt_pk_bf16(v1[0], v1[1]); w[bj].w = cvt_pk_bf16(v1[2], v1[3]); }
                const u32x4 snd = odd ? w[0] : w[1]; const u32x4 rcv = xchg1(snd);
                *(u32x4*)rowp = odd ? rcv : w[0]; *(u32x4*)(rowp + 64) = odd ? w[1] : rcv; }
    }
};
struct EpiX1 {
    static constexpr bool PERM = true, COLMAP = true;
    const float* X; bf16_t* O;
    __device__ __forceinline__ void prefetch(const g8::Unit&, LAS unsigned char*, int, int) const {}
    __device__ __forceinline__ void operator()(const f32x4 (&acc)[2][2][4][2], const g8::Unit& u, int wr, int wc, int fr, int fq, LAS unsigned char*) const {
        const bool odd = (fr & 1) != 0;
        const int row0 = u.pm * 256 + wr * 64 + fr, col0 = u.pn * 256 + wc * 64 + 8 * fq;
        const int rowA = u.pm * 256 + wr * 64 + (fr & ~1), colS = col0 + (odd ? 32 : 0);
#pragma unroll
        for (int ai = 0; ai < 2; ++ai) {
            f32x4 xv[4][2][2];
#pragma unroll
            for (int m = 0; m < 4; ++m) { const size_t off = (size_t)(row0 + ai * 128 + m * 16) * DM + col0;
#pragma unroll
                for (int bj = 0; bj < 2; ++bj) { xv[m][bj][0] = __builtin_nontemporal_load((const f32x4*)(X + off + bj * 32)); xv[m][bj][1] = __builtin_nontemporal_load((const f32x4*)(X + off + bj * 32 + 4)); } }
#pragma unroll
            for (int m = 0; m < 4; ++m) { bf16_t* rowp = O + (size_t)(rowA + ai * 128 + m * 16) * DM + colS;
                u32x4 w[2];
#pragma unroll
                for (int bj = 0; bj < 2; ++bj) { const f32x4 v0 = xv[m][bj][0] + acc[ai][bj][m][0], v1 = xv[m][bj][1] + acc[ai][bj][m][1];
                    w[bj].x = cvt_pk_bf16(v0[0], v0[1]); w[bj].y = cvt_pk_bf16(v0[2], v0[3]); w[bj].z = cvt_pk_bf16(v1[0], v1[1]); w[bj].w = cvt_pk_bf16(v1[2], v1[3]); }
                const u32x4 snd = odd ? w[0] : w[1]; const u32x4 rcv = xchg1(snd);
                *(u32x4*)rowp = odd ? rcv : w[0]; *(u32x4*)(rowp + DM) = odd ? w[1] : rcv; }
            asm volatile("" ::: "memory");
        }
    }
};

__device__ __forceinline__ f32x4 ld_bf4(const bf16_t* p) { const u32x2 w = *(const u32x2*)p; return (f32x4){bf_lo(w.x), bf_hi(w.x), bf_lo(w.y), bf_hi(w.y)}; }
__device__ __forceinline__ void ld_bf8(const bf16_t* p, float (&o)[8]) { const u32x4 w = *(const u32x4*)p; o[0] = bf_lo(w.x); o[1] = bf_hi(w.x); o[2] = bf_lo(w.y); o[3] = bf_hi(w.y); o[4] = bf_lo(w.z); o[5] = bf_hi(w.z); o[6] = bf_lo(w.w); o[7] = bf_hi(w.w); }
__device__ __forceinline__ void rwkv_lora_act(const Params& p) {
    const bf16_t* z = (const bf16_t*)(p.ws + WS_Z); bf16_t* act = (bf16_t*)(p.ws + WS_LACT);
    const int sub = threadIdx.x & 31;
    const int col = 8 * sub;
    const f32x4 m0 = *(const f32x4*)(p.shift_mu + 1536 + col), m1 = *(const f32x4*)(p.shift_mu + 1536 + col + 4);
    for (int tok0 = blockIdx.x * 16 + (threadIdx.x >> 5); tok0 < NTOK; tok0 += gridDim.x * 64) {
        u32x4 cw[4], pw[4];
#pragma unroll
        for (int q = 0; q < 4; ++q) { const int tok = tok0 + q * gridDim.x * 16; const bf16_t* zt = z + zoff(tok >> 11, 48 + (sub >> 3), tok & (SEQ - 1)) + 8 * (sub & 7);
            cw[q] = *(const u32x4*)zt; pw[q] = *(const u32x4*)(zt - ((tok & (SEQ - 1)) != 0 ? 64 : 0)); }
#pragma unroll
        for (int q = 0; q < 4; ++q) { const int tok = tok0 + q * gridDim.x * 16;
            const float hm = (tok & (SEQ - 1)) != 0 ? 1.0f : 0.0f;
            const float c[8] = {bf_lo(cw[q].x), bf_hi(cw[q].x), bf_lo(cw[q].y), bf_hi(cw[q].y), bf_lo(cw[q].z), bf_hi(cw[q].z), bf_lo(cw[q].w), bf_hi(cw[q].w)};
            const float pv[8] = {bf_lo(pw[q].x), bf_hi(pw[q].x), bf_lo(pw[q].y), bf_hi(pw[q].y), bf_lo(pw[q].z), bf_hi(pw[q].z), bf_lo(pw[q].w), bf_hi(pw[q].w)};
            float v[8];
#pragma unroll
            for (int j = 0; j < 8; ++j) { const float mm = j < 4 ? m0[j] : m1[j - 4]; float x = c[j] + (pv[j] * hm - c[j]) * mm;
                if (col < 64) x = ftanh(x); else if (col >= 128) x = sigmoidf_(x); v[j] = x; }
            u32x4 w; w.x = cvt_pk_bf16(v[0], v[1]); w.y = cvt_pk_bf16(v[2], v[3]); w.z = cvt_pk_bf16(v[4], v[5]); w.w = cvt_pk_bf16(v[6], v[7]);
            *(u32x4*)(act + (size_t)tok * 256 + col) = w; }
    }
}
constexpr int C_MUR = 256, C_MUK = 320, C_MUV = 384, C_DB = 448, C_IB = 512, C_KK = 576, C_KA = 640, C_RK = 704, C_LW = 768, C_LB = 832, C_N = 896;
__device__ __forceinline__ f32x4 up4(u32x2 w) { return (f32x4){bf_lo(w.x), bf_hi(w.x), bf_lo(w.y), bf_hi(w.y)}; }
__device__ __forceinline__ f32x4 lerp4r(u32x2 cur, u32x2 prv, float hm, f32x4 m) { const f32x4 c = up4(cur); return c + (up4(prv) * hm - c) * m; }
constexpr int CK = 16, NIV = SEQ / (CK * 8);
constexpr int CS = 72;
constexpr int SL_VV = 0, SL_RH = 2304, SL_BB = 4608, SL_KB = 6912, SL_AB = 9216  , SL_WT = 12288  , SL_ABR = 14336, SL_AKR = 14848, SL_GC = 15360  ,
              SL_Y = 15616  , SL_SIZE = 17920;
constexpr int RC_CST = 8 * SL_SIZE;
constexpr int RC_W = RC_CST + C_N * 4;
static_assert(RC_W + 16384 <= 160 * 1024 - 64, "chunked rwkv lds");
typedef short s16x4v __attribute__((ext_vector_type(4)));
typedef __bf16 bf16x2t __attribute__((ext_vector_type(2)));
__device__ __forceinline__ unsigned pkv(float lo, float hi) { return __builtin_bit_cast(unsigned, __builtin_convertvector((f32x2){lo, hi}, bf16x2t)); }
__device__ __forceinline__ s16x4v pk4(f32x4 v) { u32x2 w; w.x = pkv(v[0], v[1]); w.y = pkv(v[2], v[3]); return __builtin_bit_cast(s16x4v, w); }
__device__ __forceinline__ f32x4 mm16(s16x4v a, s16x4v b, f32x4 c) { return __builtin_amdgcn_mfma_f32_16x16x16bf16_1k(a, b, c, 0, 0, 0); }
__device__ __forceinline__ bf16x8 cat8(s16x4v a, s16x4v b) { return __builtin_shufflevector(a, b, 0, 1, 2, 3, 4, 5, 6, 7); }
__device__ __forceinline__ f32x4 mm32(bf16x8 a, bf16x8 b, f32x4 c) { return __builtin_amdgcn_mfma_f32_16x16x32_bf16(a, b, c, 0, 0, 0); }
__device__ __forceinline__ s16x4v trread(unsigned addr) { s16x4v r; asm volatile("ds_read_b64_tr_b16 %0, %1\n\ts_waitcnt lgkmcnt(0)" : "=&v"(r) : "v"(addr) : "memory"); return r; }
template <int SH> __device__ __forceinline__ float dpp_shr(float v) { return __int_as_float(__builtin_amdgcn_update_dpp(0, __float_as_int(v), 0x110 + SH, 0xf, 0xf, true)); }

__device__ __forceinline__ void phase_rwkv(const Params& p, LAS unsigned char* lds) {
    const int tid = threadIdx.x, wid = __builtin_amdgcn_readfirstlane(tid >> 6), lane0 = tid & 63;
    const bf16_t* z = (const bf16_t*)(p.ws + WS_Z); const bf16_t* act = (const bf16_t*)(p.ws + WS_LACT);
    const bf16_t* decT = (const bf16_t*)(p.ws + WS_DECUP); const bf16_t* iclT = (const bf16_t*)(p.ws + WS_ICLUP); const bf16_t* gatT = (const bf16_t*)(p.ws + WS_GATUP);
    const f32x4 zero4 = (f32x4){0.f, 0.f, 0.f, 0.f};
    for (int slot_ = blockIdx.x; slot_ < 256; slot_ += gridDim.x) {
        const int b = 4 * (slot_ & 7) + (slot_ >> 6), h = (slot_ >> 3) & 7, bh = b * 8 + h;
        {
            LAS float* C = (LAS float*)(lds + RC_CST);
            for (int i = tid; i < C_N; i += 512) {
                float v;
                if (i < 256) v = 0.f;
                else if (i < 320) v = p.shift_mu[64 * h + (i - 256)];
                else if (i < 384) v = p.shift_mu[512 + 64 * h + (i - 320)];
                else if (i < 448) v = p.shift_mu[1024 + 64 * h + (i - 384)];
                else if (i < 512) v = p.decay_bias[64 * h + (i - 448)];
                else if (i < 576) v = p.iclr_bias[64 * h + (i - 512)];
                else if (i < 640) v = p.k_k[64 * h + (i - 576)];
                else if (i < 704) v = p.k_a[64 * h + (i - 640)];
                else if (i < 768) v = p.r_k[64 * h + (i - 704)];
                else if (i < 832) v = p.lnx_w[64 * h + (i - 768)];
                else v = p.lnx_b[64 * h + (i - 832)];
                C[i] = v;
            }
#pragma unroll
            for (int i = 0; i < 2; ++i) { const int cidx = tid + 512 * i;
                const bf16_t* src = (cidx < 512 ? decT : iclT) + (size_t)h * 4096 + (cidx & 511) * 8;
                *(LAS u32x4*)(lds + RC_W + cidx * 16) = *(const u32x4*)src; }
        }
        __syncthreads();
        const LAS float* CS_ = (const LAS float*)(lds + RC_CST);
        LAS unsigned char* slot = lds + wid * SL_SIZE;
        f32x4 ST[4] = {zero4, zero4, zero4, zero4};
        u32x4 zw[7];
#define RW_LOADZ(iv_, lane_, I0, I1) do { const int t0_ = CK * ((iv_) * 8 + wid); \
            _Pragma("unroll") for (int i = I0; i < I1; ++i) { const int idx_ = 64 * i + (lane_); int pz_ = idx_ >> 3; pz_ = pz_ > 50 ? 50 : pz_; const int a_ = pz_ >= 34 ? 2 : (pz_ >= 17 ? 1 : 0); \
                int tr_ = t0_ - 1 + pz_ - 17 * a_; tr_ = tr_ < 0 ? 0 : tr_; \
                zw[i] = *(const u32x4*)(z + zoff(b, RW_OFF / 64 + h + 8 * a_, tr_) + 8 * (idx_ & 7)); } } while (0)
        RW_LOADZ(0, lane0, 0, 5);
#pragma nounroll
        for (int iv = 0; iv < NIV; ++iv) {
            int lane = lane0; asm volatile("" : "+v"(lane));
            const int n = lane & 15, g = lane >> 4;
            const int c = iv * 8 + wid, t = CK * c + n;
            f32x4 gate4[4], v4[4]; float bonus;
            {
                const float hm = t > 0 ? 1.0f : 0.0f;
                const bf16_t* at = act + (size_t)(b * SEQ + t) * 256 + 8 * g;
                f32x4 r4[4], k4[4], lw4[4], an4[4], bn4[4], kn4[4]; float ssq = 0.f;
                bf16x8 xw_[2], xa_[2], xg_[4];
#pragma unroll
                for (int s2 = 0; s2 < 2; ++s2) { xw_[s2] = *(const bf16x8*)(at + 32 * s2); xa_[s2] = *(const bf16x8*)(at + 64 + 32 * s2); }
#pragma unroll
                for (int s2 = 0; s2 < 4; ++s2) xg_[s2] = *(const bf16x8*)(at + 128 + 32 * s2);
                RW_LOADZ(iv, lane, 5, 7);
#define RW_PARK(I0, I1) do { _Pragma("unroll") for (int i = I0; i < I1; ++i) { const int idx = 64 * i + lane; int pz = idx >> 3; pz = pz > 50 ? 50 : pz; *(LAS u32x4*)(slot + pz * 144 + (idx & 7) * 16) = zw[i]; } } while (0)
                RW_PARK(0, 5);
                asm volatile("s_waitcnt lgkmcnt(0)" ::: "memory");
                const LAS unsigned char* zs = slot + n * 144 + 8 * g;
                u32x2 zk[4][2];
#pragma unroll
                for (int ct = 0; ct < 4; ++ct) { zk[ct][1] = *(const LAS u32x2*)(zs + 17 * 144 + 32 * ct); zk[ct][0] = *(const LAS u32x2*)(zs + 18 * 144 + 32 * ct); }
                bf16x8 wD[2][4];
#pragma unroll
                for (int s2 = 0; s2 < 2; ++s2)
#pragma unroll
                    for (int ct = 0; ct < 4; ++ct) wD[s2][ct] = *(const LAS bf16x8*)(lds + RC_W + (ct * 2 + s2) * 1024 + lane * 16);
                asm volatile("" ::: "memory");
#pragma unroll
                for (int ct = 0; ct < 4; ++ct) { const int cl = 16 * ct + 4 * g;
                    k4[ct] = lerp4r(zk[ct][0], zk[ct][1], hm, *(const LAS f32x4*)(CS_ + C_MUK + cl));
                    const f32x4 kk4 = k4[ct] * *(const LAS f32x4*)(CS_ + C_KK + cl); ssq += (kk4[0] * kk4[0] + kk4[1] * kk4[1]) + (kk4[2] * kk4[2] + kk4[3] * kk4[3]); }
                ssq = rsum4(ssq);
                const float inv = frcp(fmaxf(sqrtf(ssq), 1e-12f));
                bf16x8 wI[2][4];
                {   f32x4 aw[4] = {zero4, zero4, zero4, zero4};
#pragma unroll
                    for (int s2 = 0; s2 < 2; ++s2) { const bf16x8 xw = xw_[s2];
#pragma unroll
                        for (int ct = 0; ct < 4; ++ct) aw[ct] = __builtin_amdgcn_mfma_f32_16x16x32_bf16(wD[s2][ct], xw, aw[ct], 0, 0, 0); }
#pragma unroll
                    for (int s2 = 0; s2 < 2; ++s2)
#pragma unroll
                        for (int ct = 0; ct < 4; ++ct) wI[s2][ct] = *(const LAS bf16x8*)(lds + RC_W + 8192 + (ct * 2 + s2) * 1024 + lane * 16);
                    asm volatile("" ::: "memory");
#pragma unroll
                    for (int ct = 0; ct < 4; ++ct) { const f32x4 db = *(const LAS f32x4*)(CS_ + C_DB + 16 * ct + 4 * g);
#pragma unroll
                        for (int i = 0; i < 4; ++i) lw4[ct][i] = -0.6065306597126334f * frcp(1.0f + fexp(-(db[i] + aw[ct][i]))); } }
                asm volatile("" ::: "memory");
                float bon = 0.f;
                {   f32x4 aa[4] = {zero4, zero4, zero4, zero4};
#pragma unroll
                    for (int s2 = 0; s2 < 2; ++s2) { const bf16x8 xa = xa_[s2];
#pragma unroll
                        for (int ct = 0; ct < 4; ++ct) aa[ct] = __builtin_amdgcn_mfma_f32_16x16x32_bf16(wI[s2][ct], xa, aa[ct], 0, 0, 0); }
#pragma unroll
                    for (int ct = 0; ct < 4; ++ct) { const int cl = 16 * ct + 4 * g;
                        r4[ct] = lerp4r(*(const LAS u32x2*)(zs + 144 + 32 * ct), *(const LAS u32x2*)(zs + 32 * ct), hm, *(const LAS f32x4*)(CS_ + C_MUR + cl));
                        const f32x4 ib = *(const LAS f32x4*)(CS_ + C_IB + cl), kkw = *(const LAS f32x4*)(CS_ + C_KK + cl), kaw = *(const LAS f32x4*)(CS_ + C_KA + cl), rkw = *(const LAS f32x4*)(CS_ + C_RK + cl);
#pragma unroll
                        for (int i = 0; i < 4; ++i) { const float a = sigmoidf_(ib[i] + aa[ct][i]); const float kk = k4[ct][i] * kkw[i] * inv;
                            kn4[ct][i] = k4[ct][i] * (1.0f + (a - 1.0f) * kaw[i]); an4[ct][i] = -kk; bn4[ct][i] = kk * a; bon += r4[ct][i] * kn4[ct][i] * rkw[i]; } } }
                bon = rsum4(bon); bonus = bon;
                asm volatile("" ::: "memory");
                RW_PARK(5, 7);
                asm volatile("s_waitcnt lgkmcnt(0)" ::: "memory");
#pragma unroll
                for (int ct = 0; ct < 4; ++ct) v4[ct] = lerp4r(*(const LAS u32x2*)(zs + 35 * 144 + 32 * ct), *(const LAS u32x2*)(zs + 34 * 144 + 32 * ct), hm, *(const LAS f32x4*)(CS_ + C_MUV + 16 * ct + 4 * g));
                asm volatile("s_waitcnt lgkmcnt(0)" ::: "memory");
                f32x4 lg4[4];
#pragma unroll
                for (int ct = 0; ct < 4; ++ct)
#pragma unroll
                    for (int i = 0; i < 4; ++i) { float x = lw4[ct][i]; x += dpp_shr<1>(x); x += dpp_shr<2>(x); x += dpp_shr<4>(x); x += dpp_shr<8>(x); lg4[ct][i] = x; }
                s16x4v fAh[4], fBh[4], fKh[4], fRh[4];
                LAS bf16_t* imVV = (LAS bf16_t*)(slot + SL_VV); LAS bf16_t* imRH = (LAS bf16_t*)(slot + SL_RH); LAS bf16_t* imBB = (LAS bf16_t*)(slot + SL_BB); LAS bf16_t* imKB = (LAS bf16_t*)(slot + SL_KB); LAS bf16_t* imAH = (LAS bf16_t*)(slot + SL_Y);
#pragma unroll
                for (int ct = 0; ct < 4; ++ct) { f32x4 gg, gp, gi, gr, gc;
#pragma unroll
                    for (int i = 0; i < 4; ++i) { gg[i] = fexp(lg4[ct][i]); gi[i] = frcp(gg[i]); const float sh = dpp_shr<1>(gg[i]); gp[i] = n == 0 ? 1.0f : sh;
                        gc[i] = __int_as_float(__builtin_amdgcn_update_dpp(0, __float_as_int(gg[i]), 0x15F, 0xf, 0xf, false)); gr[i] = gc[i] * gi[i]; }
                    fAh[ct] = pk4(an4[ct] * gp); fBh[ct] = pk4(bn4[ct] * gi); fKh[ct] = pk4(kn4[ct] * gi); fRh[ct] = pk4(r4[ct] * gg);
                    const int o = n * CS + 16 * ct + 4 * g;
                    *(LAS s16x4v*)(imAH + o) = fAh[ct]; *(LAS s16x4v*)(imRH + o) = fRh[ct]; *(LAS s16x4v*)(imVV + o) = pk4(v4[ct]);
                    *(LAS s16x4v*)(imBB + o) = pk4(bn4[ct] * gr); *(LAS s16x4v*)(imKB + o) = pk4(kn4[ct] * gr);
                    if (n == 15) *(LAS f32x4*)(slot + SL_GC + (16 * ct + 4 * g) * 4) = gc; }
                bf16x8 wG[4][4];
#pragma unroll
                for (int s2 = 0; s2 < 4; ++s2)
#pragma unroll
                    for (int ct = 0; ct < 4; ++ct) wG[s2][ct] = *(const bf16x8*)(gatT + (size_t)(((4 * h + ct) * 4 + s2) * 64 + lane) * 8);
                asm volatile("" ::: "memory");
                f32x4 dA = zero4, dAt = zero4, dKbT = zero4, dBr = zero4, dKr = zero4;
#pragma unroll
                for (int ct = 0; ct < 4; ct += 2) { const bf16x8 a8 = cat8(fAh[ct], fAh[ct + 1]), b8 = cat8(fBh[ct], fBh[ct + 1]), k8 = cat8(fKh[ct], fKh[ct + 1]), r8 = cat8(fRh[ct], fRh[ct + 1]);
                    dA = mm32(b8, a8, dA); dAt = mm32(a8, b8, dAt); dKbT = mm32(a8, k8, dKbT); dBr = mm32(b8, r8, dBr); dKr = mm32(k8, r8, dKr); }
                f32x4 idn;
#pragma unroll
                for (int i = 0; i < 4; ++i) { const int m = 4 * g + i;
                    dA[i] = m < n ? dA[i] : 0.f; dAt[i] = n < m ? dAt[i] : 0.f; dKbT[i] = n < m ? dKbT[i] : 0.f; dBr[i] = m <= n ? dBr[i] : 0.f; dKr[i] = m <= n ? dKr[i] : 0.f; idn[i] = m == n ? 1.0f : 0.f; }
                const s16x4v pA = pk4(dA), pAt = pk4(dAt);
                const f32x4 dA2 = mm16(pAt, pA, zero4), dA2t = mm16(pA, pAt, zero4);
                const s16x4v pA2 = pk4(dA2), pA2t = pk4(dA2t);
                const f32x4 dA4 = mm16(pA2t, pA2, zero4), dA4t = mm16(pA2, pA2t, zero4);
                const s16x4v pA4 = pk4(dA4), pA4t = pk4(dA4t);
                const f32x4 dA8 = mm16(pA4t, pA4, zero4);
                const f32x4 dT1 = mm16(pAt, pA2, idn + dA + dA2), dT1t = mm16(pA2, pAt, idn + dAt + dA2t);
                const s16x4v pT1 = pk4(dT1), pT1t = pk4(dT1t);
                const f32x4 dT2 = mm16(pT1t, pA4, dT1), dT2t = mm16(pA4, pT1t, dT1t);
                const f32x4 dT = mm16(pk4(dT2t), pk4(dA8), dT2);
                const s16x4v pT = pk4(dT);
                const f32x4 dX = mm16(pk4(dKbT), pT, zero4);
                const s16x4v pX = pk4(dX);
                *(LAS s16x4v*)(slot + SL_ABR + lane * 8) = pk4(dBr); *(LAS s16x4v*)(slot + SL_AKR + lane * 8) = pk4(dKr);
                asm volatile("s_waitcnt lgkmcnt(0)" ::: "memory");
                const unsigned aAH = (unsigned)(size_t)(imAH + (4 * g + (n >> 2)) * CS + 4 * (n & 3)), aVV = (unsigned)(size_t)(imVV + (4 * g + (n >> 2)) * CS + 4 * (n & 3));
                s16x4v tA[4], tV[4];
                asm volatile("ds_read_b64_tr_b16 %0, %8\n\tds_read_b64_tr_b16 %1, %8 offset:32\n\tds_read_b64_tr_b16 %2, %8 offset:64\n\tds_read_b64_tr_b16 %3, %8 offset:96\n\t"
                             "ds_read_b64_tr_b16 %4, %9\n\tds_read_b64_tr_b16 %5, %9 offset:32\n\tds_read_b64_tr_b16 %6, %9 offset:64\n\tds_read_b64_tr_b16 %7, %9 offset:96\n\ts_waitcnt lgkmcnt(0)"
                             : "=&v"(tA[0]), "=&v"(tA[1]), "=&v"(tA[2]), "=&v"(tA[3]), "=&v"(tV[0]), "=&v"(tV[1]), "=&v"(tV[2]), "=&v"(tV[3]) : "v"(aAH), "v"(aVV) : "memory");
#pragma unroll
                for (int jt = 0; jt < 4; ++jt) {
                    const f32x4 d = mm16(pT, tA[jt], zero4);
                    *(LAS s16x4v*)(slot + SL_AB + ((16 * jt + n) * 24 + 4 * g) * 2) = pk4(d); }
#pragma unroll
                for (int it = 0; it < 4; ++it) {
                    const f32x4 d = mm16(pX, tV[it], zero4);
                    *(LAS s16x4v*)(slot + SL_WT + (it * 64 + lane) * 8) = pk4(d); }
                asm volatile("" ::: "memory");
                gate4[0] = zero4; gate4[1] = zero4; gate4[2] = zero4; gate4[3] = zero4;
#pragma unroll
                for (int s2 = 0; s2 < 4; ++s2) { const bf16x8 xg = xg_[s2];
#pragma unroll
                    for (int ct = 0; ct < 4; ++ct) gate4[ct] = __builtin_amdgcn_mfma_f32_16x16x32_bf16(wG[s2][ct], xg, gate4[ct], 0, 0, 0); }
            }
            __syncthreads();
            if (iv + 1 < NIV) RW_LOADZ(iv + 1, lane, 0, 5);
            if (wid < 4) {
                const int it = wid;
                struct Ops { s16x4v ab[4], bb[4], kb[4], vf, rh[4], abr, akr; u32x2 wt; f32x4 gc[4]; };
                const unsigned oAB = (unsigned)(size_t)(lds + SL_AB + ((4 * g + (n >> 2)) * 24 + 4 * (n & 3)) * 2);
                const unsigned oBB = (unsigned)(size_t)((LAS bf16_t*)(lds + SL_BB) + (4 * g + (n >> 2)) * CS + 4 * (n & 3));
                const unsigned oKB = (unsigned)(size_t)((LAS bf16_t*)(lds + SL_KB) + (4 * g + (n >> 2)) * CS + 4 * (n & 3));
                const unsigned oVV = (unsigned)(size_t)((LAS bf16_t*)(lds + SL_VV) + (4 * g + (n >> 2)) * CS + 16 * it + 4 * (n & 3));
                const unsigned oRH = (unsigned)(size_t)((LAS bf16_t*)(lds + SL_RH) + n * CS + 4 * g), oABR = (unsigned)(size_t)(lds + SL_ABR + lane * 8);
                const unsigned oWT = (unsigned)(size_t)(lds + SL_WT + (it * 64 + lane) * 8), oGC = (unsigned)(size_t)(lds + SL_GC + 16 * g);
#define CH_ISSUE(P, sl_) do { const unsigned so_ = (unsigned)((sl_) * SL_SIZE); \
                    asm volatile("ds_read_b64_tr_b16 %0, %13\n\tds_read_b64_tr_b16 %1, %13 offset:768\n\tds_read_b64_tr_b16 %2, %13 offset:1536\n\tds_read_b64_tr_b16 %3, %13 offset:2304\n\t" \
                                 "ds_read_b64_tr_b16 %4, %14\n\tds_read_b64_tr_b16 %5, %14 offset:32\n\tds_read_b64_tr_b16 %6, %14 offset:64\n\tds_read_b64_tr_b16 %7, %14 offset:96\n\t" \
                                 "ds_read_b64_tr_b16 %8, %15\n\tds_read_b64_tr_b16 %9, %15 offset:32\n\tds_read_b64_tr_b16 %10, %15 offset:64\n\tds_read_b64_tr_b16 %11, %15 offset:96\n\t" \
                                 "ds_read_b64_tr_b16 %12, %16" \
                                 : "=&v"(P.ab[0]), "=&v"(P.ab[1]), "=&v"(P.ab[2]), "=&v"(P.ab[3]), "=&v"(P.bb[0]), "=&v"(P.bb[1]), "=&v"(P.bb[2]), "=&v"(P.bb[3]), \
                                   "=&v"(P.kb[0]), "=&v"(P.kb[1]), "=&v"(P.kb[2]), "=&v"(P.kb[3]), "=&v"(P.vf) \
                                 : "v"(oAB + so_), "v"(oBB + so_), "v"(oKB + so_), "v"(oVV + so_) : "memory"); \
                      \
                    asm volatile("ds_read_b64 %0, %11\n\tds_read_b64 %1, %11 offset:32\n\tds_read_b64 %2, %11 offset:64\n\tds_read_b64 %3, %11 offset:96\n\t" \
                                 "ds_read_b64 %4, %12\n\tds_read_b64 %5, %12 offset:512\n\tds_read_b64 %6, %13\n\t" \
                                 "ds_read_b128 %7, %14\n\tds_read_b128 %8, %14 offset:64\n\tds_read_b128 %9, %14 offset:128\n\tds_read_b128 %10, %14 offset:192" \
                                 : "=&v"(P.rh[0]), "=&v"(P.rh[1]), "=&v"(P.rh[2]), "=&v"(P.rh[3]), "=&v"(P.abr), "=&v"(P.akr), "=&v"(P.wt), "=&v"(P.gc[0]), "=&v"(P.gc[1]), "=&v"(P.gc[2]), "=&v"(P.gc[3]) \
                                 : "v"(oRH + so_), "v"(oABR + so_), "v"(oWT + so_), "v"(oGC + so_) : "memory"); } while (0)
#define CH_WAIT(P) asm volatile("s_waitcnt lgkmcnt(0)" : "+v"(P.ab[0]), "+v"(P.ab[1]), "+v"(P.ab[2]), "+v"(P.ab[3]), "+v"(P.bb[0]), "+v"(P.bb[1]), "+v"(P.bb[2]), "+v"(P.bb[3]), \
                                   "+v"(P.kb[0]), "+v"(P.kb[1]), "+v"(P.kb[2]), "+v"(P.kb[3]), "+v"(P.vf), "+v"(P.rh[0]), "+v"(P.rh[1]), "+v"(P.rh[2]), "+v"(P.rh[3]), "+v"(P.abr), "+v"(P.akr), "+v"(P.wt), \
                                   "+v"(P.gc[0]), "+v"(P.gc[1]), "+v"(P.gc[2]), "+v"(P.gc[3]) :: "memory")
#define CH_COMPUTE(P, sl_) do { \
                    const s16x4v sf0 = pk4(ST[0]), sf1 = pk4(ST[1]), sf2 = pk4(ST[2]), sf3 = pk4(ST[3]); \
                    f32x4 U = (f32x4){bf_lo(P.wt.x), bf_hi(P.wt.x), bf_lo(P.wt.y), bf_hi(P.wt.y)}; \
                    const bf16x8 sf01 = cat8(sf0, sf1), sf23 = cat8(sf2, sf3); \
                    U = mm32(cat8(P.ab[0], P.ab[1]), sf01, U); U = mm32(cat8(P.ab[2], P.ab[3]), sf23, U); \
                    const bf16x8 ufvf = cat8(pk4(U), P.vf); \
                    ST[0] = mm32(cat8(P.bb[0], P.kb[0]), ufvf, ST[0] * P.gc[0]); ST[1] = mm32(cat8(P.bb[1], P.kb[1]), ufvf, ST[1] * P.gc[1]); \
                    ST[2] = mm32(cat8(P.bb[2], P.kb[2]), ufvf, ST[2] * P.gc[2]); ST[3] = mm32(cat8(P.bb[3], P.kb[3]), ufvf, ST[3] * P.gc[3]); \
                    f32x4 Y = mm32(cat8(P.rh[0], P.rh[1]), sf01, zero4); Y = mm32(cat8(P.rh[2], P.rh[3]), sf23, Y); Y = mm32(cat8(P.abr, P.akr), ufvf, Y); \
                    LAS bf16_t* yo = (LAS bf16_t*)(lds + (sl_) * SL_SIZE + SL_Y) + 16 * it + n; const unsigned y01 = pkv(Y[0], Y[1]), y23 = pkv(Y[2], Y[3]); \
                    yo[(4 * g + 0) * CS] = (bf16_t)(y01 & 0xffff); yo[(4 * g + 1) * CS] = (bf16_t)(y01 >> 16); yo[(4 * g + 2) * CS] = (bf16_t)(y23 & 0xffff); yo[(4 * g + 3) * CS] = (bf16_t)(y23 >> 16); } while (0)
                Ops A_, B_;
                CH_ISSUE(A_, 0);
#pragma unroll 1
                for (int sl = 0; sl < 8; sl += 2) {
                    CH_WAIT(A_); CH_ISSUE(B_, sl + 1); CH_COMPUTE(A_, sl);
                    CH_WAIT(B_); if (sl + 2 < 8) CH_ISSUE(A_, sl + 2); CH_COMPUTE(B_, sl + 1);
                }
#undef CH_ISSUE
#undef CH_WAIT
#undef CH_COMPUTE
            }
            __syncthreads();
            {
                const LAS bf16_t* yi = (const LAS bf16_t*)(slot + SL_Y) + n * CS + 4 * g;
                f32x4 y[4]; float sm = 0.f;
#pragma unroll
                for (int ct = 0; ct < 4; ++ct) { y[ct] = up4(*(const LAS u32x2*)(yi + 16 * ct)); sm += (y[ct][0] + y[ct][1]) + (y[ct][2] + y[ct][3]); }
                sm = rsum4(sm);
                const float mean = sm * (1.0f / 64.0f); float q = 0.f;
#pragma unroll
                for (int ct = 0; ct < 4; ++ct) { const f32x4 d = y[ct] - mean; q += (d[0] * d[0] + d[1] * d[1]) + (d[2] * d[2] + d[3] * d[3]); }
                q = rsum4(q);
                const float rstd = rsqrtf(q * (1.0f / 64.0f) + GN_EPS);
                bf16_t* ym = (bf16_t*)(p.ws + WS_YMIX) + ((size_t)(b * 16 + 8 + h) * SEQ + t) * 64;
#pragma unroll
                for (int ct = 0; ct < 4; ++ct) { const int cl = 16 * ct + 4 * g;
                    const f32x4 lw = *(const LAS f32x4*)(CS_ + C_LW + cl), lb = *(const LAS f32x4*)(CS_ + C_LB + cl);
                    const f32x4 o = ((y[ct] - mean) * rstd * lw + lb + bonus * v4[ct]) * gate4[ct];
                    u32x2 w; w.x = cvt_pk_bf16(o[0], o[1]); w.y = cvt_pk_bf16(o[2], o[3]);
                    *(u32x2*)(ym + cl) = w; }
            }
        }
#undef RW_LOADZ
#undef RW_PARK
        __syncthreads();
    }
}

constexpr int KSTR = 72;
constexpr int VSTR = 80;
constexpr int A_K = 0;
constexpr int A_VT = 3 * 128 * KSTR * 2;
constexpr int A_END = A_VT + 3 * 128 * VSTR * 2;
constexpr int A_STG = A_END, A_STGW = 4608;
static_assert(A_STG + 8 * A_STGW <= 159 * 1024, "attn lds");

__device__ __forceinline__ void phase_attn(const Params& p, LAS unsigned char* lds) {
    const int tid = threadIdx.x, w = __builtin_amdgcn_readfirstlane(tid >> 6), lane = tid & 63, ql = lane & 15, g = lane >> 4;
    const bf16_t* z = (const bf16_t*)(p.ws + WS_Z);
    LAS bf16_t* Ks = (LAS bf16_t*)(lds + A_K); LAS bf16_t* VT = (LAS bf16_t*)(lds + A_VT);
    constexpr float SC = 0.125f * 1.4426950408889634f;
    for (int i = tid; i < A_END / 16; i += 512) *(LAS u32x4*)(lds + A_K + i * 16) = (u32x4){0u, 0u, 0u, 0u};
    const int srow = tid >> 3, sc8 = tid & 7;
    for (int slot_ = blockIdx.x; slot_ < 256; slot_ += gridDim.x) {
        const int b = 4 * (slot_ & 7) + (slot_ >> 6), h = (slot_ >> 3) & 7, bh = b * 8 + h;
        const bf16_t* zq = z + zoff(b, h, 0); const bf16_t* zk = z + zoff(b, 8 + h, 0); const bf16_t* zv = z + zoff(b, 16 + h, 0);
        float* stA_O = (float*)(p.ws + WS_STA + (size_t)bh * ST_BYTES_PER_BH); float* stA_ML = stA_O + SEQ * 64;
        float* stB_O = (float*)(p.ws + WS_STB + (size_t)bh * ST_BYTES_PER_BH); float* stB_ML = stB_O + SEQ * 64;
        u32x4 kq[2], vq[2];
#define ATT_DECODE(u_, pat_, d_, r_, n_) const int pat_ = 2 - (u_) / 16, d_ = pat_ == 0 ? 1 : (pat_ == 1 ? 4 : 16), nb_##u_ = 16 / d_, r_ = ((u_) % 16) / nb_##u_, n_ = ((u_) % 16) % nb_##u_
#define ATT_LOAD(d_, r_, n_) do { _Pragma("unroll") for (int it = 0; it < 2; ++it) { const int zr = ((128 * (n_) + srow + 64 * it) * (d_) + (r_)) * 64 + sc8 * 8; \
            kq[it] = *(const u32x4*)(zk + zr); vq[it] = *(const u32x4*)(zv + zr); } } while (0)
#define ATT_STORE(slot_) ATT_STORE_ROW((slot_) * 128)
#define ATT_STORE_ROW(rb_) do { _Pragma("unroll") for (int it = 0; it < 2; ++it) { const int row = (rb_) + srow + 64 * it; \
            *(LAS u32x4*)(Ks + row * KSTR + sc8 * 8) = kq[it]; *(LAS u32x4*)(VT + row * VSTR + sc8 * 8) = vq[it]; } } while (0)
        LAS unsigned char* stg = lds + A_STG + w * A_STGW;
#define STG_Q(i_) ((LAS u32x4*)(stg + (i_) * 1024 + lane * 16))
#define STG_ML ((LAS f32x2*)(stg + 2048 + lane * 8))
#define STG_ST(i_) ((LAS u32x4*)(stg + 2560 + (i_) * 1024 + lane * 16))
        __syncthreads();
        { ATT_LOAD(16, 0, 0); ATT_STORE(0);
          const bf16_t* zq0 = zq + ((16 * w + ql) * 16) * 64;
          *STG_Q(0) = *(const u32x4*)(zq0 + 8 * g); *STG_Q(1) = *(const u32x4*)(zq0 + 32 + 8 * g); }
        __syncthreads();
        int cb = 0, pb = 256, nbk = 128;
        for (int u = 0; u < 48; ++u) {
            ATT_DECODE(u, pat, d, r, n);
            const int tq = (128 * n + 16 * w + ql) * d + r;
            float* outO = pat == 2 ? stA_O : stB_O; float* outML = pat == 2 ? stA_ML : stB_ML;
            const bf16x8 qf0 = __builtin_bit_cast(bf16x8, *STG_Q(0)), qf1 = __builtin_bit_cast(bf16x8, *STG_Q(1));
            float m_prev = -INFINITY, l_prev = 0.f;
            f32x4 accO[4];
#pragma unroll
            for (int dt = 0; dt < 4; ++dt) accO[dt] = (f32x4){0.f, 0.f, 0.f, 0.f};
            const bool oddq = (ql & 1) != 0;
            const int tqA = (128 * n + 16 * w + (ql & ~1)) * d + r;
            u32x4 la = (u32x4){0u, 0u, 0u, 0u}, lb = la;
            if (pat != 2) { const f32x2 ml = *STG_ML; m_prev = ml.x; l_prev = ml.y; la = *STG_ST(0); lb = *STG_ST(1); }
            asm volatile("s_waitcnt lgkmcnt(0)" ::: "memory");
            u32x4 nq0 = (u32x4){0u, 0u, 0u, 0u}, nq1 = nq0, nla = nq0, nlb = nq0; f32x2 nml = (f32x2){0.f, 0.f};
            bool nstate = false;
            if (u + 1 < 48) { const int u1 = u + 1; ATT_DECODE(u1, pat1, d1, r1, n1); ATT_LOAD(d1, r1, n1);
                const int tq1 = (128 * n1 + 16 * w + ql) * d1 + r1;
                const bf16_t* zq1 = zq + tq1 * 64;
                nq0 = *(const u32x4*)(zq1 + 8 * g); nq1 = *(const u32x4*)(zq1 + 32 + 8 * g);
                if (pat1 != 2) { nstate = true; const float* inML = pat1 == 1 ? stA_ML : stB_ML; nml = *(const f32x2*)(inML + tq1 * 2);
                    const unsigned char* inO1 = (const unsigned char*)(pat1 == 1 ? stA_O : stB_O) + (oddq ? 64 : 0) + 16 * g; const int tq1A = (128 * n1 + 16 * w + (ql & ~1)) * d1 + r1;
                    nla = *(const u32x4*)(inO1 + (size_t)tq1A * 128); nlb = *(const u32x4*)(inO1 + (size_t)(tq1A + d1) * 128); } }
            int rbx[9];
#pragma unroll
            for (int x = 0; x < 9; ++x) rbx[x] = (x <= 7 - w) ? pb + 16 * (w + x) : cb + 16 * (x - (8 - w));
            u32x2 vt[9][4];
#define ATT_VISSUE(x0_) do { const unsigned a0_ = (unsigned)(size_t)(VT + (rbx[x0_] + 4 * g + (ql >> 2)) * VSTR + 4 * (ql & 3)), a1_ = (unsigned)(size_t)(VT + (rbx[x0_ + 1] + 4 * g + (ql >> 2)) * VSTR + 4 * (ql & 3)), \
                                                   a2_ = (unsigned)(size_t)(VT + (rbx[x0_ + 2] + 4 * g + (ql >> 2)) * VSTR + 4 * (ql & 3)); \
                asm volatile("ds_read_b64_tr_b16 %0, %12\n\tds_read_b64_tr_b16 %1, %12 offset:32\n\tds_read_b64_tr_b16 %2, %12 offset:64\n\tds_read_b64_tr_b16 %3, %12 offset:96\n\t" \
                             "ds_read_b64_tr_b16 %4, %13\n\tds_read_b64_tr_b16 %5, %13 offset:32\n\tds_read_b64_tr_b16 %6, %13 offset:64\n\tds_read_b64_tr_b16 %7, %13 offset:96\n\t" \
                             "ds_read_b64_tr_b16 %8, %14\n\tds_read_b64_tr_b16 %9, %14 offset:32\n\tds_read_b64_tr_b16 %10, %14 offset:64\n\tds_read_b64_tr_b16 %11, %14 offset:96" \
                             : "=&v"(vt[x0_][0]), "=&v"(vt[x0_][1]), "=&v"(vt[x0_][2]), "=&v"(vt[x0_][3]), "=&v"(vt[x0_ + 1][0]), "=&v"(vt[x0_ + 1][1]), "=&v"(vt[x0_ + 1][2]), "=&v"(vt[x0_ + 1][3]), \
                               "=&v"(vt[x0_ + 2][0]), "=&v"(vt[x0_ + 2][1]), "=&v"(vt[x0_ + 2][2]), "=&v"(vt[x0_ + 2][3]) : "v"(a0_), "v"(a1_), "v"(a2_) : "memory"); } while (0)
            ATT_VISSUE(0); ATT_VISSUE(3); ATT_VISSUE(6);
#undef ATT_VISSUE
            bf16x8 kf0[9], kf1[9];
#pragma unroll
            for (int x = 0; x < 9; ++x) { const LAS bf16_t* kp = Ks + (rbx[x] + ql) * KSTR + 8 * g; kf0[x] = *(const LAS bf16x8*)kp; kf1[x] = *(const LAS bf16x8*)(kp + 32); }
            f32x4 sc[9];
#pragma unroll
            for (int x = 0; x < 9; ++x) {
                const bool prev = (x <= 7 - w);
                f32x4 a = (f32x4){0.f, 0.f, 0.f, 0.f};
                a = __builtin_amdgcn_mfma_f32_16x16x32_bf16(kf0[x], qf0, a, 0, 0, 0);
                a = __builtin_amdgcn_mfma_f32_16x16x32_bf16(kf1[x], qf1, a, 0, 0, 0);
#pragma unroll
                for (int i = 0; i < 4; ++i) { const int kl = 4 * g + i; bool ok = true;
                    if (prev) ok = (n > 0) && (x > 0 || kl >= ql); else ok = (x < 8) || (kl <= ql);
                    a[i] = ok ? a[i] : -INFINITY; }
                sc[x] = a;
            }
            float mx = -INFINITY;
#pragma unroll
            for (int x = 0; x < 9; ++x) mx = fmaxf(mx, fmaxf(fmaxf(sc[x][0], sc[x][1]), fmaxf(sc[x][2], sc[x][3])));
            mx = rmax4(mx);
            const float m_new = fmaxf(m_prev, mx * SC);
            float ls = 0.f;
#pragma unroll
            for (int x = 0; x < 9; ++x)
#pragma unroll
                for (int i = 0; i < 4; ++i) { const float e = __builtin_amdgcn_exp2f(__builtin_fmaf(sc[x][i], SC, -m_new)); sc[x][i] = e; ls += e; }
            ls = rsum4(ls);
            const float alpha = __builtin_amdgcn_exp2f(m_prev - m_new);
            const float l_new = l_prev * alpha + ls;
            {   const u32x4 rcv = xchg1(oddq ? la : lb); const u32x4 w0 = oddq ? rcv : la, w1 = oddq ? lb : rcv;
                accO[0] = (f32x4){bf_lo(w0.x), bf_hi(w0.x), bf_lo(w0.y), bf_hi(w0.y)} * alpha; accO[1] = (f32x4){bf_lo(w0.z), bf_hi(w0.z), bf_lo(w0.w), bf_hi(w0.w)} * alpha;
                accO[2] = (f32x4){bf_lo(w1.x), bf_hi(w1.x), bf_lo(w1.y), bf_hi(w1.y)} * alpha; accO[3] = (f32x4){bf_lo(w1.z), bf_hi(w1.z), bf_lo(w1.w), bf_hi(w1.w)} * alpha; }
            asm volatile("s_waitcnt lgkmcnt(0)" : "+v"(vt[0][0]), "+v"(vt[0][1]), "+v"(vt[0][2]), "+v"(vt[0][3]), "+v"(vt[1][0]), "+v"(vt[1][1]), "+v"(vt[1][2]), "+v"(vt[1][3]), "+v"(vt[2][0]), "+v"(vt[2][1]), "+v"(vt[2][2]), "+v"(vt[2][3]),
                                                   "+v"(vt[3][0]), "+v"(vt[3][1]), "+v"(vt[3][2]), "+v"(vt[3][3]), "+v"(vt[4][0]), "+v"(vt[4][1]), "+v"(vt[4][2]), "+v"(vt[4][3]) :: "memory");
            asm volatile("" : "+v"(vt[5][0]), "+v"(vt[5][1]), "+v"(vt[5][2]), "+v"(vt[5][3]), "+v"(vt[6][0]), "+v"(vt[6][1]), "+v"(vt[6][2]), "+v"(vt[6][3]), "+v"(vt[7][0]), "+v"(vt[7][1]), "+v"(vt[7][2]), "+v"(vt[7][3]),
                             "+v"(vt[8][0]), "+v"(vt[8][1]), "+v"(vt[8][2]), "+v"(vt[8][3]) :: "memory");
#pragma unroll
            for (int s2 = 0; s2 < 5; ++s2) {
                const int x0 = 2 * s2, x1 = 2 * s2 + 1;
                u32x4 pw; pw.x = cvt_pk_bf16(sc[x0][0], sc[x0][1]); pw.y = cvt_pk_bf16(sc[x0][2], sc[x0][3]);
                if (x1 < 9) { pw.z = cvt_pk_bf16(sc[x1 < 9 ? x1 : 8][0], sc[x1 < 9 ? x1 : 8][1]); pw.w = cvt_pk_bf16(sc[x1 < 9 ? x1 : 8][2], sc[x1 < 9 ? x1 : 8][3]); } else { pw.z = 0u; pw.w = 0u; }
                const bf16x8 pf = __builtin_bit_cast(bf16x8, pw);
#pragma unroll
                for (int dt = 0; dt < 4; ++dt) {
                    const u32x2 lo = vt[x0][dt], hi = x1 < 9 ? vt[x1 < 9 ? x1 : 8][dt] : (u32x2){0u, 0u};
                    const u32x4 vw = (u32x4){lo.x, lo.y, hi.x, hi.y};
                    accO[dt] = __builtin_amdgcn_mfma_f32_16x16x32_bf16(__builtin_bit_cast(bf16x8, vw), pf, accO[dt], 0, 0, 0);
                }
            }
            if (pat != 0) {
                u32x4 w0, w1;
                w0.x = cvt_pk_bf16(accO[0][0], accO[0][1]); w0.y = cvt_pk_bf16(accO[0][2], accO[0][3]); w0.z = cvt_pk_bf16(accO[1][0], accO[1][1]); w0.w = cvt_pk_bf16(accO[1][2], accO[1][3]);
                w1.x = cvt_pk_bf16(accO[2][0], accO[2][1]); w1.y = cvt_pk_bf16(accO[2][2], accO[2][3]); w1.z = cvt_pk_bf16(accO[3][0], accO[3][1]); w1.w = cvt_pk_bf16(accO[3][2], accO[3][3]);
                const u32x4 rcv = xchg1(oddq ? w0 : w1);
                unsigned char* oO = (unsigned char*)outO + (oddq ? 64 : 0) + 16 * g;
                *(u32x4*)(oO + (size_t)tqA * 128) = oddq ? rcv : w0; *(u32x4*)(oO + (size_t)(tqA + d) * 128) = oddq ? w1 : rcv;
                if (g == 0) *(f32x2*)(outML + tq * 2) = (f32x2){m_new, l_new};
            } else {
                const float il = frcp(l_new); float ss = 0.f;
#pragma unroll
                for (int dt = 0; dt < 4; ++dt) { accO[dt] = accO[dt] * il; ss += (accO[dt][0] * accO[dt][0] + accO[dt][1] * accO[dt][1]) + (accO[dt][2] * accO[dt][2] + accO[dt][3] * accO[dt][3]); }
                ss = rsum4(ss);
                const float rs = rsqrtf(ss * (1.0f / 64.0f) + NORM_EPS);
                bf16_t* ym = (bf16_t*)(p.ws + WS_YMIX) + ((size_t)(b * 16 + h) * SEQ + tq) * 64;
#pragma unroll
                for (int dt = 0; dt < 4; ++dt) { const f32x4 gn = *(const f32x4*)(p.attn_out_gain + 64 * h + 16 * dt + 4 * g); const f32x4 o = accO[dt] * rs * gn;
                    u32x2 wv; wv.x = cvt_pk_bf16(o[0], o[1]); wv.y = cvt_pk_bf16(o[2], o[3]); *(u32x2*)(ym + 16 * dt + 4 * g) = wv; }
            }
            if (u + 1 < 48) { ATT_STORE_ROW(nbk); *STG_Q(0) = nq0; *STG_Q(1) = nq1;
                if (nstate) { *STG_ML = nml; *STG_ST(0) = nla; *STG_ST(1) = nlb; } }
            { const int t_ = pb; pb = cb; cb = nbk; nbk = t_; }
            __syncthreads();
        }
#undef ATT_DECODE
#undef ATT_LOAD
#undef ATT_STORE
#undef ATT_STORE_ROW
#undef STG_Q
#undef STG_ML
#undef STG_ST
        asm volatile("s_waitcnt vmcnt(0)" ::: "memory");
    }
}

constexpr int P4_WH = 0;
constexpr int P4_WL = 65536;
constexpr int P4_GN = 131072;
constexpr int P4_LG = P4_GN + 4096;
constexpr int P4_RS = P4_LG + 16384;
constexpr int P4_CNT = P4_RS + 512;
constexpr int P4_ASG = P4_CNT + 256;
constexpr int P4_GT = P4_ASG + 4096;
constexpr int P4_END = P4_GT + 4096;
static_assert(P4_END <= 158 * 1024, "router lds");

__device__ __forceinline__ void phase_router(const Params& p, LAS unsigned char* lds) {
    const int tid = threadIdx.x, wid = __builtin_amdgcn_readfirstlane(tid >> 6), lane = tid & 63, n = lane & 15, g = lane >> 4;
    LAS float* GN = (LAS float*)(lds + P4_GN); LAS float* LG = (LAS float*)(lds + P4_LG) + wid * 512; LAS float* RSD = (LAS float*)(lds + P4_RS) + wid * 16;
    LAS unsigned* cnt = (LAS unsigned*)(lds + P4_CNT); LAS unsigned* bas = cnt + 32; LAS unsigned* asg = (LAS unsigned*)(lds + P4_ASG);
    unsigned* ctl = (unsigned*)(p.ws + WS_CTL);
    int* list = (int*)(p.ws + WS_LIST); float* glist = (float*)(p.ws + WS_GLIST);
    LAS float* gtl = (LAS float*)(lds + P4_GT);
    unsigned char* h2 = p.ws + WS_H;
    const bf16_t* x1 = (const bf16_t*)(p.ws + WS_X1);
    for (int i = tid; i < 1024; i += 512) GN[i] = p.norm2_gain[i];
    for (int i0 = tid; i0 < 32 * 1024; i0 += 8 * 512) {
        float wv[8], gv[8];
#pragma unroll
        for (int j = 0; j < 8; ++j) { const int i = i0 + 512 * j; wv[j] = p.router_w[i]; gv[j] = p.norm2_gain[i >> 5]; }
#pragma unroll
        for (int j = 0; j < 8; ++j) { const int i = i0 + 512 * j, k = i >> 5, e = i & 31; const float w = wv[j] * gv[j];
            const unsigned hb = cvt_pk_bf16(w, 0.f) & 0xffffu; const float hf = __uint_as_float(hb << 16); const unsigned lb = cvt_pk_bf16(w - hf, 0.f) & 0xffffu;
            const int off = e * 2048 + ((((k >> 3) ^ (e & 15)) << 4) | ((k & 7) << 1));
            *(LAS bf16_t*)(lds + P4_WH + off) = (bf16_t)hb; *(LAS bf16_t*)(lds + P4_WL + off) = (bf16_t)lb; } }
    const float rb0 = p.router_b[lane & 31];
    for (int panel = blockIdx.x; panel < NTOK / 256; panel += gridDim.x) {
        if (tid < 32) cnt[tid] = 0u;
        __syncthreads();
        for (int tile = 0; tile < 2; ++tile) {
            const int tl0 = wid * 32 + tile * 16, tok0 = panel * 256 + tl0;
            bf16x8 raw[32];
            const bf16_t* xp = x1 + (size_t)(tok0 + n) * DM + 8 * g;
#pragma unroll
            for (int s2 = 0; s2 < 32; ++s2) raw[s2] = *(const bf16x8*)(xp + 32 * s2);
            f32x4 aq = (f32x4){0.f, 0.f, 0.f, 0.f};
#pragma unroll
            for (int s2 = 0; s2 < 32; ++s2) aq = __builtin_amdgcn_mfma_f32_16x16x32_bf16(raw[s2], raw[s2], aq, 0, 0, 0);
            { const int i = n & 3; const float d = i == 0 ? aq[0] : (i == 1 ? aq[1] : (i == 2 ? aq[2] : aq[3]));
              if (g == (n >> 2)) RSD[n] = rsqrtf(d * (1.0f / DM) + NORM_EPS); }
            asm volatile("s_waitcnt lgkmcnt(0)" ::: "memory");
            const float rs = RSD[n];
            f32x4 al[2] = {{0.f, 0.f, 0.f, 0.f}, {0.f, 0.f, 0.f, 0.f}};
            unsigned char* hp = h2 + (size_t)(tok0 + n) * DM + 8 * g;
#pragma unroll
            for (int s2 = 0; s2 < 32; ++s2) {
#pragma unroll
                for (int et = 0; et < 2; ++et) { const int e = 16 * et + n; const int off = e * 2048 + (((4 * s2 + g) ^ (e & 15)) << 4);
                    const bf16x8 wh = *(const LAS bf16x8*)(lds + P4_WH + off), wl = *(const LAS bf16x8*)(lds + P4_WL + off);
                    al[et] = __builtin_amdgcn_mfma_f32_16x16x32_bf16(raw[s2], wh, al[et], 0, 0, 0);
                    al[et] = __builtin_amdgcn_mfma_f32_16x16x32_bf16(raw[s2], wl, al[et], 0, 0, 0); }
                const f32x4 g0 = *(const LAS f32x4*)(GN + 32 * s2 + 8 * g), g1 = *(const LAS f32x4*)(GN + 32 * s2 + 8 * g + 4);
                const u32x4 rw = __builtin_bit_cast(u32x4, raw[s2]);
                const f32x4 v0 = (f32x4){bf_lo(rw.x), bf_hi(rw.x), bf_lo(rw.y), bf_hi(rw.y)} * g0 * rs, v1 = (f32x4){bf_lo(rw.z), bf_hi(rw.z), bf_lo(rw.w), bf_hi(rw.w)} * g1 * rs;
                *(u32x2*)(hp + 32 * s2) = (u32x2){pk4_fp8(v0[0], v0[1], v0[2], v0[3]), pk4_fp8(v1[0], v1[1], v1[2], v1[3])};
            }
            const float rbv0 = __shfl(rb0, n), rbv1 = __shfl(rb0, 16 + n);
#pragma unroll
            for (int i = 0; i < 4; ++i) { const float rsi = RSD[4 * g + i]; LG[(4 * g + i) * 32 + n] = al[0][i] * rsi + rbv0; LG[(4 * g + i) * 32 + 16 + n] = al[1][i] * rsi + rbv1; }
            asm volatile("s_waitcnt lgkmcnt(0)" ::: "memory");
            if (lane < 16) {
                float lv[32];
#pragma unroll
                for (int q = 0; q < 8; ++q) { const f32x4 t4 = *(const LAS f32x4*)(LG + lane * 32 + 4 * q); lv[4 * q] = t4[0]; lv[4 * q + 1] = t4[1]; lv[4 * q + 2] = t4[2]; lv[4 * q + 3] = t4[3]; }
                float tv[4]; int te[4];
#pragma unroll
                for (int k = 0; k < 4; ++k) { float bv = -INFINITY; int be = 0;
#pragma unroll
                    for (int e = 0; e < 32; ++e) { const bool taken = (k > 0 && te[0] == e) || (k > 1 && te[1] == e) || (k > 2 && te[2] == e); if (!taken && lv[e] > bv) { bv = lv[e]; be = e; } }
                    tv[k] = bv; te[k] = be; }
                const float e1 = fexp(tv[1] - tv[0]), e2 = fexp(tv[2] - tv[0]), e3 = fexp(tv[3] - tv[0]);
                const float isum = 1.0f / (1.0f + e1 + e2 + e3);
                const float gk[4] = {isum, e1 * isum, e2 * isum, e3 * isum};
                const int tl = tl0 + lane, tok = tok0 + lane;
#pragma unroll
                for (int k = 0; k < 4; ++k) { const unsigned pos = __hip_atomic_fetch_add(&cnt[te[k]], 1u, __ATOMIC_RELAXED, __HIP_MEMORY_SCOPE_WORKGROUP);
                    asg[tl * 4 + k] = ((unsigned)te[k] << 16) | pos; gtl[tl * 4 + k] = gk[k]; }
            }
            asm volatile("s_waitcnt lgkmcnt(0)" ::: "memory");
        }
        __syncthreads();
        if (tid < 32) bas[tid] = __hip_atomic_fetch_add(ctl + CW_CNT + 64 * tid, cnt[tid], __ATOMIC_RELAXED, __HIP_MEMORY_SCOPE_AGENT);
        __syncthreads();
        for (int i = tid; i < 1024; i += 512) { const unsigned a = asg[i]; const int e = a >> 16, pos = a & 0xffff; const size_t li = (size_t)e * NTOK + bas[e] + pos;
            list[li] = (panel * 256 + (i >> 2)) * 4 + (i & 3); glist[li] = gtl[i]; }
        __syncthreads();
    }
}

struct TileTab { int tb[33]; int cn[32]; };
__device__ __forceinline__ void build_tiletab(const Params& p, LAS TileTab* T) {
    if (threadIdx.x < 32) {
        const unsigned* ctl = (const unsigned*)(p.ws + WS_CTL);
        const int e = threadIdx.x, c = (int)__hip_atomic_load(ctl + CW_CNT + 64 * e, __ATOMIC_RELAXED, __HIP_MEMORY_SCOPE_AGENT), nt = (c + 255) >> 8;
        int incl = nt;
#pragma unroll
        for (int o = 1; o < 32; o <<= 1) { const int v = __shfl_up(incl, o); if (e >= o) incl += v; }
        T->cn[e] = c; T->tb[e] = incl - nt; if (e == 31) T->tb[32] = incl;
    }
    __syncthreads();
}
template <int NCT>
struct GroupProb {
    const char* Abase; const char* Bt; const int* list; const LAS TileTab* T; int ntiles, xcd, rank; bool gather;
    static constexpr int RPX = 32 / NCT;
    static constexpr size_t A_KSTEP = 128;
    __device__ __forceinline__ void init(const void* A, const void* B, const int* list_, const LAS TileTab* T_, bool gather_) {
        Abase = (const char*)A; Bt = (const char*)B; list = list_; T = T_; gather = gather_; ntiles = T_->tb[32];
        const int c = blockIdx.x; xcd = c & 7; rank = c >> 3; }
    __device__ __forceinline__ bool next(int i, g8::Unit& u) const {
        if (rank >= 32) return false;
        const int rt = (i * 8 + xcd) * RPX + rank / NCT; if (rt >= ntiles) return false;
        int e = 0;
#pragma unroll
        for (int s = 16; s >= 1; s >>= 1) if (T->tb[e + s] <= rt) e += s;
        u.pm = rt; u.pn = rank % NCT; u.e = e; u.cnt = T->cn[e] - (rt - T->tb[e]) * 256; return true;
    }
    __device__ __forceinline__ int rot(const g8::Unit& u) const { return NCT == 8 ? u.pn + 2 * (u.pm & 3) : 2 * u.pn + u.pm; }
    __device__ __forceinline__ unsigned a_off(const g8::Unit& u, int row) const {
        if (gather) { const int rc = row < u.cnt ? row : u.cnt - 1; const int tokn = list[(size_t)u.e * NTOK + (u.pm - T->tb[u.e]) * 256 + rc] >> 2; return (unsigned)tokn * 1024u; }
        return (unsigned)(u.pm * 256 + row) * 1024u;
    }
    template <bool CM> __device__ __forceinline__ const char* b_ptr(const g8::Unit& u, int half) const {
        if (NCT == 8) return Bt + ((size_t)u.e * 2048 + (size_t)half * 1024 + u.pn * 128) * 1024;
        return Bt + ((size_t)u.e * 1024 + u.pn * 256 + half * (CM ? 32 : 128)) * 1024;
    }
};
struct EpiHid {
    static constexpr bool PERM = true, COLMAP = false;
    unsigned char* H; const float* b1;
    __device__ __forceinline__ void prefetch(const g8::Unit& u, LAS unsigned char* my, int wid, int lane) const {
        const float* src = b1 + (size_t)u.e * 2048 + (lane >> 5) * 1024 + u.pn * 128 + (wid & 3) * 32 + (lane & 31);
        __builtin_amdgcn_global_load_lds((const unsigned*)src, (LAS unsigned*)my, 4, 0, 0);
    }
    __device__ __forceinline__ void operator()(const f32x4 (&acc)[2][2][4][2], const g8::Unit& u, int wr, int wc, int fr, int fq, LAS unsigned char* my) const {
        const int row0 = u.pm * 256 + wr * 64 + fr, col0 = u.pn * 128 + wc * 32 + 8 * fq;
        const f32x4 bg0 = *(const LAS f32x4*)(my + 32 * fq), bg1 = *(const LAS f32x4*)(my + 32 * fq + 16), bl0 = *(const LAS f32x4*)(my + 128 + 32 * fq), bl1 = *(const LAS f32x4*)(my + 128 + 32 * fq + 16);
        const f32x2 bg[4] = {{bg0[0], bg0[1]}, {bg0[2], bg0[3]}, {bg1[0], bg1[1]}, {bg1[2], bg1[3]}};
        const f32x2 bl[4] = {{bl0[0] + 1.0f, bl0[1] + 1.0f}, {bl0[2] + 1.0f, bl0[3] + 1.0f}, {bl1[0] + 1.0f, bl1[1] + 1.0f}, {bl1[2] + 1.0f, bl1[3] + 1.0f}};
        const f32x2 sc = {1.0f / W8_SCALE, 1.0f / W8_SCALE}, ce = {-1.702f * 1.4426950408889634f, -1.702f * 1.4426950408889634f}, one = {1.0f, 1.0f};
#pragma unroll
        for (int ai = 0; ai < 2; ++ai)
#pragma unroll
            for (int m = 0; m < 4; ++m) {
                f32x2 o[4];
#pragma unroll
                for (int q = 0; q < 4; ++q) {
                    const f32x4 ga = acc[ai][0][m][q >> 1], la = acc[ai][1][m][q >> 1];
                    const f32x2 gr = (q & 1) ? (f32x2){ga[2], ga[3]} : (f32x2){ga[0], ga[1]}, lr = (q & 1) ? (f32x2){la[2], la[3]} : (f32x2){la[0], la[1]};
                    f32x2 gl = __builtin_elementwise_fma(gr, sc, bg[q]), li = __builtin_elementwise_fma(lr, sc, bl[q]);
                    gl.x = fminf(gl.x, 7.0f); gl.y = fminf(gl.y, 7.0f);
                    li.x = __builtin_amdgcn_fmed3f(li.x, -6.0f, 8.0f); li.y = __builtin_amdgcn_fmed3f(li.y, -6.0f, 8.0f);
                    const f32x2 ex = gl * ce;
                    f32x2 den = {__builtin_amdgcn_exp2f(ex.x), __builtin_amdgcn_exp2f(ex.y)}; den = den + one;
                    const f32x2 rc = {__builtin_amdgcn_rcpf(den.x), __builtin_amdgcn_rcpf(den.y)};
                    o[q] = (gl * rc) * li; }
                u32x2 w; w.x = pk4_fp8(o[0].x, o[0].y, o[1].x, o[1].y); w.y = pk4_fp8(o[2].x, o[2].y, o[3].x, o[3].y);
                *(u32x2*)(H + (size_t)(row0 + ai * 128 + m * 16) * FF + col0) = w; }
    }
};
struct EpiY2 {
    static constexpr bool PERM = true, COLMAP = true;
    unsigned char* Y; const float* b2; const int* list; const float* gate; const LAS TileTab* T;
    __device__ __forceinline__ void prefetch(const g8::Unit& u, LAS unsigned char* my, int wid, int lane) const {
        const size_t lb = (size_t)u.e * NTOK + (u.pm - T->tb[u.e]) * 256;
#pragma unroll
        for (int ai = 0; ai < 2; ++ai) { const int r = ai * 128 + (wid >> 2) * 64 + lane, rc = r < u.cnt ? r : u.cnt - 1;
            __builtin_amdgcn_global_load_lds((const unsigned*)(list + lb + rc), (LAS unsigned*)(my + ai * 256), 4, 0, 0);
            __builtin_amdgcn_global_load_lds((const unsigned*)(gate + lb + rc), (LAS unsigned*)(my + 512 + ai * 256), 4, 0, 0); }
        __builtin_amdgcn_global_load_lds((const unsigned*)(b2 + (size_t)u.e * DM + u.pn * 256 + (wid & 3) * 64 + lane), (LAS unsigned*)(my + 1024), 4, 0, 0);
    }
    __device__ __forceinline__ void operator()(const f32x4 (&acc)[2][2][4][2], const g8::Unit& u, int wr, int wc, int fr, int fq, LAS unsigned char* my) const {
        const bool oddq = (fq & 1) != 0;
        const int colS = u.pn * 256 + wc * 64 + (oddq ? 32 + 8 * (fq - 1) : 8 * fq);
        f32x4 bv[2][2];
#pragma unroll
        for (int bj = 0; bj < 2; ++bj) { bv[bj][0] = *(const LAS f32x4*)(my + 1024 + 128 * bj + 32 * fq); bv[bj][1] = *(const LAS f32x4*)(my + 1024 + 128 * bj + 32 * fq + 16); }
        int dsts[2][4]; float gts[2][4];
#pragma unroll
        for (int ai = 0; ai < 2; ++ai)
#pragma unroll
            for (int m = 0; m < 4; ++m) { dsts[ai][m] = *(const LAS int*)(my + ai * 256 + (m * 16 + fr) * 4); gts[ai][m] = *(const LAS float*)(my + 512 + ai * 256 + (m * 16 + fr) * 4); }
#pragma unroll
        for (int ai = 0; ai < 2; ++ai)
#pragma unroll
            for (int m = 0; m < 4; ++m) { const int r = ai * 128 + wr * 64 + m * 16 + fr; const float gt = gts[ai][m];
                u32x2 pc[2];
#pragma unroll
                for (int bj = 0; bj < 2; ++bj) { const f32x4 v0 = (acc[ai][bj][m][0] * (1.0f / W8_SCALE) + bv[bj][0]) * gt, v1 = (acc[ai][bj][m][1] * (1.0f / W8_SCALE) + bv[bj][1]) * gt;
                    pc[bj] = (u32x2){pk4_fp8(v0[0], v0[1], v0[2], v0[3]), pk4_fp8(v1[0], v1[1], v1[2], v1[3])}; }
                const u32x2 snd = oddq ? pc[0] : pc[1];
                const auto sx = __builtin_amdgcn_permlane16_swap(snd.x, snd.x, false, false), sy = __builtin_amdgcn_permlane16_swap(snd.y, snd.y, false, false);
                const u32x2 rcv = {oddq ? sx[0] : sx[1], oddq ? sy[0] : sy[1]};
                const u32x4 dat = oddq ? (u32x4){rcv.x, rcv.y, pc[1].x, pc[1].y} : (u32x4){pc[0].x, pc[0].y, rcv.x, rcv.y};
                if (r < u.cnt) *(u32x4*)(Y + (size_t)dsts[ai][m] * DM + colS) = dat; }
    }
};
__device__ __forceinline__ void phase_final(const Params& p) {
    const int lane = threadIdx.x & 63, wid = threadIdx.x >> 6;
    const unsigned char* y2 = p.ws + WS_Y2;
    f32x4 gn[4];
#pragma unroll
    for (int c = 0; c < 4; ++c) gn[c] = *(const f32x4*)(p.final_norm_gain + 256 * c + 4 * lane);
    for (int tok0 = (blockIdx.x * 8 + wid) * 4; tok0 < NTOK; tok0 += gridDim.x * 32) {
        u32x2 xb[4][4]; int yw[4][4][4];
#pragma unroll
        for (int q = 0; q < 4; ++q) { const bf16_t* x1r = (const bf16_t*)(p.ws + WS_X1) + (size_t)(tok0 + q) * DM;
#pragma unroll
            for (int c = 0; c < 4; ++c) xb[q][c] = __builtin_nontemporal_load((const u32x2*)(x1r + 256 * c + 4 * lane));
#pragma unroll
            for (int k = 0; k < 4; ++k) { const unsigned char* yr = y2 + ((size_t)(tok0 + q) * 4 + k) * DM;
#pragma unroll
                for (int c = 0; c < 4; ++c) yw[q][k][c] = __builtin_nontemporal_load((const int*)(yr + 256 * c + 4 * lane)); } }
#pragma unroll
        for (int q = 0; q < 4; ++q) {
            f32x4 v[4];
#pragma unroll
            for (int c = 0; c < 4; ++c) v[c] = up4(xb[q][c]);
#pragma unroll
            for (int k = 0; k < 4; ++k)
#pragma unroll
                for (int c = 0; c < 4; ++c) { const int w = yw[q][k][c];
                    const f32x2 lo = __builtin_amdgcn_cvt_pk_f32_fp8(w, false), hi = __builtin_amdgcn_cvt_pk_f32_fp8(w, true);
                    v[c][0] += lo.x; v[c][1] += lo.y; v[c][2] += hi.x; v[c][3] += hi.y; }
            float ss = 0.f;
#pragma unroll
            for (int c = 0; c < 4; ++c) ss += (v[c][0] * v[c][0] + v[c][1] * v[c][1]) + (v[c][2] * v[c][2] + v[c][3] * v[c][3]);
            ss = wave_sum(ss);
            const float rs = rsqrtf(ss * (1.0f / DM) + NORM_EPS);
            float* xr = p.out + (size_t)(tok0 + q) * DM;
#pragma unroll
            for (int c = 0; c < 4; ++c) *(f32x4*)(xr + 256 * c + 4 * lane) = v[c] * rs * gn[c];
        }
    }
}

constexpr int LDS_BYTES = 163840;
constexpr int L_MISC = 160 * 1024 - 64;
constexpr int L_TT = 159 * 1024;
__global__ void __launch_bounds__(512, 2) mega_fwd(Params p) {
    extern __shared__ __attribute__((aligned(16))) unsigned char lds_raw[];
    LAS unsigned char* lds = (LAS unsigned char*)lds_raw;
    volatile LAS unsigned* misc = (volatile LAS unsigned*)(lds + L_MISC);
    LAS TileTab* TT = (LAS TileTab*)(lds + L_TT);
    if (threadIdx.x < 4) misc[threadIdx.x] = 0u;
    __syncthreads();
    XcdBarrier bar = xcd_barrier_post((unsigned*)(p.ws + WS_CTL) + CW_BAR, misc);
    const int lo = p.ph_lo, hi = p.ph_hi;
#define IN(k) (lo <= (k) && (k) < hi)
    if (IN(0)) { phase0(p, lds); xcd_barrier(bar); }
    if (IN(1)) {
        {
            g8::DenseProb S; S.init(p.ws + WS_H, p.ws + WS_WIN, NTOK, N_BF, (int)gridDim.x, (int)blockIdx.x);
            EpiZT<false> E{(bf16_t*)(p.ws + WS_Z), 0};
            g8::gemm_phase<false>(lds, S, E); }
        __syncthreads();
        {
            g8::DenseProbT<1024> S; S.init(p.ws + WS_H8, p.ws + WS_WIN8, NTOK, INW - N_BF, (int)gridDim.x, (int)blockIdx.x);
            EpiZT<true> E{(bf16_t*)(p.ws + WS_Z), N_BF};
            g8::gemm_phase<true>(lds, S, E); }
        xcd_barrier(bar);
    }
    if (IN(2)) { rwkv_lora_act(p); xcd_barrier(bar); phase_rwkv(p, lds); __syncthreads(); phase_attn(p, lds); xcd_barrier(bar); }
    if (IN(3)) {
        g8::DenseProbT<2048, true> S; S.init(p.ws + WS_YMIX, p.ws + WS_WOUT, NTOK, DM, (int)gridDim.x, (int)blockIdx.x);
        EpiX1 E{p.x, (bf16_t*)(p.ws + WS_X1)};
        g8::gemm_phase<false>(lds, S, E);
        xcd_barrier(bar);
    }
    if (IN(4)) { phase_router(p, lds); xcd_barrier(bar); }
    if (IN(5)) {
        build_tiletab(p, TT);
        GroupProb<8> S; S.init(p.ws + WS_H, p.ws + WS_W1T, (const int*)(p.ws + WS_LIST), TT, true);
        EpiHid E{p.ws + WS_HID, p.expert_b1};
        g8::gemm_phase<true>(lds, S, E);
        xcd_barrier(bar);
    }
    if (IN(6)) {
        build_tiletab(p, TT);
        GroupProb<4> S; S.init(p.ws + WS_HID, p.ws + WS_W2T, (const int*)(p.ws + WS_LIST), TT, false);
        EpiY2 E{p.ws + WS_Y2, p.expert_b2, (const int*)(p.ws + WS_LIST), (const float*)(p.ws + WS_GLIST), TT};
        g8::gemm_phase<true>(lds, S, E);
        xcd_barrier(bar);
    }
    if (IN(7)) phase_final(p);
#undef IN
}

extern "C" void kernel_launch(void* const* d_in, const int* in_sizes, int n_in, void* d_out, int out_size, void* d_ws, size_t ws_size, hipStream_t stream) {
    static int grid = 0;
    if (grid == 0) {
        if (n_in != 24 || out_size != NTOK * DM || ws_size < WS_END) { fprintf(stderr, "kernel_launch: unexpected shapes (n_in %d, out %d, ws %zu < %zu); nothing launched\n", n_in, out_size, ws_size, (size_t)WS_END); grid = -1; return; }
        int dev = 0, cus = 0, per_cu = 0;
        if (hipGetDevice(&dev) != hipSuccess || hipDeviceGetAttribute(&cus, hipDeviceAttributeMultiprocessorCount, dev) != hipSuccess) { grid = -1; return; }
        if (hipFuncSetAttribute((const void*)mega_fwd, hipFuncAttributeMaxDynamicSharedMemorySize, LDS_BYTES) != hipSuccess) { fprintf(stderr, "kernel_launch: hipFuncSetAttribute failed\n"); grid = -1; return; }
        if (hipOccupancyMaxActiveBlocksPerMultiprocessor(&per_cu, (const void*)mega_fwd, 512, LDS_BYTES) != hipSuccess || per_cu < 1) { fprintf(stderr, "kernel_launch: occupancy query says %d\n", per_cu); (void)hipGetLastError(); grid = -1; return; }
        grid = cus;
    }
    if (grid < 0) return;
    if (hipMemsetAsync((char*)d_ws + WS_CTL, 0, CTL_ZERO_BYTES, stream) != hipSuccess) return;
    Params p{};
    const float** pp = (const float**)&p;
    for (int i = 0; i < 24; ++i) pp[i] = (const float*)d_in[i];
    p.out = (float*)d_out; p.ws = (unsigned char*)d_ws;
    p.ph_lo = 0; p.ph_hi = 8;
    hipLaunchKernelGGL(mega_fwd, dim3(grid), dim3(512), LDS_BYTES, stream, p);
}
```
